# Optimizing an MI355X kernel written in HIP

```python
import jax, jax.numpy as jnp
from jax import lax
import numpy as np

D_MODEL = 2048
BATCH = 4
SEQ = 4096
DEPTH = 2

HEAD_DIM = 128
D_CONV = D_MODEL // 4
CONV_GROUPS = D_CONV // HEAD_DIM
CONV_WIDTH = 3
N_NSA_HEADS = D_MODEL // 2 // HEAD_DIM
N_NSA_KV = 2
NSA_REP = N_NSA_HEADS // N_NSA_KV
D_NSA = N_NSA_HEADS * HEAD_DIM
D_NSA_KV = N_NSA_KV * HEAD_DIM
CMP_LEN = 32
CMP_STRIDE = 16
CMP_HIDDEN = 256
SLC_LEN = 64
N_SLC = 16
WINDOW = 512
Q_BLOCK = 64
ROPE_THETA = 500000.0
ROPE_DIM = HEAD_DIM // 4
N_RET_HEADS = D_MODEL // 4 // HEAD_DIM
D_RET = N_RET_HEADS * HEAD_DIM
RET_THETA = 10000.0
RET_CHUNK = 128
D_MIX = D_CONV + D_NSA + D_RET
N_EXPERTS = 64
N_EXPERT_GROUPS = 8
TOPK_GROUPS = 4
TOP_K = 8
D_EXPERT = 512
D_SHARED = 512
ROUTED_SCALE = 2.5
MOE_BLOCK = 256
ADA_CHUNKS = 6
EPS = 1e-6
NEG_INF = -1e30
FORCE_SCORE = 1e4
IN_SIZES = (D_CONV, D_CONV, D_CONV, D_NSA, 6 * D_NSA_KV, 3 * N_NSA_HEADS, D_RET, D_RET, D_RET, D_RET)
D_IN = sum(IN_SIZES)

kernel_name = "hybrid_conv_nsa_retention_moe_adaln"


def rms_norm(x, g):
    xf = x.astype(jnp.float32)
    xf = xf * lax.rsqrt(jnp.mean(xf * xf, axis=-1, keepdims=True) + EPS)
    return (xf * g.astype(jnp.float32)).astype(x.dtype)


def group_rms_norm(y, g, n_groups):
    shp = y.shape
    yf = y.astype(jnp.float32).reshape(shp[:-1] + (n_groups, shp[-1] // n_groups))
    yf = yf * lax.rsqrt(jnp.mean(yf * yf, axis=-1, keepdims=True) + EPS)
    return (yf.reshape(shp) * g.astype(jnp.float32)).astype(y.dtype)


def rotary(x, pos, rot_dim, theta):
    half = rot_dim // 2
    inv = theta ** (-jnp.arange(half, dtype=jnp.float32) / half)
    ang = pos.astype(jnp.float32)[..., None] * inv
    ang = ang.reshape(ang.shape[:2] + (1,) * (x.ndim - 3) + (half,))
    cos, sin = jnp.cos(ang), jnp.sin(ang)
    xr = x[..., :rot_dim].astype(jnp.float32)
    x1, x2 = xr[..., :half], xr[..., half:]
    rot = jnp.concatenate([x1 * cos - x2 * sin, x1 * sin + x2 * cos], axis=-1).astype(x.dtype)
    return jnp.concatenate([rot, x[..., rot_dim:]], axis=-1)


def short_conv_mixer(gate_b, gate_c, u, conv_w, norm_g):
    v = jnp.swapaxes(gate_c * u, 1, 2)
    y = lax.conv_general_dilated(v, conv_w.astype(v.dtype)[:, None, :], window_strides=(1,),
                                 padding=[(CONV_WIDTH - 1, 0)], dimension_numbers=("NCH", "OIH", "NCH"),
                                 feature_group_count=D_CONV)
    y = gate_b * jnp.swapaxes(y, 1, 2)
    return group_rms_norm(y, norm_g, CONV_GROUPS)


def compress_blocks(kv, pe, w1, w2):
    b, g, s, hd = kv.shape
    n_cmp = (s - CMP_LEN) // CMP_STRIDE + 1
    idx = np.arange(n_cmp)[:, None] * CMP_STRIDE + np.arange(CMP_LEN)[None, :]
    blocks = (kv[:, :, idx, :] + pe).reshape(b, g, n_cmp, CMP_LEN * hd)
    return jax.nn.gelu(blocks @ w1) @ w2


def cmp_slc_overlap(n_cmp, n_slc):
    cs = np.arange(n_cmp) * CMP_STRIDE
    js = np.arange(n_slc) * SLC_LEN
    ov = np.minimum(cs[:, None] + CMP_LEN, js[None, :] + SLC_LEN) - np.maximum(cs[:, None], js[None, :])
    return (np.clip(ov, 0, None) / CMP_LEN).astype(np.float32)


def nsa_mixer(q, k, v, gate_logits, cmp_pe, cmp_w1, cmp_w2, norm_g):
    b, s = q.shape[:2]
    scale = HEAD_DIM ** -0.5
    qg = q.reshape(b, s, N_NSA_KV, NSA_REP, HEAD_DIM).transpose(0, 2, 3, 1, 4)
    k = k.transpose(2, 0, 3, 1, 4)
    v = v.transpose(2, 0, 3, 1, 4)
    t = jnp.arange(s)
    k_c = compress_blocks(k[0], cmp_pe[0], cmp_w1[0], cmp_w2[0])
    v_c = compress_blocks(v[0], cmp_pe[1], cmp_w1[1], cmp_w2[1])
    n_cmp = k_c.shape[2]
    cmp_end = jnp.arange(n_cmp) * CMP_STRIDE + CMP_LEN - 1
    cmask = cmp_end[None, :] <= t[:, None]
    s_c = jnp.einsum("bgrqd,bgcd->bgrqc", qg, k_c).astype(jnp.float32) * scale
    p_c = jax.nn.softmax(jnp.where(cmask, s_c, NEG_INF), axis=-1) * cmask
    o_cmp = jnp.einsum("bgrqc,bgcd->bgrqd", p_c.astype(v_c.dtype), v_c)
    n_slc = s // SLC_LEN
    n_sel = min(N_SLC, n_slc)
    imp = jnp.einsum("bgrqc,cj->bgqj", p_c, jnp.asarray(cmp_slc_overlap(n_cmp, n_slc)))
    j = jnp.arange(n_slc)[None, :]
    jq = (t // SLC_LEN)[:, None]
    forced = (j == 0) | (j == jq) | (j == jq - 1)
    imp = jnp.where(forced, FORCE_SCORE, jnp.where(j <= jq, imp, -1.0))
    _, sel = lax.top_k(imp, n_sel)
    k_s, v_s = k[1], v[1]
    pad = ((0, 0), (0, 0), (WINDOW, 0), (0, 0))
    k_w, v_w = jnp.pad(k[2], pad), jnp.pad(v[2], pad)
    bi = jnp.arange(b)[:, None, None]
    gi = jnp.arange(N_NSA_KV)[None, :, None]
    span = WINDOW + Q_BLOCK
    n_keys = n_sel * SLC_LEN

    def query_block(i):
        t0 = i * Q_BLOCK
        qb = lax.dynamic_slice_in_dim(qg, t0, Q_BLOCK, axis=3)
        tq = t0 + jnp.arange(Q_BLOCK)
        blk = lax.dynamic_slice_in_dim(sel, t0, Q_BLOCK, axis=2)
        tok = (blk[..., None] * SLC_LEN + jnp.arange(SLC_LEN)).reshape(b, N_NSA_KV, Q_BLOCK * n_keys)
        ks = k_s[bi, gi, tok].reshape(b, N_NSA_KV, Q_BLOCK, n_keys, HEAD_DIM)
        vs = v_s[bi, gi, tok].reshape(b, N_NSA_KV, Q_BLOCK, n_keys, HEAD_DIM)
        smask = (tok.reshape(b, N_NSA_KV, Q_BLOCK, n_keys) <= tq[:, None])[:, :, None]
        ss = jnp.einsum("bgrqd,bgqkd->bgrqk", qb, ks).astype(jnp.float32) * scale
        ps = jax.nn.softmax(jnp.where(smask, ss, NEG_INF), axis=-1)
        o_s = jnp.einsum("bgrqk,bgqkd->bgrqd", ps.astype(vs.dtype), vs)
        kw = lax.dynamic_slice_in_dim(k_w, t0, span, axis=2)
        vw = lax.dynamic_slice_in_dim(v_w, t0, span, axis=2)
        sk = t0 - WINDOW + jnp.arange(span)
        diff = tq[:, None] - sk[None, :]
        wmask = (diff >= 0) & (diff < WINDOW) & (sk[None, :] >= 0)
        sw = jnp.einsum("bgrqd,bgkd->bgrqk", qb, kw).astype(jnp.float32) * scale
        pw = jax.nn.softmax(jnp.where(wmask, sw, NEG_INF), axis=-1)
        o_w = jnp.einsum("bgrqk,bgkd->bgrqd", pw.astype(vw.dtype), vw)
        return o_s, o_w

    o_slc, o_win = lax.map(query_block, jnp.arange(s // Q_BLOCK))
    unblock = lambda o: o.transpose(1, 2, 3, 0, 4, 5).reshape(b, N_NSA_KV, NSA_REP, s, HEAD_DIM)
    o_slc, o_win = unblock(o_slc), unblock(o_win)
    gates = jax.nn.sigmoid(gate_logits.astype(jnp.float32)).reshape(b, s, N_NSA_KV, NSA_REP, 3)
    gates = gates.transpose(0, 2, 3, 1, 4)[..., None]
    o = gates[..., 0, :] * o_cmp + gates[..., 1, :] * o_slc + gates[..., 2, :] * o_win
    o = o.transpose(0, 3, 1, 2, 4).reshape(b, s, D_NSA).astype(q.dtype)
    return group_rms_norm(o, norm_g, N_NSA_HEADS)


def retention_mixer(q, k, v, g, norm_g):
    b, s, h, hd = q.shape
    nc = s // RET_CHUNK
    f32 = jnp.float32
    log_gamma = jnp.log1p(-(2.0 ** (-5.0 - jnp.arange(h, dtype=f32))))
    chunk = lambda a: a.astype(f32).transpose(0, 2, 1, 3).reshape(b, h, nc, RET_CHUNK, hd)
    qc, kc, vc = chunk(q), chunk(k) * hd ** -0.5, chunk(v)
    n = jnp.arange(RET_CHUNK, dtype=f32)
    diff = n[:, None] - n[None, :]
    decay = jnp.where(diff >= 0, jnp.exp(jnp.maximum(diff, 0.0) * log_gamma[:, None, None]), 0.0)
    scores = jnp.einsum("bhcnd,bhcmd->bhcnm", qc, kc) * decay[None, :, None]
    o_intra = jnp.einsum("bhcnm,bhcme->bhcne", scores, vc)
    zeta = jnp.exp((RET_CHUNK - 1 - n) * log_gamma[:, None])
    kv_chunk = jnp.einsum("bhcmd,bhcme->bhcde", kc * zeta[None, :, None, :, None], vc)
    chunk_decay = jnp.exp(RET_CHUNK * log_gamma)[None, :, None, None]

    def step(state, kv):
        return state * chunk_decay + kv, state

    _, states = lax.scan(step, jnp.zeros((b, h, hd, hd), f32), jnp.moveaxis(kv_chunk, 2, 0))
    xi = jnp.exp((n + 1.0) * log_gamma[:, None])
    o_inter = jnp.einsum("bhcnd,cbhde->bhcne", qc * xi[None, :, None, :, None], states)
    o = (o_intra + o_inter).reshape(b, h, s, hd).transpose(0, 2, 1, 3).reshape(b, s, h * hd)
    o = group_rms_norm(o, norm_g, h)
    return (jax.nn.silu(g.astype(f32)) * o.astype(f32)).astype(g.dtype)


def token_mixer(h, positions, w_in, conv_w, conv_g, cmp_pe, cmp_w1, cmp_w2, nsa_g, ret_g, w_out):
    b, s, _ = h.shape
    splits = np.cumsum(IN_SIZES)[:-1].tolist()
    cb, cc, cu, q_n, kv_n, gate_n, q_r, k_r, v_r, g_r = jnp.split(h @ w_in, splits, axis=-1)
    y_conv = short_conv_mixer(cb, cc, cu, conv_w, conv_g)
    q_n = rotary(q_n.reshape(b, s, N_NSA_HEADS, HEAD_DIM), positions, ROPE_DIM, ROPE_THETA)
    kv_n = kv_n.reshape(b, s, 3, 2, N_NSA_KV, HEAD_DIM)
    k_n = rotary(kv_n[:, :, :, 0], positions, ROPE_DIM, ROPE_THETA)
    y_nsa = nsa_mixer(q_n, k_n, kv_n[:, :, :, 1], gate_n, cmp_pe, cmp_w1, cmp_w2, nsa_g)
    heads = lambda a: a.reshape(b, s, N_RET_HEADS, HEAD_DIM)
    q_r = rotary(heads(q_r), positions, HEAD_DIM, RET_THETA)
    k_r = rotary(heads(k_r), positions, HEAD_DIM, RET_THETA)
    y_ret = retention_mixer(q_r, k_r, heads(v_r), g_r, ret_g)
    return jnp.concatenate([y_conv, y_nsa, y_ret], axis=-1) @ w_out


def swiglu(t, w_gu, w_down):
    gate, up = jnp.split(t @ w_gu, 2, axis=-1)
    return (jax.nn.silu(gate) * up) @ w_down


def moe_ffn(h, router_w, router_bias, w_gu, w_down, shared_gu, shared_down):
    b, s, d = h.shape
    n_tok = b * s
    t = h.reshape(n_tok, d)
    scores = jax.nn.sigmoid((t @ router_w).astype(jnp.float32))
    biased = scores + router_bias.astype(jnp.float32)
    per_group = N_EXPERTS // N_EXPERT_GROUPS
    group_score = lax.top_k(biased.reshape(n_tok, N_EXPERT_GROUPS, per_group), 2)[0].sum(-1)
    _, top_groups = lax.top_k(group_score, TOPK_GROUPS)
    group_mask = jnp.any(top_groups[..., None] == jnp.arange(N_EXPERT_GROUPS), axis=1)
    biased = jnp.where(jnp.repeat(group_mask, per_group, axis=1), biased, -jnp.inf)
    _, top_e = lax.top_k(biased, TOP_K)
    w = jnp.take_along_axis(scores, top_e, axis=1)
    w = ROUTED_SCALE * w / jnp.sum(w, axis=-1, keepdims=True)
    n_assign = n_tok * TOP_K
    n_blocks = (n_assign + N_EXPERTS * (MOE_BLOCK - 1) + MOE_BLOCK - 1) // MOE_BLOCK
    flat_e = top_e.reshape(-1)
    order = jnp.argsort(flat_e)
    sorted_e = flat_e[order]
    counts = jnp.bincount(flat_e, length=N_EXPERTS)
    padded = (counts + MOE_BLOCK - 1) // MOE_BLOCK * MOE_BLOCK
    pad_end = jnp.cumsum(padded)
    dest = (pad_end - padded)[sorted_e] + jnp.arange(n_assign) - (jnp.cumsum(counts) - counts)[sorted_e]
    tok = order // TOP_K
    xs = jnp.zeros((n_blocks * MOE_BLOCK, d), t.dtype).at[dest].set(t[tok])
    block_e = jnp.minimum(jnp.searchsorted(pad_end, jnp.arange(n_blocks) * MOE_BLOCK, side="right"), N_EXPERTS - 1)

    def expert_block(args):
        xb, e = args
        return swiglu(xb, w_gu[e], w_down[e])

    ys = lax.map(expert_block, (xs.reshape(n_blocks, MOE_BLOCK, d), block_e)).reshape(n_blocks * MOE_BLOCK, d)
    y = ys[dest] * w.reshape(-1)[order][:, None].astype(ys.dtype)
    routed = jnp.zeros_like(t).at[tok].add(y)
    return (routed + swiglu(t, shared_gu, shared_down)).reshape(b, s, d)


def setup_inputs(seed: int = 0) -> dict:
    key = jax.random.key(seed)
    ks = jax.random.split(key, 24)
    L = DEPTH

    def nrm(k, shape, scale):
        return jax.random.normal(k, shape, jnp.float32) * scale

    offset = jax.random.randint(ks[2], (BATCH, 1), 0, 1024, dtype=jnp.int32)
    positions = offset + jnp.arange(SEQ, dtype=jnp.int32)[None, :]
    return {
        "x": nrm(ks[0], (BATCH, SEQ, D_MODEL), 1.0),
        "c": nrm(ks[1], (BATCH, D_MODEL), 1.0),
        "positions": positions,
        "ada_w": nrm(ks[3], (L, D_MODEL, ADA_CHUNKS * D_MODEL), 0.5 * D_MODEL ** -0.5),
        "ada_b": nrm(ks[4], (L, ADA_CHUNKS * D_MODEL), 0.02),
        "norm1_g": 1.0 + nrm(ks[5], (L, D_MODEL), 0.1),
        "norm2_g": 1.0 + nrm(ks[6], (L, D_MODEL), 0.1),
        "w_in": nrm(ks[7], (L, D_MODEL, D_IN), D_MODEL ** -0.5),
        "conv_w": nrm(ks[8], (L, D_CONV, CONV_WIDTH), CONV_WIDTH ** -0.5),
        "conv_g": 1.0 + nrm(ks[9], (L, D_CONV), 0.1),
        "cmp_pe": nrm(ks[10], (L, 2, CMP_LEN, HEAD_DIM), 0.5),
        "cmp_w1": nrm(ks[11], (L, 2, CMP_LEN * HEAD_DIM, CMP_HIDDEN), (CMP_LEN * HEAD_DIM) ** -0.5),
        "cmp_w2": nrm(ks[12], (L, 2, CMP_HIDDEN, HEAD_DIM), CMP_HIDDEN ** -0.5),
        "nsa_g": 1.0 + nrm(ks[13], (L, D_NSA), 0.1),
        "ret_g": 1.0 + nrm(ks[14], (L, D_RET), 0.1),
        "w_out": nrm(ks[15], (L, D_MIX, D_MODEL), D_MIX ** -0.5),
        "router_w": nrm(ks[16], (L, D_MODEL, N_EXPERTS), D_MODEL ** -0.5),
        "router_bias": nrm(ks[17], (L, N_EXPERTS), 0.01),
        "exp_w_gu": nrm(ks[18], (L, N_EXPERTS, D_MODEL, 2 * D_EXPERT), D_MODEL ** -0.5),
        "exp_w_down": nrm(ks[19], (L, N_EXPERTS, D_EXPERT, D_MODEL), D_EXPERT ** -0.5),
        "shared_w_gu": nrm(ks[20], (L, D_MODEL, 2 * D_SHARED), D_MODEL ** -0.5),
        "shared_w_down": nrm(ks[21], (L, D_SHARED, D_MODEL), D_SHARED ** -0.5),
        "final_g": 1.0 + nrm(ks[22], (D_MODEL,), 0.1),
    }


def reference(x, c, positions, ada_w, ada_b, norm1_g, norm2_g, w_in, conv_w, conv_g, cmp_pe, cmp_w1, cmp_w2,
              nsa_g, ret_g, w_out, router_w, router_bias, exp_w_gu, exp_w_down, shared_w_gu, shared_w_down, final_g):
    c_act = jax.nn.silu(c)
    for l in range(DEPTH):
        mod = (c_act @ ada_w[l] + ada_b[l])[:, None, :]
        sh1, sc1, g1, sh2, sc2, g2 = jnp.split(mod, ADA_CHUNKS, axis=-1)
        h = rms_norm(x, norm1_g[l]) * (1.0 + sc1) + sh1
        x = x + g1 * token_mixer(h, positions, w_in[l], conv_w[l], conv_g[l], cmp_pe[l], cmp_w1[l], cmp_w2[l],
                                 nsa_g[l], ret_g[l], w_out[l])
        h = rms_norm(x, norm2_g[l]) * (1.0 + sc2) + sh2
        x = x + g2 * moe_ffn(h, router_w[l], router_bias[l], exp_w_gu[l], exp_w_down[l],
                             shared_w_gu[l], shared_w_down[l])
    return rms_norm(x, final_g)
```

```cpp
#include <hip/hip_runtime.h>
#include <stdint.h>
#include <stdio.h>
#include <string.h>

typedef unsigned short bf16_t;
#define DI __device__ __forceinline__
#define LDS_WAIT() asm volatile("s_waitcnt lgkmcnt(0)" ::: "memory")

constexpr int NB = 4, SEQ = 4096, DM = 2048, NT = NB * SEQ, NL = 2;
constexpr int HD = 128;
constexpr int D_IN = 6168, LDY = 6400;
constexpr int Y_CB = 0, Y_CC = 512, Y_CU = 1024, Y_QN = 1536, Y_KV = 2560, Y_QR = 4096, Y_KR = 4608, Y_VR = 5120, Y_GR = 5632, Y_GATE = 6144;
constexpr int NEXP = 64, TOPK = 8, DEXP = 512;
constexpr int NSLOT = 576 * 256;
constexpr int NROWS_E = NSLOT + NT;
constexpr float EPS = 1e-6f;
constexpr int NCMP = 255;

constexpr size_t MiB = 1ull << 20;
constexpr size_t WS_CTL = 0;
constexpr size_t WS_MOD = 1 * MiB;
constexpr size_t WS_CMPB = WS_MOD + 512 * 1024;
constexpr size_t WS_W = 2 * MiB;
constexpr size_t WL_WIN = 0;
constexpr size_t WL_WOUT = WL_WIN + (size_t)LDY * DM * 2;
constexpr size_t WL_CW1 = WL_WOUT + (size_t)DM * DM * 2;
constexpr size_t WL_CW2 = WL_CW1 + (size_t)2 * 256 * 4096 * 2;
constexpr size_t WL_RTH = WL_CW2 + (size_t)2 * 128 * 256 * 2;
constexpr size_t WL_RTL = WL_RTH + (size_t)64 * DM * 2;
constexpr size_t WL_EGU = WL_RTL + (size_t)64 * DM * 2;
constexpr size_t WL_EDN = WL_EGU + (size_t)65 * 1024 * DM * 2;
constexpr size_t WL_END = WL_EDN + (size_t)65 * DM * 512 * 2;
constexpr size_t WL_STRIDE = 428 * MiB;
static_assert(WL_END <= WL_STRIDE, "layer weights");
constexpr size_t WS_H = WS_W + NL * WL_STRIDE;
constexpr size_t WS_HLO = WS_H + (size_t)NT * DM * 2;
constexpr size_t WS_Y = WS_HLO + (size_t)NT * DM * 2;
constexpr size_t WS_YMIX = WS_Y + (size_t)NT * LDY * 2;
constexpr size_t WS_X1 = WS_YMIX + (size_t)NT * DM * 2;
constexpr size_t WS_X2 = WS_X1 + (size_t)NT * DM * 4;
constexpr size_t WS_OCMP = WS_X2 + (size_t)NT * DM * 4;
constexpr size_t WS_SEL = WS_OCMP + (size_t)NT * 1024 * 4;
constexpr size_t WS_HID = WS_SEL + (size_t)NB * 2 * SEQ * 8;
constexpr size_t WS_KC = WS_HID + (size_t)2 * 8 * 256 * 256 * 2;
constexpr size_t WS_VC = WS_KC + (size_t)8 * 256 * 128 * 2;
constexpr size_t WS_KVC = WS_VC + (size_t)8 * 256 * 128 * 2;
constexpr size_t WS_STATE = WS_KVC + (size_t)16 * 32 * 16384 * 4;
constexpr size_t WS_TOPE = WS_STATE + (size_t)16 * 32 * 16384 * 4;
constexpr size_t WS_TOPW = WS_TOPE + (size_t)NT * 8 * 4;
constexpr size_t WS_RANK = WS_TOPW + (size_t)NT * 8 * 4;
constexpr size_t WS_SLOT = WS_RANK + (size_t)NT * 8 * 4;
constexpr size_t WS_XS = WS_SLOT + (size_t)NT * 8 * 4;
constexpr size_t WS_GU = WS_XS + (size_t)NSLOT * DM * 2;
constexpr size_t WS_ACT = WS_GU + (size_t)NROWS_E * 1024 * 2;
constexpr size_t WS_YS = WS_ACT + (size_t)NROWS_E * 512 * 2;
constexpr size_t WS_END = WS_YS + (size_t)NROWS_E * DM * 2;
constexpr int CW_CNT = 8192;

struct Params {
    const float *x, *c; const int* pos;
    const float *ada_w, *ada_b, *norm1_g, *norm2_g, *w_in, *conv_w, *conv_g, *cmp_pe, *cmp_w1, *cmp_w2, *nsa_g, *ret_g, *w_out,
                *router_w, *router_bias, *exp_w_gu, *exp_w_down, *shared_w_gu, *shared_w_down, *final_g;
    float* out; unsigned char* ws;
};

DI float bf2f(bf16_t b) { return __uint_as_float(((unsigned)b) << 16); }
DI bf16_t f2bf(float f) { unsigned u = __float_as_uint(f); u += 0x7fffu + ((u >> 16) & 1u); return (bf16_t)(u >> 16); }
DI unsigned pk2(float lo, float hi) { return (unsigned)f2bf(lo) | ((unsigned)f2bf(hi) << 16); }
DI float wave_sum(float v) {
#pragma unroll
    for (int o = 1; o < 64; o <<= 1) v += __shfl_xor(v, o);
    return v;
}
DI float wave_max(float v) {
#pragma unroll
    for (int o = 1; o < 64; o <<= 1) v = fmaxf(v, __shfl_xor(v, o));
    return v;
}
DI float silu_f(float v) { return v / (1.f + __expf(-v)); }
DI float sigmoid_f(float v) { return 1.f / (1.f + __expf(-v)); }
DI float gelu_tanh_f(float v) { const float u = 0.7978845608028654f * (v + 0.044715f * v * v * v); return 0.5f * v * (1.f + tanhf(u)); }
DI bf16_t* wl_ptr(const Params& p, int l, size_t off) { return (bf16_t*)(p.ws + WS_W + (size_t)l * WL_STRIDE + off); }
DI float* mod_ptr(const Params& p, int l, int b, int chunk) { return (float*)(p.ws + WS_MOD) + ((size_t)(l * NB + b) * 6 + chunk) * DM; }
DI double ret_loggamma(int h) { return log1p(-exp2(-5.0 - (double)h)); }

DI int maprow(int kind, int n) {
    if (kind == 1) return n < 4096 ? n : (n < 4120 ? n + 2048 : n - 24);
    if (kind == 2) { if (n < 512) return (n >> 7) * 256 + (n & 127); const int j = n - 512; return (j >> 7) * 256 + 128 + (j & 127); }
    return n;
}
DI void tr_item(const float* __restrict__ W, int ldw, int ncols, int Kd, bf16_t* WT, int k0, int n0, int kind, float* scr, int lane) {
#pragma unroll 8
    for (int i = 0; i < 32; ++i) { const int kk = 2 * i + (lane >> 5), n = n0 + (lane & 31);
        scr[kk * 33 + (lane & 31)] = (n < ncols) ? W[(size_t)(k0 + kk) * ldw + n] : 0.f; }
    LDS_WAIT();
    const int c = lane & 7;
#pragma unroll
    for (int j = 0; j < 4; ++j) { const int nn = (lane >> 3) + 8 * j, n = n0 + nn;
        if (n < ncols) { const float* s = scr + (8 * c) * 33 + nn;
            uint4 o; o.x = pk2(s[0 * 33], s[1 * 33]); o.y = pk2(s[2 * 33], s[3 * 33]); o.z = pk2(s[4 * 33], s[5 * 33]); o.w = pk2(s[6 * 33], s[7 * 33]);
            *(uint4*)(WT + (size_t)maprow(kind, n) * Kd + k0 + 8 * c) = o; } }
    LDS_WAIT();
}
DI void tr_job(const float* W, int ldw, int ncols, int Kd, bf16_t* WT, int kind, int r, float* scr, int lane) {
    const int nblk = (ncols + 31) / 32; const int kb = r / nblk, nb = r % nblk;
    tr_item(W, ldw, ncols, Kd, WT, kb * 64, nb * 32, kind, scr, lane);
}
DI void st_convert(const Params& p, unsigned char* smem) {
    const int tid = threadIdx.x, lane = tid & 63, wave = tid >> 6;
    float* scr = (float*)smem + wave * (64 * 33);
    const int gw = blockIdx.x * 8 + wave, NGW = gridDim.x * 8;
    constexpr int I_WIN = 32 * 193, I_WOUT = 32 * 64, I_C1 = 64 * 8, I_C2 = 4 * 4, I_GU = 32 * 32, I_DN = 8 * 64;
    constexpr int PER_L = I_WIN + I_WOUT + 2 * I_C1 + 2 * I_C2 + 65 * I_GU + 65 * I_DN;
    for (int it = gw; it < NL * PER_L; it += NGW) {
        const int l = it / PER_L; int r = it % PER_L;
        if (r < I_WIN) { tr_job(p.w_in + (size_t)l * DM * D_IN, D_IN, D_IN, DM, wl_ptr(p, l, WL_WIN), 1, r, scr, lane); continue; } r -= I_WIN;
        if (r < I_WOUT) { tr_job(p.w_out + (size_t)l * DM * DM, DM, DM, DM, wl_ptr(p, l, WL_WOUT), 0, r, scr, lane); continue; } r -= I_WOUT;
        if (r < 2 * I_C1) { const int kv = r / I_C1; tr_job(p.cmp_w1 + (size_t)(l * 2 + kv) * 4096 * 256, 256, 256, 4096, wl_ptr(p, l, WL_CW1) + (size_t)kv * 256 * 4096, 0, r % I_C1, scr, lane); continue; } r -= 2 * I_C1;
        if (r < 2 * I_C2) { const int kv = r / I_C2; tr_job(p.cmp_w2 + (size_t)(l * 2 + kv) * 256 * 128, 128, 128, 256, wl_ptr(p, l, WL_CW2) + (size_t)kv * 128 * 256, 0, r % I_C2, scr, lane); continue; } r -= 2 * I_C2;
        if (r < 65 * I_GU) { const int e = r / I_GU; const float* src = e < 64 ? p.exp_w_gu + (size_t)(l * 64 + e) * DM * 1024 : p.shared_w_gu + (size_t)l * DM * 1024;
            tr_job(src, 1024, 1024, DM, wl_ptr(p, l, WL_EGU) + (size_t)e * 1024 * DM, 2, r % I_GU, scr, lane); continue; } r -= 65 * I_GU;
        { const int e = r / I_DN; const float* src = e < 64 ? p.exp_w_down + (size_t)(l * 64 + e) * 512 * DM : p.shared_w_down + (size_t)l * 512 * DM;
            tr_job(src, DM, DM, 512, wl_ptr(p, l, WL_EDN) + (size_t)e * DM * 512, 0, r % I_DN, scr, lane); }
    }
    const size_t gt = (size_t)blockIdx.x * blockDim.x + tid, NGT = (size_t)gridDim.x * blockDim.x;
    for (int l = 0; l < NL; ++l) {
        bf16_t* wt = wl_ptr(p, l, WL_WIN);
        for (size_t i = gt; i < (size_t)(LDY - D_IN) * DM / 8; i += NGT) ((uint4*)(wt + (size_t)D_IN * DM))[i] = make_uint4(0, 0, 0, 0);
        bf16_t* rh = wl_ptr(p, l, WL_RTH); bf16_t* rl = wl_ptr(p, l, WL_RTL);
        for (size_t i = gt; i < (size_t)64 * DM; i += NGT) { const int e = (int)(i / DM), k = (int)(i % DM); const float w = p.router_w[((size_t)l * DM + k) * 64 + e];
            const bf16_t h = f2bf(w); rh[i] = h; rl[i] = f2bf(w - bf2f(h)); }
    }
    if (blockIdx.x < 16) {
        const int l = blockIdx.x >> 3, kv = (blockIdx.x >> 2) & 1, jb = blockIdx.x & 3;
        const float* pe = p.cmp_pe + (size_t)(l * 2 + kv) * 4096; const float* w1 = p.cmp_w1 + (size_t)(l * 2 + kv) * 4096 * 256;
        float acc = 0.f; const int j = jb * 64 + lane;
        for (int i = wave * 512; i < wave * 512 + 512; ++i) acc += pe[i] * w1[(size_t)i * 256 + j];
        __syncthreads();
        float* red = (float*)smem; red[wave * 64 + lane] = acc; __syncthreads();
        if (wave == 0) { float s = 0.f; for (int w = 0; w < 8; ++w) s += red[w * 64 + lane]; ((float*)(p.ws + WS_CMPB))[(l * 2 + kv) * 256 + j] = s; }
    }
}

DI void st_mod(const Params& p, unsigned char* smem) {
    const int tid = threadIdx.x, lane = tid & 63, wave = tid >> 6;
    float* ca = (float*)smem;
    float* red = ca + 4 * DM;
    for (int i = tid; i < 4 * DM; i += 512) ca[i] = silu_f(p.c[i]);
    __syncthreads();
    for (int u = blockIdx.x; u < NL * 96; u += gridDim.x) {
        const int l = u / 96, cb = u % 96; const int col = cb * 128 + (lane & 31) * 4;
        const float* W = p.ada_w + (size_t)l * DM * 12288;
        float acc[4][4] = {};
        for (int i = 0; i < 128; ++i) { const int k = 2 * (wave + 8 * i) + (lane >> 5);
            const float4 w = *(const float4*)(W + (size_t)k * 12288 + col);
#pragma unroll
            for (int b = 0; b < 4; ++b) { const float cv = ca[b * DM + k]; acc[b][0] += cv * w.x; acc[b][1] += cv * w.y; acc[b][2] += cv * w.z; acc[b][3] += cv * w.w; } }
#pragma unroll
        for (int b = 0; b < 4; ++b)
#pragma unroll
            for (int j = 0; j < 4; ++j) acc[b][j] += __shfl_xor(acc[b][j], 32);
        __syncthreads();
        if (lane < 32) {
#pragma unroll
            for (int b = 0; b < 4; ++b)
#pragma unroll
                for (int j = 0; j < 4; ++j) red[(wave * 4 + b) * 128 + lane * 4 + j] = acc[b][j]; }
        __syncthreads();
        { const int b = tid >> 7, cc = tid & 127; float s = 0.f;
            for (int w = 0; w < 8; ++w) s += red[(w * 4 + b) * 128 + cc];
            const int gcol = cb * 128 + cc;
            ((float*)(p.ws + WS_MOD))[(size_t)(l * NB + b) * 12288 + gcol] = s + p.ada_b[(size_t)l * 12288 + gcol]; }
    }
}

DI void norm_row_store(float4 (&v)[8], int lane, const float* g, const float* sc, const float* sh, bf16_t* hrow, bf16_t* lorow) {
    float ss = 0.f;
#pragma unroll
    for (int j = 0; j < 8; ++j) ss += v[j].x * v[j].x + v[j].y * v[j].y + v[j].z * v[j].z + v[j].w * v[j].w;
    const float r = rsqrtf(wave_sum(ss) * (1.f / DM) + EPS);
#pragma unroll
    for (int j = 0; j < 8; ++j) { const int e = (j * 64 + lane) * 4;
        const float4 gg = *(const float4*)(g + e), s1 = *(const float4*)(sc + e), s0 = *(const float4*)(sh + e);
        const float h0 = v[j].x * r * gg.x * (1.f + s1.x) + s0.x, h1 = v[j].y * r * gg.y * (1.f + s1.y) + s0.y,
                    h2 = v[j].z * r * gg.z * (1.f + s1.z) + s0.z, h3 = v[j].w * r * gg.w * (1.f + s1.w) + s0.w;
        const bf16_t b0 = f2bf(h0), b1 = f2bf(h1), b2 = f2bf(h2), b3 = f2bf(h3);
        uint2 o; o.x = (unsigned)b0 | ((unsigned)b1 << 16); o.y = (unsigned)b2 | ((unsigned)b3 << 16);
        *(uint2*)(hrow + e) = o;
        if (lorow) { uint2 q; q.x = pk2(h0 - bf2f(b0), h1 - bf2f(b1)); q.y = pk2(h2 - bf2f(b2), h3 - bf2f(b3)); *(uint2*)(lorow + e) = q; } }
}
DI void st_norm(const Params& p, int l, const float* xin, int which) {
    const int lane = threadIdx.x & 63, wave = threadIdx.x >> 6;
    bf16_t* H = (bf16_t*)(p.ws + WS_H); bf16_t* HLO = (bf16_t*)(p.ws + WS_HLO);
    const float* g = (which == 0 ? p.norm1_g : p.norm2_g) + (size_t)l * DM;
    for (int t = blockIdx.x * 8 + wave; t < NT; t += gridDim.x * 8) {
        const int b = t / SEQ; float4 v[8];
#pragma unroll
        for (int j = 0; j < 8; ++j) v[j] = *(const float4*)(xin + (size_t)t * DM + (j * 64 + lane) * 4);
        norm_row_store(v, lane, g, mod_ptr(p, l, b, which * 3 + 1), mod_ptr(p, l, b, which * 3 + 0), H + (size_t)t * DM, which ? HLO + (size_t)t * DM : nullptr);
    }
}

template <class Epi>
DI void sgemm_tile(unsigned char* smem, const bf16_t* A, size_t lda, size_t kseg, int mvalid, const bf16_t* Bt, size_t ldb, int K, const Epi& epi) {
    float* As = (float*)smem; float* Bs = As + 16 * 132;
    const int tid = threadIdx.x, tx = tid & 31, ty = tid >> 5;
    const int lr = tid >> 2, lk = (tid & 3) * 4;
    const int ar = lr < mvalid ? lr : mvalid - 1;
    float acc[8][4] = {};
    for (int k0 = 0; k0 < K; k0 += 16) {
        const int k = k0 + lk;
        const uint2 av = *(const uint2*)(A + (size_t)ar * lda + (size_t)(k >> 7) * kseg + (k & 127));
        const uint2 bv = *(const uint2*)(Bt + (size_t)lr * ldb + k);
        __syncthreads();
        As[(lk + 0) * 132 + lr] = __uint_as_float(av.x << 16); As[(lk + 1) * 132 + lr] = __uint_as_float(av.x & 0xffff0000u);
        As[(lk + 2) * 132 + lr] = __uint_as_float(av.y << 16); As[(lk + 3) * 132 + lr] = __uint_as_float(av.y & 0xffff0000u);
        Bs[(lk + 0) * 132 + lr] = __uint_as_float(bv.x << 16); Bs[(lk + 1) * 132 + lr] = __uint_as_float(bv.x & 0xffff0000u);
        Bs[(lk + 2) * 132 + lr] = __uint_as_float(bv.y << 16); Bs[(lk + 3) * 132 + lr] = __uint_as_float(bv.y & 0xffff0000u);
        __syncthreads();
#pragma unroll
        for (int kk = 0; kk < 16; ++kk) {
            const float4 a0 = *(const float4*)(As + kk * 132 + ty * 8), a1 = *(const float4*)(As + kk * 132 + ty * 8 + 4);
            const float4 b = *(const float4*)(Bs + kk * 132 + tx * 4);
            const float a[8] = {a0.x, a0.y, a0.z, a0.w, a1.x, a1.y, a1.z, a1.w};
#pragma unroll
            for (int i = 0; i < 8; ++i) { acc[i][0] += a[i] * b.x; acc[i][1] += a[i] * b.y; acc[i][2] += a[i] * b.z; acc[i][3] += a[i] * b.w; }
        }
    }
    __syncthreads();
#pragma unroll
    for (int i = 0; i < 8; ++i) { const int r = ty * 8 + i; if (r < mvalid) {
#pragma unroll
        for (int j = 0; j < 4; ++j) epi(r, tx * 4 + j, acc[i][j]); } }
}

DI void st_inproj(const Params& p, int l, unsigned char* smem) {
    const bf16_t* H = (const bf16_t*)(p.ws + WS_H); const bf16_t* W = wl_ptr(p, l, WL_WIN); bf16_t* Y = (bf16_t*)(p.ws + WS_Y);
    constexpr int NNT = LDY / 128;
    for (int u = blockIdx.x; u < (NT / 128) * NNT; u += gridDim.x) {
        const int mt = u / NNT, nt = u % NNT;
        bf16_t* out = Y + (size_t)mt * 128 * LDY + nt * 128;
        sgemm_tile(smem, H + (size_t)mt * 128 * DM, DM, 128, 128, W + (size_t)nt * 128 * DM, DM, DM, [&](int r, int c, float v) { out[(size_t)r * LDY + c] = f2bf(v); });
    }
}

DI void st_post(const Params& p, int l) {
    const int lane = threadIdx.x & 63, wave = threadIdx.x >> 6;
    bf16_t* Y = (bf16_t*)(p.ws + WS_Y); bf16_t* YM = (bf16_t*)(p.ws + WS_YMIX);
    for (int t = blockIdx.x * 8 + wave; t < NT; t += gridDim.x * 8) {
        bf16_t* y = Y + (size_t)t * LDY; const double pos = (double)p.pos[t]; const int s = t % SEQ;
        { const int i = lane & 15; const double inv = exp2(-(double)i / 16.0 * 18.931568569324174);
          double sd, cd; sincos(pos * inv, &sd, &cd); const float cs = (float)cd, sn = (float)sd;
          for (int vv = lane >> 4; vv < 14; vv += 4) {
              const int base = vv < 8 ? Y_QN + vv * 128 : Y_KV + ((vv - 8) >> 1) * 512 + ((vv - 8) & 1) * 128;
              const float x1 = bf2f(y[base + i]), x2 = bf2f(y[base + i + 16]);
              y[base + i] = f2bf(x1 * cs - x2 * sn); y[base + i + 16] = f2bf(x1 * sn + x2 * cs); } }
        { const int i = lane; const double inv = exp2(-(double)i / 64.0 * 13.287712379549449);
          double sd, cd; sincos(pos * inv, &sd, &cd); const float cs = (float)cd, sn = (float)sd;
          for (int vv = 0; vv < 8; ++vv) { const int base = (vv < 4 ? Y_QR : Y_KR) + (vv & 3) * 128;
              const float x1 = bf2f(y[base + i]), x2 = bf2f(y[base + i + 64]);
              y[base + i] = f2bf(x1 * cs - x2 * sn); y[base + i + 64] = f2bf(x1 * sn + x2 * cs); } }
        float yc[8]; float gs[4] = {0.f, 0.f, 0.f, 0.f};
#pragma unroll
        for (int i = 0; i < 8; ++i) { const int c = lane + 64 * i; const float* cw = p.conv_w + ((size_t)l * 512 + c) * 3;
            const float v0 = bf2f(y[Y_CC + c]) * bf2f(y[Y_CU + c]);
            const float v1 = s >= 1 ? bf2f(y[Y_CC + c - LDY]) * bf2f(y[Y_CU + c - LDY]) : 0.f;
            const float v2 = s >= 2 ? bf2f(y[Y_CC + c - 2 * LDY]) * bf2f(y[Y_CU + c - 2 * LDY]) : 0.f;
            yc[i] = bf2f(y[Y_CB + c]) * (cw[0] * v2 + cw[1] * v1 + cw[2] * v0); gs[i >> 1] += yc[i] * yc[i]; }
#pragma unroll
        for (int g = 0; g < 4; ++g) gs[g] = rsqrtf(wave_sum(gs[g]) * (1.f / 128.f) + EPS);
#pragma unroll
        for (int i = 0; i < 8; ++i) { const int c = lane + 64 * i; YM[(size_t)t * DM + c] = f2bf(yc[i] * gs[i >> 1] * p.conv_g[(size_t)l * 512 + c]); }
    }
}

DI void st_cmp1(const Params& p, int l, unsigned char* smem) {
    const bf16_t* Y = (const bf16_t*)(p.ws + WS_Y); bf16_t* HID = (bf16_t*)(p.ws + WS_HID); const float* bias = (const float*)(p.ws + WS_CMPB) + l * 512;
    for (int u = blockIdx.x; u < 2 * 8 * 2 * 2; u += gridDim.x) {
        const int kv = u >> 5, bg = (u >> 2) & 7, mt = (u >> 1) & 1, nt = u & 1; const int b = bg >> 1, g = bg & 1;
        const bf16_t* A = Y + ((size_t)b * SEQ + (size_t)mt * 128 * 16) * LDY + Y_KV + kv * 256 + g * 128;
        const bf16_t* W = wl_ptr(p, l, WL_CW1) + ((size_t)kv * 256 + nt * 128) * 4096;
        bf16_t* out = HID + ((size_t)(kv * 8 + bg) * 256 + mt * 128) * 256 + nt * 128; const float* bb = bias + kv * 256 + nt * 128;
        sgemm_tile(smem, A, (size_t)16 * LDY, LDY, mt ? 127 : 128, W, 4096, 4096, [&](int r, int c, float v) { out[(size_t)r * 256 + c] = f2bf(gelu_tanh_f(v + bb[c])); });
    }
}
DI void st_cmp2(const Params& p, int l, unsigned char* smem) {
    const bf16_t* HID = (const bf16_t*)(p.ws + WS_HID);
    for (int u = blockIdx.x; u < 2 * 8 * 2; u += gridDim.x) {
        const int kv = u >> 4, bg = (u >> 1) & 7, mt = u & 1;
        bf16_t* out = (bf16_t*)(p.ws + (kv ? WS_VC : WS_KC)) + ((size_t)bg * 256 + mt * 128) * 128;
        sgemm_tile(smem, HID + ((size_t)(kv * 8 + bg) * 256 + mt * 128) * 256, 256, 128, mt ? 127 : 128, wl_ptr(p, l, WL_CW2) + (size_t)kv * 128 * 256, 256, 256,
                   [&](int r, int c, float v) { out[(size_t)r * 128 + c] = f2bf(v); });
        if (mt && threadIdx.x < 128) out[(size_t)127 * 128 + threadIdx.x] = 0;
    }
}

DI void st_kvchunk(const Params& p, int l) {
    const bf16_t* Y = (const bf16_t*)(p.ws + WS_Y); float* KVC = (float*)(p.ws + WS_KVC);
    const int tid = threadIdx.x;
    for (int u = blockIdx.x; u < 16 * 32 * 32; u += gridDim.x) {
        const int bh = u >> 10, c = (u >> 5) & 31, eb = u & 31; const int b = bh >> 2, h = bh & 3;
        const int e = eb * 4 + (tid >> 7), d = tid & 127; const float lg = (float)ret_loggamma(h);
        const bf16_t* base = Y + ((size_t)b * SEQ + c * 128) * LDY;
        float acc = 0.f;
        for (int m = 0; m < 128; ++m) { const float z = __expf((float)(127 - m) * lg) * 0.08838834764831845f;
            acc += bf2f(base[(size_t)m * LDY + Y_KR + h * 128 + d]) * z * bf2f(base[(size_t)m * LDY + Y_VR + h * 128 + e]); }
        KVC[((size_t)(bh * 32 + c) * 128 + e) * 128 + d] = acc;
    }
}
DI void st_scan(const Params& p, int l) {
    const float* KVC = (const float*)(p.ws + WS_KVC); float* ST = (float*)(p.ws + WS_STATE);
    for (size_t i = (size_t)blockIdx.x * blockDim.x + threadIdx.x; i < (size_t)16 * 16384; i += (size_t)gridDim.x * blockDim.x) {
        const int bh = (int)(i >> 14), ed = (int)(i & 16383); const float cd = (float)exp(128.0 * ret_loggamma(bh & 3));
        float st = 0.f;
        for (int c = 0; c < 32; ++c) { const size_t o = (size_t)(bh * 32 + c) * 16384 + ed; ST[o] = st; st = st * cd + KVC[o]; }
    }
}
DI void st_retout(const Params& p, int l, unsigned char* smem) {
    const bf16_t* Y = (const bf16_t*)(p.ws + WS_Y); const float* ST = (const float*)(p.ws + WS_STATE); bf16_t* YM = (bf16_t*)(p.ws + WS_YMIX);
    const int lane = threadIdx.x & 63, wave = threadIdx.x >> 6;
    float* q = (float*)smem + wave * 256; float* sc = q + 128;
    for (int u = blockIdx.x; u < 16 * 512; u += gridDim.x) {
        const int bh = u >> 9, b = bh >> 2, h = bh & 3, tt = (u & 511) * 8 + wave, c = tt >> 7, n = tt & 127;
        const float lg = (float)ret_loggamma(h);
        const bf16_t* yrow = Y + ((size_t)b * SEQ + tt) * LDY;
        q[lane] = bf2f(yrow[Y_QR + h * 128 + lane]); q[lane + 64] = bf2f(yrow[Y_QR + h * 128 + lane + 64]);
        LDS_WAIT();
        const bf16_t* cb = Y + ((size_t)b * SEQ + c * 128) * LDY;
        for (int m = lane; m < 128; m += 64) { float s = 0.f;
            if (m <= n) { const bf16_t* kr = cb + (size_t)m * LDY + Y_KR + h * 128; _Pragma("unroll 8") for (int d = 0; d < 128; ++d) s += q[d] * bf2f(kr[d]);
                s *= 0.08838834764831845f * __expf((float)(n - m) * lg); }
            sc[m] = s; }
        LDS_WAIT();
        float o[2];
#pragma unroll
        for (int j = 0; j < 2; ++j) { const int e = lane + 64 * j; float a = 0.f;
            _Pragma("unroll 4") for (int m = 0; m <= n; ++m) a += sc[m] * bf2f(cb[(size_t)m * LDY + Y_VR + h * 128 + e]);
            const float* sr = ST + (size_t)(bh * 32 + c) * 16384 + (size_t)e * 128; float in = 0.f;
            _Pragma("unroll 8") for (int d = 0; d < 128; ++d) in += q[d] * sr[d];
            o[j] = a + __expf((float)(n + 1) * lg) * in; }
        const float r = rsqrtf(wave_sum(o[0] * o[0] + o[1] * o[1]) * (1.f / 128.f) + EPS);
#pragma unroll
        for (int j = 0; j < 2; ++j) { const int e = lane + 64 * j; const float gr = bf2f(yrow[Y_GR + h * 128 + e]);
            YM[((size_t)b * SEQ + tt) * DM + 1536 + h * 128 + e] = f2bf(silu_f(gr) * (o[j] * r * p.ret_g[(size_t)l * 512 + h * 128 + e])); }
        LDS_WAIT();
    }
}

DI void st_cmpattn(const Params& p, int l, unsigned char* smem) {
    const bf16_t* Y = (const bf16_t*)(p.ws + WS_Y); const bf16_t* KC = (const bf16_t*)(p.ws + WS_KC); const bf16_t* VC = (const bf16_t*)(p.ws + WS_VC);
    float* OC = (float*)(p.ws + WS_OCMP); unsigned long long* SEL = (unsigned long long*)(p.ws + WS_SEL);
    const int lane = threadIdx.x & 63, wave = threadIdx.x >> 6;
    float* q = (float*)smem + wave * 384; float* pp = q + 128;
    float* impw = (float*)smem + 8 * 384;
    float* val = impw + 8 * 64;
    for (int u = blockIdx.x; u < NB * 2 * (SEQ / 2); u += gridDim.x) {
        const int bg = u / (SEQ / 2), b = bg >> 1, g = bg & 1, tt = (u % (SEQ / 2)) * 2 + (wave >> 2), r = wave & 3, h = g * 4 + r;
        const bf16_t* yrow = Y + ((size_t)b * SEQ + tt) * LDY;
        q[lane] = bf2f(yrow[Y_QN + h * 128 + lane]); q[lane + 64] = bf2f(yrow[Y_QN + h * 128 + lane + 64]);
        LDS_WAIT();
        int ncv = tt >= 31 ? (tt - 31) / 16 + 1 : 0; if (ncv > NCMP) ncv = NCMP;
        float s[4]; float mx = -3.0e38f;
#pragma unroll
        for (int i = 0; i < 4; ++i) { const int c = lane + 64 * i; s[i] = -3.0e38f;
            if (c < ncv) { const bf16_t* kr = KC + ((size_t)bg * 256 + c) * 128; float a = 0.f; for (int d = 0; d < 128; ++d) a += q[d] * bf2f(kr[d]); s[i] = a * 0.08838834764831845f; mx = fmaxf(mx, s[i]); } }
        mx = wave_max(mx); float sum = 0.f;
#pragma unroll
        for (int i = 0; i < 4; ++i) { const int c = lane + 64 * i; s[i] = (c < ncv) ? __expf(s[i] - mx) : 0.f; sum += s[i]; }
        sum = wave_sum(sum); const float inv = ncv > 0 ? 1.f / sum : 0.f;
#pragma unroll
        for (int i = 0; i < 4; ++i) pp[lane + 64 * i] = s[i] * inv;
        LDS_WAIT();
#pragma unroll
        for (int j = 0; j < 2; ++j) { const int d = lane + 64 * j; float a = 0.f;
            for (int c = 0; c < ncv; ++c) a += pp[c] * bf2f(VC[((size_t)bg * 256 + c) * 128 + d]);
            OC[((size_t)b * SEQ + tt) * 1024 + h * 128 + d] = a; }
        { const int j = lane; float im = pp[4 * j] + pp[4 * j + 1] + pp[4 * j + 2] + 0.5f * ((j > 0 ? pp[4 * j - 1] : 0.f) + pp[4 * j + 3]);
          impw[wave * 64 + j] = im; }
        __syncthreads();
        if (r == 0) { const int j = lane, jq = tt >> 6, w0 = wave; const float im = impw[w0 * 64 + j] + impw[(w0 + 1) * 64 + j] + impw[(w0 + 2) * 64 + j] + impw[(w0 + 3) * 64 + j];
            const bool forced = (j == 0) || (j == jq) || (j == jq - 1);
            const float v = forced ? 1.0e4f : (j <= jq ? im : -1.f);
            float* vv = val + (wave >> 2) * 64; vv[j] = v; LDS_WAIT();
            int rank = 0; for (int jj = 0; jj < 64; ++jj) { const float o = vv[jj]; rank += (o > v || (o == v && jj < j)) ? 1 : 0; }
            const unsigned long long m = __ballot(rank < 16);
            if (lane == 0) SEL[(size_t)bg * SEQ + tt] = m; }
        __syncthreads();
    }
}

DI void st_slcwin(const Params& p, int l, unsigned char* smem) {
    const bf16_t* Y = (const bf16_t*)(p.ws + WS_Y); const float* OC = (const float*)(p.ws + WS_OCMP); const unsigned long long* SEL = (const unsigned long long*)(p.ws + WS_SEL);
    bf16_t* YM = (bf16_t*)(p.ws + WS_YMIX);
    const int lane = threadIdx.x & 63, wave = threadIdx.x >> 6;
    float* q = (float*)smem + wave * (128 + 1024); float* sc = q + 128;
    for (int u = blockIdx.x; u < NB * 2 * (SEQ / 2); u += gridDim.x) {
        const int bg = u / (SEQ / 2), b = bg >> 1, g = bg & 1, tt = (u % (SEQ / 2)) * 2 + (wave >> 2), r = wave & 3, h = g * 4 + r, jq = tt >> 6;
        const bf16_t* yb = Y + (size_t)b * SEQ * LDY; const bf16_t* yrow = yb + (size_t)tt * LDY;
        q[lane] = bf2f(yrow[Y_QN + h * 128 + lane]); q[lane + 64] = bf2f(yrow[Y_QN + h * 128 + lane + 64]);
        LDS_WAIT();
        float ob[2][2];
        { const unsigned long long sel = SEL[(size_t)bg * SEQ + tt]; const int kof = Y_KV + 1 * 512 + g * 128, vof = kof + 256;
          int nb = 0; float mx = -3.0e38f;
          for (int j = 0; j <= jq; ++j) if ((sel >> j) & 1ull) { const int key = j * 64 + lane; float sv = -3.0e38f;
              if (key <= tt) { const bf16_t* kr = yb + (size_t)key * LDY + kof; float a = 0.f; for (int d = 0; d < 128; ++d) a += q[d] * bf2f(kr[d]); sv = a * 0.08838834764831845f; mx = fmaxf(mx, sv); }
              sc[nb * 64 + lane] = sv; ++nb; }
          mx = wave_max(mx); float sum = 0.f;
          for (int i = 0; i < nb; ++i) { const float sv = sc[i * 64 + lane]; const float e = sv > -1.0e38f ? __expf(sv - mx) : 0.f; sc[i * 64 + lane] = e; sum += e; }
          sum = wave_sum(sum); const float inv = 1.f / sum;
          LDS_WAIT();
          float a0 = 0.f, a1 = 0.f; int i = 0;
          for (int j = 0; j <= jq; ++j) if ((sel >> j) & 1ull) { const int kmax = (j == jq) ? (tt - j * 64) : 63;
              for (int k = 0; k <= kmax; ++k) { const float pv = sc[i * 64 + k]; const bf16_t* vr = yb + (size_t)(j * 64 + k) * LDY + vof; a0 += pv * bf2f(vr[lane]); a1 += pv * bf2f(vr[lane + 64]); }
              ++i; }
          ob[0][0] = a0 * inv; ob[0][1] = a1 * inv; LDS_WAIT(); }
        { const int kof = Y_KV + 2 * 512 + g * 128, vof = kof + 256; const int k0 = tt >= 511 ? tt - 511 : 0, nk = tt - k0 + 1;
          float mx = -3.0e38f;
          for (int i = lane; i < nk; i += 64) { const bf16_t* kr = yb + (size_t)(k0 + i) * LDY + kof; float a = 0.f; for (int d = 0; d < 128; ++d) a += q[d] * bf2f(kr[d]);
              a *= 0.08838834764831845f; sc[i] = a; mx = fmaxf(mx, a); }
          mx = wave_max(mx); float sum = 0.f;
          for (int i = lane; i < nk; i += 64) { const float e = __expf(sc[i] - mx); sc[i] = e; sum += e; }
          sum = wave_sum(sum); const float inv = 1.f / sum;
          LDS_WAIT();
          float a0 = 0.f, a1 = 0.f;
          for (int i = 0; i < nk; ++i) { const float pv = sc[i]; const bf16_t* vr = yb + (size_t)(k0 + i) * LDY + vof; a0 += pv * bf2f(vr[lane]); a1 += pv * bf2f(vr[lane + 64]); }
          ob[1][0] = a0 * inv; ob[1][1] = a1 * inv; LDS_WAIT(); }
        const float g0 = sigmoid_f(bf2f(yrow[Y_GATE + h * 3 + 0])), g1 = sigmoid_f(bf2f(yrow[Y_GATE + h * 3 + 1])), g2 = sigmoid_f(bf2f(yrow[Y_GATE + h * 3 + 2]));
        float o[2];
#pragma unroll
        for (int j = 0; j < 2; ++j) o[j] = g0 * OC[((size_t)b * SEQ + tt) * 1024 + h * 128 + lane + 64 * j] + g1 * ob[0][j] + g2 * ob[1][j];
        const float rr = rsqrtf(wave_sum(o[0] * o[0] + o[1] * o[1]) * (1.f / 128.f) + EPS);
#pragma unroll
        for (int j = 0; j < 2; ++j) YM[((size_t)b * SEQ + tt) * DM + 512 + h * 128 + lane + 64 * j] = f2bf(o[j] * rr * p.nsa_g[(size_t)l * 1024 + h * 128 + lane + 64 * j]);
    }
}

DI void st_outproj(const Params& p, int l, const float* xin, unsigned char* smem) {
    const bf16_t* YM = (const bf16_t*)(p.ws + WS_YMIX); const bf16_t* W = wl_ptr(p, l, WL_WOUT); float* X1 = (float*)(p.ws + WS_X1);
    for (int u = blockIdx.x; u < (NT / 128) * 16; u += gridDim.x) {
        const int mt = u >> 4, nt = u & 15; const int b = (mt * 128) / SEQ; const float* g1 = mod_ptr(p, l, b, 2) + nt * 128;
        const float* xi = xin + (size_t)mt * 128 * DM + nt * 128; float* xo = X1 + (size_t)mt * 128 * DM + nt * 128;
        sgemm_tile(smem, YM + (size_t)mt * 128 * DM, DM, 128, 128, W + (size_t)nt * 128 * DM, DM, DM, [&](int r, int c, float v) { xo[(size_t)r * DM + c] = xi[(size_t)r * DM + c] + g1[c] * v; });
    }
}

DI void st_router(const Params& p, int l, unsigned char* smem) {
    const bf16_t* H = (const bf16_t*)(p.ws + WS_H); const bf16_t* HLO = (const bf16_t*)(p.ws + WS_HLO);
    int* TOPE = (int*)(p.ws + WS_TOPE); float* TOPW = (float*)(p.ws + WS_TOPW); int* RANK = (int*)(p.ws + WS_RANK); unsigned* CNT = (unsigned*)(p.ws + WS_CTL) + CW_CNT + l * 64;
    const int lane = threadIdx.x & 63, wave = threadIdx.x >> 6;
    float* hr = (float*)smem + wave * DM; const float* rw = p.router_w + (size_t)l * DM * 64;
    for (int t = blockIdx.x * 8 + wave; t < NT; t += gridDim.x * 8) {
        for (int k = lane; k < DM; k += 64) hr[k] = bf2f(H[(size_t)t * DM + k]) + bf2f(HLO[(size_t)t * DM + k]);
        LDS_WAIT();
        float a0 = 0.f, a1 = 0.f, a2 = 0.f, a3 = 0.f;
        for (int k = 0; k < DM; k += 4) { a0 += hr[k] * rw[(size_t)k * 64 + lane]; a1 += hr[k + 1] * rw[(size_t)(k + 1) * 64 + lane]; a2 += hr[k + 2] * rw[(size_t)(k + 2) * 64 + lane]; a3 += hr[k + 3] * rw[(size_t)(k + 3) * 64 + lane]; }
        const float score = sigmoid_f((a0 + a1) + (a2 + a3)); const float biased = score + p.router_bias[l * 64 + lane];
        int rk = 0; const int gb = lane & ~7;
#pragma unroll
        for (int j = 0; j < 8; ++j) { const float o = __shfl(biased, gb + j); rk += (o > biased || (o == biased && (gb + j) < lane)) ? 1 : 0; }
        float gsum = rk < 2 ? biased : 0.f; gsum += __shfl_xor(gsum, 1); gsum += __shfl_xor(gsum, 2); gsum += __shfl_xor(gsum, 4);
        int grk = 0; const int myg = lane >> 3;
#pragma unroll
        for (int gg = 0; gg < 8; ++gg) { const float o = __shfl(gsum, gg * 8); grk += (o > gsum || (o == gsum && gg < myg)) ? 1 : 0; }
        const float masked = grk < 4 ? biased : -__builtin_inff();
        int erk = 0;
        for (int j = 0; j < 64; ++j) { const float o = __shfl(masked, j); erk += (o > masked || (o == masked && j < lane)) ? 1 : 0; }
        const bool selx = erk < 8; const float wsum = wave_sum(selx ? score : 0.f);
        if (selx) { const unsigned rr = atomicAdd(CNT + lane, 1u);
            TOPE[(size_t)t * 8 + erk] = lane; TOPW[(size_t)t * 8 + erk] = 2.5f * score / wsum; RANK[(size_t)t * 8 + erk] = (int)rr; }
        LDS_WAIT();
    }
}
DI void pad_offsets(const unsigned* CNT, int* po) {
    if (threadIdx.x == 0) { int a = 0; for (int e = 0; e < 64; ++e) { po[e] = a; a += (int)((CNT[e] + 255u) / 256u) * 256; } po[64] = a; }
    __syncthreads();
}
DI void st_scatter(const Params& p, int l, unsigned char* smem) {
    const bf16_t* H = (const bf16_t*)(p.ws + WS_H); bf16_t* XS = (bf16_t*)(p.ws + WS_XS);
    const int* TOPE = (const int*)(p.ws + WS_TOPE); const int* RANK = (const int*)(p.ws + WS_RANK); int* SLOT = (int*)(p.ws + WS_SLOT);
    const unsigned* CNT = (const unsigned*)(p.ws + WS_CTL) + CW_CNT + l * 64;
    int* po = (int*)smem; pad_offsets(CNT, po);
    const int lane = threadIdx.x & 63, wave = threadIdx.x >> 6;
    for (int t = blockIdx.x; t < NT; t += gridDim.x) {
        const int slot = po[TOPE[(size_t)t * 8 + wave]] + RANK[(size_t)t * 8 + wave];
        if (lane == 0) SLOT[(size_t)t * 8 + wave] = slot;
        const uint4* src = (const uint4*)(H + (size_t)t * DM); uint4* dst = (uint4*)(XS + (size_t)slot * DM);
#pragma unroll
        for (int j = 0; j < 4; ++j) dst[j * 64 + lane] = src[j * 64 + lane];
    }
}
DI int blk_expert(const int* po, int blk) { int e = 0; while (e < 63 && po[e + 1] <= blk * 256) ++e; return e; }
DI void st_gemm1(const Params& p, int l, unsigned char* smem) {
    const bf16_t* H = (const bf16_t*)(p.ws + WS_H); const bf16_t* XS = (const bf16_t*)(p.ws + WS_XS); bf16_t* GU = (bf16_t*)(p.ws + WS_GU);
    const unsigned* CNT = (const unsigned*)(p.ws + WS_CTL) + CW_CNT + l * 64;
    int* po = (int*)(smem + 32768); pad_offsets(CNT, po);
    const int nblk = po[64] / 256; const int nu_r = nblk * 16, nu_s = (NT / 128) * 8;
    for (int u = blockIdx.x; u < nu_r + nu_s; u += gridDim.x) {
        const bf16_t* A; const bf16_t* W; bf16_t* out;
        if (u < nu_r) { const int blk = u >> 4, mh = (u >> 3) & 1, nt = u & 7, e = blk_expert(po, blk); const size_t row0 = (size_t)blk * 256 + mh * 128;
            A = XS + row0 * DM; W = wl_ptr(p, l, WL_EGU) + ((size_t)e * 1024 + nt * 128) * DM; out = GU + row0 * 1024 + nt * 128; }
        else { const int v = u - nu_r, mt = v >> 3, nt = v & 7; A = H + (size_t)mt * 128 * DM; W = wl_ptr(p, l, WL_EGU) + ((size_t)64 * 1024 + nt * 128) * DM; out = GU + ((size_t)NSLOT + mt * 128) * 1024 + nt * 128; }
        sgemm_tile(smem, A, DM, 128, 128, W, DM, DM, [&](int r, int c, float v) { out[(size_t)r * 1024 + c] = f2bf(v); });
    }
}
DI void st_act(const Params& p, int l, unsigned char* smem) {
    const bf16_t* GU = (const bf16_t*)(p.ws + WS_GU); bf16_t* ACT = (bf16_t*)(p.ws + WS_ACT);
    const unsigned* CNT = (const unsigned*)(p.ws + WS_CTL) + CW_CNT + l * 64;
    int* po = (int*)smem; pad_offsets(CNT, po); const size_t nr = (size_t)po[64];
    for (size_t i = (size_t)blockIdx.x * blockDim.x + threadIdx.x; i < (nr + NT) * 512; i += (size_t)gridDim.x * blockDim.x) {
        size_t row = i >> 9; const int j = (int)(i & 511); if (row >= nr) row = row - nr + NSLOT;
        const int pn = j >> 7, jj = j & 127; const float g = bf2f(GU[row * 1024 + pn * 256 + jj]), uu = bf2f(GU[row * 1024 + pn * 256 + 128 + jj]);
        ACT[row * 512 + j] = f2bf(silu_f(g) * uu);
    }
}
DI void st_gemm2(const Params& p, int l, unsigned char* smem) {
    const bf16_t* ACT = (const bf16_t*)(p.ws + WS_ACT); bf16_t* YS = (bf16_t*)(p.ws + WS_YS);
    const unsigned* CNT = (const unsigned*)(p.ws + WS_CTL) + CW_CNT + l * 64;
    int* po = (int*)(smem + 32768); pad_offsets(CNT, po);
    const int nblk = po[64] / 256; const int nu_r = nblk * 32, nu_s = (NT / 128) * 16;
    for (int u = blockIdx.x; u < nu_r + nu_s; u += gridDim.x) {
        size_t row0; int e, nt;
        if (u < nu_r) { const int blk = u >> 5, mh = (u >> 4) & 1; nt = u & 15; e = blk_expert(po, blk); row0 = (size_t)blk * 256 + mh * 128; }
        else { const int v = u - nu_r; nt = v & 15; e = 64; row0 = (size_t)NSLOT + (size_t)(v >> 4) * 128; }
        bf16_t* out = YS + row0 * DM + nt * 128;
        sgemm_tile(smem, ACT + row0 * 512, 512, 128, 128, wl_ptr(p, l, WL_EDN) + ((size_t)e * DM + nt * 128) * 512, 512, 512, [&](int r, int c, float v) { out[(size_t)r * DM + c] = f2bf(v); });
    }
}
DI void st_combine(const Params& p, int l) {
    const bf16_t* YS = (const bf16_t*)(p.ws + WS_YS); const float* X1 = (const float*)(p.ws + WS_X1); float* X2 = (float*)(p.ws + WS_X2);
    const int* SLOT = (const int*)(p.ws + WS_SLOT); const float* TOPW = (const float*)(p.ws + WS_TOPW);
    const int lane = threadIdx.x & 63, wave = threadIdx.x >> 6;
    for (int t = blockIdx.x * 8 + wave; t < NT; t += gridDim.x * 8) {
        const int b = t / SEQ; float4 acc[8];
        { const bf16_t* ys = YS + ((size_t)NSLOT + t) * DM;
#pragma unroll
          for (int j = 0; j < 8; ++j) { const uint2 w = *(const uint2*)(ys + (j * 64 + lane) * 4);
              acc[j] = make_float4(__uint_as_float(w.x << 16), __uint_as_float(w.x & 0xffff0000u), __uint_as_float(w.y << 16), __uint_as_float(w.y & 0xffff0000u)); } }
        for (int k = 0; k < 8; ++k) { const int slot = SLOT[(size_t)t * 8 + k]; const float wk = TOPW[(size_t)t * 8 + k]; const bf16_t* ys = YS + (size_t)slot * DM;
#pragma unroll
            for (int j = 0; j < 8; ++j) { const uint2 w = *(const uint2*)(ys + (j * 64 + lane) * 4);
                acc[j].x += wk * __uint_as_float(w.x << 16); acc[j].y += wk * __uint_as_float(w.x & 0xffff0000u); acc[j].z += wk * __uint_as_float(w.y << 16); acc[j].w += wk * __uint_as_float(w.y & 0xffff0000u); } }
        const float* g2 = mod_ptr(p, l, b, 5); float4 v[8];
#pragma unroll
        for (int j = 0; j < 8; ++j) { const int e = (j * 64 + lane) * 4; const float4 x1 = *(const float4*)(X1 + (size_t)t * DM + e), gg = *(const float4*)(g2 + e);
            v[j] = make_float4(x1.x + gg.x * acc[j].x, x1.y + gg.y * acc[j].y, x1.z + gg.z * acc[j].z, x1.w + gg.w * acc[j].w); }
        if (l + 1 < NL) {
#pragma unroll
            for (int j = 0; j < 8; ++j) *(float4*)(X2 + (size_t)t * DM + (j * 64 + lane) * 4) = v[j];
            norm_row_store(v, lane, p.norm1_g + (size_t)(l + 1) * DM, mod_ptr(p, l + 1, b, 1), mod_ptr(p, l + 1, b, 0), (bf16_t*)(p.ws + WS_H) + (size_t)t * DM, nullptr);
        } else {
            float ss = 0.f;
#pragma unroll
            for (int j = 0; j < 8; ++j) ss += v[j].x * v[j].x + v[j].y * v[j].y + v[j].z * v[j].z + v[j].w * v[j].w;
            const float r = rsqrtf(wave_sum(ss) * (1.f / DM) + EPS);
#pragma unroll
            for (int j = 0; j < 8; ++j) { const int e = (j * 64 + lane) * 4; const float4 gg = *(const float4*)(p.final_g + e);
                *(float4*)(p.out + (size_t)t * DM + e) = make_float4(v[j].x * r * gg.x, v[j].y * r * gg.y, v[j].z * r * gg.z, v[j].w * r * gg.w); }
        }
    }
}

enum { ST_CONVERT = 0, ST_MOD, ST_NORM1, ST_INPROJ, ST_POST, ST_CMP1, ST_CMP2, ST_KVCHUNK, ST_SCAN, ST_CMPATTN, ST_SLCWIN, ST_RETOUT, ST_OUTPROJ, ST_NORM2, ST_ROUTER, ST_SCATTER, ST_GEMM1, ST_ACT, ST_GEMM2, ST_COMBINE };
template <int ST> __global__ void __launch_bounds__(512) k_stage(Params p, int l) {
    extern __shared__ __attribute__((aligned(16))) unsigned char smem[];
    const float* xin = l == 0 ? p.x : (const float*)(p.ws + WS_X2);
    if constexpr (ST == ST_CONVERT) st_convert(p, smem);
    if constexpr (ST == ST_MOD) st_mod(p, smem);
    if constexpr (ST == ST_NORM1) st_norm(p, l, xin, 0);
    if constexpr (ST == ST_INPROJ) st_inproj(p, l, smem);
    if constexpr (ST == ST_POST) st_post(p, l);
    if constexpr (ST == ST_CMP1) st_cmp1(p, l, smem);
    if constexpr (ST == ST_CMP2) st_cmp2(p, l, smem);
    if constexpr (ST == ST_KVCHUNK) st_kvchunk(p, l);
    if constexpr (ST == ST_SCAN) st_scan(p, l);
    if constexpr (ST == ST_CMPATTN) st_cmpattn(p, l, smem);
    if constexpr (ST == ST_SLCWIN) st_slcwin(p, l, smem);
    if constexpr (ST == ST_RETOUT) st_retout(p, l, smem);
    if constexpr (ST == ST_OUTPROJ) st_outproj(p, l, xin, smem);
    if constexpr (ST == ST_NORM2) st_norm(p, l, (const float*)(p.ws + WS_X1), 1);
    if constexpr (ST == ST_ROUTER) st_router(p, l, smem);
    if constexpr (ST == ST_SCATTER) st_scatter(p, l, smem);
    if constexpr (ST == ST_GEMM1) st_gemm1(p, l, smem);
    if constexpr (ST == ST_ACT) st_act(p, l, smem);
    if constexpr (ST == ST_GEMM2) st_gemm2(p, l, smem);
    if constexpr (ST == ST_COMBINE) st_combine(p, l);
}
constexpr int SMEM_BYTES = 96 * 1024;
template <int ST> static void launch(const Params& p, int l, int grid, hipStream_t s) {
    static bool attr = false;
    if (!attr) { (void)hipFuncSetAttribute((const void*)k_stage<ST>, hipFuncAttributeMaxDynamicSharedMemorySize, SMEM_BYTES); attr = true; }
    hipLaunchKernelGGL((k_stage<ST>), dim3(grid), dim3(512), SMEM_BYTES, s, p, l);
}

extern "C" void kernel_launch(void* const* d_in, const int* in_sizes, int n_in, void* d_out, int out_size, void* d_ws, size_t ws_size, hipStream_t stream) {
    if (n_in != 23 || ws_size < WS_END) { fprintf(stderr, "kernel_launch: unexpected n_in %d or ws_size %zu < %zu\n", n_in, ws_size, (size_t)WS_END); return; }
    Params p; memset(&p, 0, sizeof(p));
    p.x = (const float*)d_in[0]; p.c = (const float*)d_in[1]; p.pos = (const int*)d_in[2];
    p.ada_w = (const float*)d_in[3]; p.ada_b = (const float*)d_in[4]; p.norm1_g = (const float*)d_in[5]; p.norm2_g = (const float*)d_in[6]; p.w_in = (const float*)d_in[7];
    p.conv_w = (const float*)d_in[8]; p.conv_g = (const float*)d_in[9]; p.cmp_pe = (const float*)d_in[10]; p.cmp_w1 = (const float*)d_in[11]; p.cmp_w2 = (const float*)d_in[12];
    p.nsa_g = (const float*)d_in[13]; p.ret_g = (const float*)d_in[14]; p.w_out = (const float*)d_in[15]; p.router_w = (const float*)d_in[16]; p.router_bias = (const float*)d_in[17];
    p.exp_w_gu = (const float*)d_in[18]; p.exp_w_down = (const float*)d_in[19]; p.shared_w_gu = (const float*)d_in[20]; p.shared_w_down = (const float*)d_in[21]; p.final_g = (const float*)d_in[22];
    p.out = (float*)d_out; p.ws = (unsigned char*)d_ws;
    (void)hipMemsetAsync((char*)d_ws + WS_CTL, 0, 1 * MiB, stream);
    const int G = 2048;
    launch<ST_CONVERT>(p, 0, G, stream);
    launch<ST_MOD>(p, 0, 192, stream);
    launch<ST_NORM1>(p, 0, G, stream);
    for (int l = 0; l < NL; ++l) {
        launch<ST_INPROJ>(p, l, G, stream);
        launch<ST_POST>(p, l, G, stream);
        launch<ST_CMP1>(p, l, 64, stream);
        launch<ST_CMP2>(p, l, 32, stream);
        launch<ST_KVCHUNK>(p, l, G, stream);
        launch<ST_SCAN>(p, l, 512, stream);
        launch<ST_CMPATTN>(p, l, G, stream);
        launch<ST_SLCWIN>(p, l, G, stream);
        launch<ST_RETOUT>(p, l, G, stream);
        launch<ST_OUTPROJ>(p, l, G, stream);
        launch<ST_NORM2>(p, l, G, stream);
        launch<ST_ROUTER>(p, l, G, stream);
        launch<ST_SCATTER>(p, l, G, stream);
        launch<ST_GEMM1>(p, l, G, stream);
        launch<ST_ACT>(p, l, G, stream);
        launch<ST_GEMM2>(p, l, G, stream);
        launch<ST_COMBINE>(p, l, G, stream);
    }
}
```

```cpp
#include <hip/hip_runtime.h>
#include <stdint.h>
#include <stdio.h>
#include <string.h>
#ifndef MK_PROBE
#define MK_PROBE 0
#endif

typedef unsigned short bf16_t;
#define DI __device__ __forceinline__
#define LDS_WAIT() asm volatile("s_waitcnt lgkmcnt(0)" ::: "memory")

constexpr int NB = 4, SEQ = 4096, DM = 2048, NT = NB * SEQ, NL = 2;
constexpr int HD = 128;
constexpr int D_IN = 6168, LDY = 6400;
constexpr int Y_CB = 0, Y_CC = 512, Y_CU = 1024, Y_QN = 1536, Y_KV = 2560, Y_QR = 4096, Y_KR = 4608, Y_VR = 5120, Y_GR = 5632, Y_GATE = 6144;
constexpr int NEXP = 64, TOPK = 8, DEXP = 512;
constexpr int NSLOT = 576 * 256;
constexpr int NROWS_E = NSLOT + NT;
constexpr float EPS = 1e-6f;
constexpr int NCMP = 255;

constexpr size_t MiB = 1ull << 20;
constexpr size_t WS_CTL = 0;
constexpr size_t WS_MOD = 1 * MiB;
constexpr size_t WS_CMPB = WS_MOD + 512 * 1024;
constexpr size_t WS_W = 2 * MiB;
constexpr size_t WL_WIN = 0;
constexpr size_t WL_WOUT = WL_WIN + (size_t)LDY * DM * 2;
constexpr size_t WL_CW1 = WL_WOUT + (size_t)DM * DM * 2;
constexpr size_t WL_CW2 = WL_CW1 + (size_t)2 * 256 * 4096 * 2;
constexpr size_t WL_RTH = WL_CW2 + (size_t)2 * 128 * 256 * 2;
constexpr size_t WL_RTL = WL_RTH + (size_t)64 * DM * 2;
constexpr size_t WL_RTZ = WL_RTL + (size_t)64 * DM * 2;
constexpr size_t WL_EGU = WL_RTZ + (size_t)128 * DM * 2;
constexpr size_t WL_EDN = WL_EGU + (size_t)65 * 1024 * DM * 2;
constexpr size_t WL_END = WL_EDN + (size_t)65 * DM * 512 * 2;
constexpr size_t WL_STRIDE = 429 * MiB;
static_assert(WL_END <= WL_STRIDE, "layer weights");
constexpr size_t WS_H = WS_W + NL * WL_STRIDE;
constexpr size_t WS_HLO = WS_H + (size_t)NT * DM * 2;
constexpr size_t WS_Y = WS_HLO + (size_t)NT * DM * 2;
constexpr size_t WS_YMIX = WS_Y + (size_t)NT * LDY * 2;
constexpr size_t WS_X1 = WS_YMIX + (size_t)NT * DM * 2;
constexpr size_t WS_X2 = WS_X1 + (size_t)NT * DM * 4;
constexpr size_t WS_OCMP = WS_X2 + (size_t)NT * DM * 4;
constexpr size_t WS_SEL = WS_OCMP + (size_t)NT * 1024 * 4;
constexpr size_t WS_HID = WS_SEL + (size_t)NB * 2 * SEQ * 8;
constexpr size_t WS_KC = WS_HID + (size_t)2 * 8 * 256 * 256 * 2;
constexpr size_t WS_VC = WS_KC + (size_t)8 * 256 * 128 * 2;
constexpr size_t WS_KVC = WS_VC + (size_t)8 * 256 * 128 * 2;
constexpr size_t WS_STATE = WS_KVC + (size_t)16 * 32 * 16384 * 4;
constexpr size_t WS_TOPE = WS_STATE + (size_t)16 * 32 * 16384 * 4;
constexpr size_t WS_TOPW = WS_TOPE + (size_t)NT * 8 * 4;
constexpr size_t WS_RANK = WS_TOPW + (size_t)NT * 8 * 4;
constexpr size_t WS_SLOT = WS_RANK + (size_t)NT * 8 * 4;
constexpr size_t WS_XS = WS_SLOT + (size_t)NT * 8 * 4;
constexpr size_t WS_GU = WS_XS + (size_t)NSLOT * DM * 2;
constexpr size_t WS_ACT = WS_GU + (size_t)NROWS_E * 1024 * 2;
constexpr size_t WS_YS = WS_ACT + (size_t)NROWS_E * 512 * 2;
constexpr size_t WS_VT = WS_YS + (size_t)NROWS_E * DM * 2;
constexpr size_t WS_STATEB = WS_VT + (size_t)NB * 2 * 2 * 128 * SEQ * 2;
constexpr size_t WS_PART = WS_STATEB + (size_t)16 * 32 * 16384 * 2;
constexpr size_t WS_TOKOF = WS_PART + (size_t)NT * 1024 * 4;
constexpr size_t WS_LOGP = WS_TOKOF + (size_t)NSLOT * 4;
constexpr size_t WS_CP = WS_LOGP + (size_t)4 * NT * 256 * 4;
constexpr size_t WS_GATEP = WS_CP + (size_t)4 * 16 * 256 * 256 * 4;
constexpr size_t WS_END = WS_GATEP + (size_t)2 * NT * 256 * 4;
constexpr int CW_CNT = 8192;

struct Params {
    const float *x, *c; const int* pos;
    const float *ada_w, *ada_b, *norm1_g, *norm2_g, *w_in, *conv_w, *conv_g, *cmp_pe, *cmp_w1, *cmp_w2, *nsa_g, *ret_g, *w_out,
                *router_w, *router_bias, *exp_w_gu, *exp_w_down, *shared_w_gu, *shared_w_down, *final_g;
    float* out; unsigned char* ws;
};

DI float bf2f(bf16_t b) { return __uint_as_float(((unsigned)b) << 16); }
DI bf16_t f2bf(float f) { unsigned u = __float_as_uint(f); u += 0x7fffu + ((u >> 16) & 1u); return (bf16_t)(u >> 16); }
DI unsigned pk2(float lo, float hi) { return (unsigned)f2bf(lo) | ((unsigned)f2bf(hi) << 16); }
DI float wave_sum(float v) {
#pragma unroll
    for (int o = 1; o < 64; o <<= 1) v += __shfl_xor(v, o);
    return v;
}
DI float wave_max(float v) {
#pragma unroll
    for (int o = 1; o < 64; o <<= 1) v = fmaxf(v, __shfl_xor(v, o));
    return v;
}
DI int kperm16(int k) { return (k & ~12) | ((k & 4) << 1) | ((k & 8) >> 1); }
DI float silu_f(float v) { return v / (1.f + __expf(-v)); }
DI float sigmoid_f(float v) { return 1.f / (1.f + __expf(-v)); }
DI float gelu_tanh_f(float v) { const float u = 0.7978845608028654f * (v + 0.044715f * v * v * v); return 0.5f * v * (1.f + tanhf(u)); }
DI bf16_t* wl_ptr(const Params& p, int l, size_t off) { return (bf16_t*)(p.ws + WS_W + (size_t)l * WL_STRIDE + off); }
DI float* mod_ptr(const Params& p, int l, int b, int chunk) { return (float*)(p.ws + WS_MOD) + ((size_t)(l * NB + b) * 6 + chunk) * DM; }
DI float ret_loggamma(int h) { return h == 0 ? -0.0317486983145803f : (h == 1 ? -0.015748356968139168f : (h == 2 ? -0.007843177461025893f : -0.003913899321136329f)); }
DI float ret_chunkdecay(int h) { return h == 0 ? 0.01718302357081791f : (h == 1 ? 0.13321516287964844f : (h == 2 ? 0.3664377159220373f : 0.6059370882290803f)); }

DI int opq_tid(const int WV) { unsigned z = 0u; asm volatile("" : "+v"(z)); int t = (WV << 6) | (int)__builtin_amdgcn_mbcnt_hi(~0u, __builtin_amdgcn_mbcnt_lo(~0u, z)); asm volatile("" : "+v"(t)); return t; }
DI int opq_bid() { int b = blockIdx.x; asm volatile("" : "+s"(b)); return b; }
DI int maprow(int kind, int n) {
    if (kind == 1) return n < 4096 ? n : (n < 4120 ? n + 2048 : n - 24);
    if (kind == 2) { if (n < 512) return (n >> 7) * 256 + (n & 127); const int j = n - 512; return (j >> 7) * 256 + 128 + (j & 127); }
    return n;
}
DI void tr_item(const float* __restrict__ W, int ldw, int ncols, int Kd, bf16_t* WT, int k0, int n0, int kind, float* scr, int lane) {
    const int n4 = (lane & 15) * 4, kr = lane >> 4; const bool inb = (n0 + n4) < ncols;
    float4 v[16];
#pragma unroll
    for (int i = 0; i < 16; ++i) { typedef float f4v_t __attribute__((ext_vector_type(4))); if (inb) { const f4v_t t_ = __builtin_nontemporal_load((const f4v_t*)(W + (size_t)(k0 + 4 * i + kr) * ldw + n0 + n4)); v[i] = make_float4(t_.x, t_.y, t_.z, t_.w); } else v[i] = make_float4(0.f, 0.f, 0.f, 0.f); }
#pragma unroll
    for (int i = 0; i < 16; ++i) { float* s = scr + (4 * i + kr) * 65 + n4; s[0] = v[i].x; s[1] = v[i].y; s[2] = v[i].z; s[3] = v[i].w; }
    LDS_WAIT();
    const int c = lane & 7;
#pragma unroll
    for (int j = 0; j < 8; ++j) { const int nn = (lane >> 3) + 8 * j, n = n0 + nn;
        if (n < ncols) { const float* s = scr + (8 * c) * 65 + nn;
            uint4 o; o.x = pk2(s[0 * 65], s[1 * 65]); o.y = pk2(s[2 * 65], s[3 * 65]); o.z = pk2(s[4 * 65], s[5 * 65]); o.w = pk2(s[6 * 65], s[7 * 65]);
            *(uint4*)(WT + (size_t)maprow(kind, n) * Kd + k0 + 8 * c) = o; } }
    LDS_WAIT();
}
DI void tr_job(const float* W, int ldw, int ncols, int Kd, bf16_t* WT, int kind, int r, float* scr, int lane) {
    const int nblk = (ncols + 63) / 64; const int kb = r / nblk, nb = r % nblk;
    tr_item(W, ldw, ncols, Kd, WT, kb * 64, nb * 64, kind, scr, lane);
}
DI void st_convert(const Params& p, unsigned char* smem, const int WV) {
    const int TIDX = opq_tid(WV); const int BIDX = opq_bid(); (void)TIDX; (void)BIDX;
    const int tid = TIDX, lane = tid & 63, wave = tid >> 6;
    float* scr = (float*)smem + wave * (64 * 65);
    const int gw = BIDX * 8 + wave, NGW = gridDim.x * 8;
    constexpr int I_WIN = 32 * 97, I_WOUT = 32 * 32, I_C1 = 64 * 4, I_C2 = 4 * 2, I_GU = 32 * 16, I_DN = 8 * 32;
    constexpr int PER_L = I_WIN + I_WOUT + 2 * I_C1 + 2 * I_C2 + 65 * I_GU + 65 * I_DN;
    for (int it = gw; it < NL * PER_L; it += NGW) {
        const int l = it / PER_L; int r = it % PER_L;
        if (r < I_WIN) { tr_job(p.w_in + (size_t)l * DM * D_IN, D_IN, D_IN, DM, wl_ptr(p, l, WL_WIN), 1, r, scr, lane); continue; } r -= I_WIN;
        if (r < I_WOUT) { tr_job(p.w_out + (size_t)l * DM * DM, DM, DM, DM, wl_ptr(p, l, WL_WOUT), 0, r, scr, lane); continue; } r -= I_WOUT;
        if (r < 2 * I_C1) { const int kv = r / I_C1; tr_job(p.cmp_w1 + (size_t)(l * 2 + kv) * 4096 * 256, 256, 256, 4096, wl_ptr(p, l, WL_CW1) + (size_t)kv * 256 * 4096, 0, r % I_C1, scr, lane); continue; } r -= 2 * I_C1;
        if (r < 2 * I_C2) { const int kv = r / I_C2; tr_job(p.cmp_w2 + (size_t)(l * 2 + kv) * 256 * 128, 128, 128, 256, wl_ptr(p, l, WL_CW2) + (size_t)kv * 128 * 256, 0, r % I_C2, scr, lane); continue; } r -= 2 * I_C2;
        if (r < 65 * I_GU) { const int e = r / I_GU; const float* src = e < 64 ? p.exp_w_gu + (size_t)(l * 64 + e) * DM * 1024 : p.shared_w_gu + (size_t)l * DM * 1024;
            tr_job(src, 1024, 1024, DM, wl_ptr(p, l, WL_EGU) + (size_t)e * 1024 * DM, 2, r % I_GU, scr, lane); continue; } r -= 65 * I_GU;
        { const int e = r / I_DN; const float* src = e < 64 ? p.exp_w_down + (size_t)(l * 64 + e) * 512 * DM : p.shared_w_down + (size_t)l * 512 * DM;
            tr_job(src, DM, DM, 512, wl_ptr(p, l, WL_EDN) + (size_t)e * DM * 512, 0, r % I_DN, scr, lane); }
    }
    const size_t gt = (size_t)BIDX * 512 + tid, NGT = (size_t)gridDim.x * 512;
    for (int l = 0; l < NL; ++l) {
        bf16_t* wt = wl_ptr(p, l, WL_WIN);
        for (size_t i = gt; i < (size_t)(LDY - D_IN) * DM / 8; i += NGT) ((uint4*)(wt + (size_t)D_IN * DM))[i] = make_uint4(0, 0, 0, 0);
        { uint4* rz = (uint4*)wl_ptr(p, l, WL_RTZ); for (size_t i = gt; i < (size_t)128 * DM / 8; i += NGT) rz[i] = make_uint4(0, 0, 0, 0); }
        bf16_t* rh = wl_ptr(p, l, WL_RTH); bf16_t* rl = wl_ptr(p, l, WL_RTL);
        for (size_t i = gt; i < (size_t)64 * DM; i += NGT) { const int e = (int)(i / DM), k = (int)(i % DM); const float w = p.router_w[((size_t)l * DM + k) * 64 + e];
            const bf16_t h = f2bf(w); rh[i] = h; rl[i] = f2bf(w - bf2f(h)); }
    }
    { const int ub = (int)gridDim.x - 1 - BIDX;
      if (ub < 64) {
        const int l = ub >> 5, kv = (ub >> 4) & 1, jb = (ub >> 2) & 3, ic = ub & 3;
        const float* pe = p.cmp_pe + (size_t)(l * 2 + kv) * 4096; const float* w1 = p.cmp_w1 + (size_t)(l * 2 + kv) * 4096 * 256;
        float acc = 0.f; const int j = jb * 64 + lane; const int i0 = ic * 1024 + wave * 128;
#pragma unroll 16
        for (int i = i0; i < i0 + 128; ++i) acc += pe[i] * w1[(size_t)i * 256 + j];
        __syncthreads();
        float* red = (float*)smem; red[wave * 64 + lane] = acc; __syncthreads();
        if (wave == 0) { float s = 0.f; for (int w = 0; w < 8; ++w) s += red[w * 64 + lane]; ((float*)(p.ws + WS_CMPB))[ic * 1024 + (l * 2 + kv) * 256 + j] = s; }
      } }
}

DI void st_mod(const Params& p, unsigned char* smem, const int WV) {
    const int TIDX = opq_tid(WV); const int BIDX = opq_bid(); (void)TIDX; (void)BIDX;
    const int tid = TIDX, lane = tid & 63, wave = tid >> 6;
    float* ca = (float*)smem;
    float* red = ca + 4 * DM;
    for (int i = tid; i < 4 * DM; i += 512) ca[i] = silu_f(p.c[i]);
    __syncthreads();
    for (int u = BIDX; u < NL * 96; u += gridDim.x) {
        const int l = u / 96, cb = u % 96; const int col = cb * 128 + (lane & 31) * 4;
        const float* W = p.ada_w + (size_t)l * DM * 12288;
        float acc[4][4] = {};
#pragma unroll 8
        for (int i = 0; i < 128; ++i) { const int k = 2 * (wave + 8 * i) + (lane >> 5);
            typedef float f4v_t __attribute__((ext_vector_type(4))); const f4v_t w = __builtin_nontemporal_load((const f4v_t*)(W + (size_t)k * 12288 + col));
#pragma unroll
            for (int b = 0; b < 4; ++b) { const float cv = ca[b * DM + k]; acc[b][0] += cv * w.x; acc[b][1] += cv * w.y; acc[b][2] += cv * w.z; acc[b][3] += cv * w.w; } }
#pragma unroll
        for (int b = 0; b < 4; ++b)
#pragma unroll
            for (int j = 0; j < 4; ++j) acc[b][j] += __shfl_xor(acc[b][j], 32);
        __syncthreads();
        if (lane < 32) {
#pragma unroll
            for (int b = 0; b < 4; ++b)
#pragma unroll
                for (int j = 0; j < 4; ++j) red[(wave * 4 + b) * 128 + lane * 4 + j] = acc[b][j]; }
        __syncthreads();
        { const int b = tid >> 7, cc = tid & 127; float s = 0.f;
            for (int w = 0; w < 8; ++w) s += red[(w * 4 + b) * 128 + cc];
            const int gcol = cb * 128 + cc;
            ((float*)(p.ws + WS_MOD))[(size_t)(l * NB + b) * 12288 + gcol] = s + p.ada_b[(size_t)l * 12288 + gcol]; }
    }
}

typedef float f4v_t __attribute__((ext_vector_type(4)));
#define LDSF __attribute__((address_space(3)))
DI void norm_row_store(float4 (&v)[8], int lane, const LDSF float* gs, const LDSF float* sh, bf16_t* hrow, bf16_t* lorow) {
    float ss = 0.f;
#pragma unroll
    for (int j = 0; j < 8; ++j) ss += v[j].x * v[j].x + v[j].y * v[j].y + v[j].z * v[j].z + v[j].w * v[j].w;
    const float r = rsqrtf(wave_sum(ss) * (1.f / DM) + EPS);
#pragma unroll
    for (int j = 0; j < 8; ++j) { const unsigned e = ((unsigned)j * 64u + (unsigned)lane) * 4u;
        const f4v_t gg = *(const LDSF f4v_t*)(gs + e), s0 = *(const LDSF f4v_t*)(sh + e);
        const float h0 = v[j].x * r * gg.x + s0.x, h1 = v[j].y * r * gg.y + s0.y, h2 = v[j].z * r * gg.z + s0.z, h3 = v[j].w * r * gg.w + s0.w;
        const bf16_t b0 = f2bf(h0), b1 = f2bf(h1), b2 = f2bf(h2), b3 = f2bf(h3);
        uint2 o; o.x = (unsigned)b0 | ((unsigned)b1 << 16); o.y = (unsigned)b2 | ((unsigned)b3 << 16);
        *(uint2*)(hrow + e) = o;
        if (lorow) { uint2 q; q.x = pk2(h0 - bf2f(b0), h1 - bf2f(b1)); q.y = pk2(h2 - bf2f(b2), h3 - bf2f(b3)); *(uint2*)(lorow + e) = q; } }
}
DI void norm_tables(const Params& p, int l, int which, const float* g, LDSF float* gs, LDSF float* sh, int tid) {
#pragma unroll
    for (int it = 0; it < 4 * DM / 512; ++it) { const int i = tid + it * 512; const int b = i >> 11, kk = i & (DM - 1);
        gs[i] = g[kk] * (1.f + mod_ptr(p, l, b, which * 3 + 1)[kk]); sh[i] = mod_ptr(p, l, b, which * 3 + 0)[kk]; }
}
DI void st_norm(const Params& p, int l, const float* xin, int which, unsigned char* smem, const int WV) {
    const int TIDX = opq_tid(WV); const int BIDX = opq_bid(); (void)TIDX; (void)BIDX;
    const int lane = TIDX & 63, wave = __builtin_amdgcn_readfirstlane(TIDX >> 6);
    bf16_t* H = (bf16_t*)(p.ws + WS_H); bf16_t* HLO = (bf16_t*)(p.ws + WS_HLO);
    LDSF float* gs = (LDSF float*)(LDSF unsigned char*)smem; LDSF float* sh = gs + 4 * DM;
    norm_tables(p, l, which, (which == 0 ? p.norm1_g : p.norm2_g) + (size_t)l * DM, gs, sh, TIDX);
    __syncthreads();
    for (int t = BIDX * 8 + wave; t < NT; t += gridDim.x * 8) {
        const int b = t / SEQ; float4 v[8];
#pragma unroll
        for (int j = 0; j < 8; ++j) {
            if (which) { const uint2 w = *(const uint2*)((const bf16_t*)xin + (size_t)t * DM + (j * 64 + lane) * 4);
                v[j] = make_float4(__uint_as_float(w.x << 16), __uint_as_float(w.x & 0xffff0000u), __uint_as_float(w.y << 16), __uint_as_float(w.y & 0xffff0000u)); }
            else v[j] = *(const float4*)(xin + (size_t)t * DM + (j * 64 + lane) * 4); }
        norm_row_store(v, lane, gs + b * DM, sh + b * DM, H + (size_t)t * DM, nullptr);
    }
}

template <class Epi>
DI void sgemm_tile(unsigned char* smem, const bf16_t* A, size_t lda, size_t kseg, int mvalid, const bf16_t* Bt, size_t ldb, int K, const Epi& epi, const int WV) {
    const int TIDX = opq_tid(WV); const int BIDX = opq_bid(); (void)TIDX; (void)BIDX;
    float* As = (float*)smem; float* Bs = As + 16 * 132;
    const int tid = TIDX, tx = tid & 31, ty = tid >> 5;
    const int lr = tid >> 2, lk = (tid & 3) * 4;
    const int ar = lr < mvalid ? lr : mvalid - 1;
    float acc[8][4] = {};
    for (int k0 = 0; k0 < K; k0 += 16) {
        const int k = k0 + lk;
        const uint2 av = *(const uint2*)(A + (size_t)ar * lda + (size_t)(k >> 7) * kseg + (k & 127));
        const uint2 bv = *(const uint2*)(Bt + (size_t)lr * ldb + k);
        __syncthreads();
        As[(lk + 0) * 132 + lr] = __uint_as_float(av.x << 16); As[(lk + 1) * 132 + lr] = __uint_as_float(av.x & 0xffff0000u);
        As[(lk + 2) * 132 + lr] = __uint_as_float(av.y << 16); As[(lk + 3) * 132 + lr] = __uint_as_float(av.y & 0xffff0000u);
        Bs[(lk + 0) * 132 + lr] = __uint_as_float(bv.x << 16); Bs[(lk + 1) * 132 + lr] = __uint_as_float(bv.x & 0xffff0000u);
        Bs[(lk + 2) * 132 + lr] = __uint_as_float(bv.y << 16); Bs[(lk + 3) * 132 + lr] = __uint_as_float(bv.y & 0xffff0000u);
        __syncthreads();
#pragma unroll
        for (int kk = 0; kk < 16; ++kk) {
            const float4 a0 = *(const float4*)(As + kk * 132 + ty * 8), a1 = *(const float4*)(As + kk * 132 + ty * 8 + 4);
            const float4 b = *(const float4*)(Bs + kk * 132 + tx * 4);
            const float a[8] = {a0.x, a0.y, a0.z, a0.w, a1.x, a1.y, a1.z, a1.w};
#pragma unroll
            for (int i = 0; i < 8; ++i) { acc[i][0] += a[i] * b.x; acc[i][1] += a[i] * b.y; acc[i][2] += a[i] * b.z; acc[i][3] += a[i] * b.w; }
        }
    }
    __syncthreads();
#pragma unroll
    for (int i = 0; i < 8; ++i) { const int r = ty * 8 + i; if (r < mvalid) {
#pragma unroll
        for (int j = 0; j < 4; ++j) epi(r, tx * 4 + j, acc[i][j]); } }
}


DI void rot8(uint4& A, uint4& B, const float* cs, const float* sn) {
    unsigned a[4] = {A.x, A.y, A.z, A.w}, b[4] = {B.x, B.y, B.z, B.w};
#pragma unroll
    for (int j = 0; j < 4; ++j) { const float a0 = __uint_as_float(a[j] << 16), a1 = __uint_as_float(a[j] & 0xffff0000u), b0 = __uint_as_float(b[j] << 16), b1 = __uint_as_float(b[j] & 0xffff0000u);
        const float c0 = cs[2 * j], c1 = cs[2 * j + 1], s0 = sn[2 * j], s1 = sn[2 * j + 1];
        a[j] = pk2(a0 * c0 - b0 * s0, a1 * c1 - b1 * s1); b[j] = pk2(a0 * s0 + b0 * c0, a1 * s1 + b1 * c1); }
    A = make_uint4(a[0], a[1], a[2], a[3]); B = make_uint4(b[0], b[1], b[2], b[3]);
}
DI void st_post(const Params& p, int l, unsigned char* smem, const int WV, const float sgn = 1.f) {
    const int TIDX = opq_tid(WV); const int BIDX = opq_bid(); (void)TIDX; (void)BIDX;
    const int lane = TIDX & 63, wave = __builtin_amdgcn_readfirstlane(TIDX >> 6);
    bf16_t* Y = (bf16_t*)(p.ws + WS_Y); bf16_t* YM = (bf16_t*)(p.ws + WS_YMIX);
    float* tab = (float*)smem + wave * 160;
    const float inv_n = exp2f(-(float)(lane & 15) * (18.931568569324174f / 16.f));
    const float inv_r = exp2f(-(float)lane * (13.287712379549449f / 64.f));
    const int c0 = lane * 8;
    float cw[24], cg[8];
    { const float4* w4 = (const float4*)(p.conv_w + ((size_t)l * 512 + c0) * 3);
#pragma unroll
      for (int i = 0; i < 6; ++i) { const float4 v = w4[i]; cw[4 * i] = v.x; cw[4 * i + 1] = v.y; cw[4 * i + 2] = v.z; cw[4 * i + 3] = v.w; }
      const float4* g4 = (const float4*)(p.conv_g + (size_t)l * 512 + c0); const float4 g0 = g4[0], g1 = g4[1];
      cg[0] = g0.x; cg[1] = g0.y; cg[2] = g0.z; cg[3] = g0.w; cg[4] = g1.x; cg[5] = g1.y; cg[6] = g1.z; cg[7] = g1.w; }
    for (int t = BIDX * 8 + wave; t < NT; t += gridDim.x * 8) {
        bf16_t* y = Y + (size_t)t * LDY; const float pos = (float)p.pos[t]; const int s = t % SEQ;
        { float sn, cs; sincosf(pos * inv_r, &sn, &cs); tab[32 + lane] = cs; tab[96 + lane] = sn * sgn;
          if (lane < 16) { sincosf(pos * inv_n, &sn, &cs); tab[lane] = cs; tab[16 + lane] = sn * sgn; } }
        const uint4 qb_ = *(const uint4*)(y + Y_CB + c0), qc0 = *(const uint4*)(y + Y_CC + c0), qu0 = *(const uint4*)(y + Y_CU + c0);
        uint4 qc1 = make_uint4(0, 0, 0, 0), qu1 = qc1, qc2 = qc1, qu2 = qc1;
        if (s >= 1) { qc1 = *(const uint4*)(y + Y_CC + c0 - LDY); qu1 = *(const uint4*)(y + Y_CU + c0 - LDY); }
        if (s >= 2) { qc2 = *(const uint4*)(y + Y_CC + c0 - 2 * LDY); qu2 = *(const uint4*)(y + Y_CU + c0 - 2 * LDY); }
        LDS_WAIT();
        { const int v = lane >> 3, kk = lane & 7; bf16_t* base = y + (v < 4 ? Y_QR : Y_KR) + (v & 3) * 128 + 8 * kk;
          uint4 A = *(const uint4*)base, B = *(const uint4*)(base + 64); rot8(A, B, tab + 32 + 8 * kk, tab + 96 + 8 * kk); *(uint4*)base = A; *(uint4*)(base + 64) = B; }
        if (lane < 28) { const int v = lane >> 1, cp = lane & 1; bf16_t* base = y + (v < 8 ? Y_QN + v * 128 : Y_KV + ((v - 8) >> 1) * 512 + ((v - 8) & 1) * 128) + 8 * cp;
          uint4 A = *(const uint4*)base, B = *(const uint4*)(base + 16); rot8(A, B, tab + 8 * cp, tab + 16 + 8 * cp); *(uint4*)base = A; *(uint4*)(base + 16) = B; }
        const unsigned wb[4] = {qb_.x, qb_.y, qb_.z, qb_.w}, wc0[4] = {qc0.x, qc0.y, qc0.z, qc0.w}, wu0[4] = {qu0.x, qu0.y, qu0.z, qu0.w}, wc1[4] = {qc1.x, qc1.y, qc1.z, qc1.w}, wu1[4] = {qu1.x, qu1.y, qu1.z, qu1.w},
                       wc2[4] = {qc2.x, qc2.y, qc2.z, qc2.w}, wu2[4] = {qu2.x, qu2.y, qu2.z, qu2.w};
        float yc[8]; float ss = 0.f;
#pragma unroll
        for (int i = 0; i < 8; ++i) { const int w = i >> 1; const bool hi_ = i & 1;
#define BFX(arr) (hi_ ? __uint_as_float(arr[w] & 0xffff0000u) : __uint_as_float(arr[w] << 16))
            const float v0 = BFX(wc0) * BFX(wu0), v1 = BFX(wc1) * BFX(wu1), v2 = BFX(wc2) * BFX(wu2);
            yc[i] = BFX(wb) * (cw[3 * i] * v2 + cw[3 * i + 1] * v1 + cw[3 * i + 2] * v0); ss += yc[i] * yc[i]; }
#undef BFX
        ss += __shfl_xor(ss, 1); ss += __shfl_xor(ss, 2); ss += __shfl_xor(ss, 4); ss += __shfl_xor(ss, 8);
        const float rs = rsqrtf(ss * (1.f / 128.f) + EPS);
        uint4 o; o.x = pk2(yc[0] * rs * cg[0], yc[1] * rs * cg[1]); o.y = pk2(yc[2] * rs * cg[2], yc[3] * rs * cg[3]); o.z = pk2(yc[4] * rs * cg[4], yc[5] * rs * cg[5]); o.w = pk2(yc[6] * rs * cg[6], yc[7] * rs * cg[7]);
        *(uint4*)(YM + (size_t)t * DM + c0) = o;
        LDS_WAIT();
    }
}

DI void st_cmp2(const Params& p, int l, unsigned char* smem, const int WV) {
    const int TIDX = opq_tid(WV); const int BIDX = opq_bid(); (void)TIDX; (void)BIDX;
    typedef short c2_bf16x8 __attribute__((ext_vector_type(8))); typedef float c2_f32x16 __attribute__((ext_vector_type(16))); typedef unsigned c2_u4 __attribute__((ext_vector_type(4)));
    constexpr int HP = 264;
    const float* CP = (const float*)(p.ws + WS_CP); const float* bias = (const float*)(p.ws + WS_CMPB) + l * 512;
    bf16_t* hid = (bf16_t*)(smem + 32768);
    const int wid = __builtin_amdgcn_readfirstlane(TIDX >> 6), lane = TIDX & 63, li = lane & 31, hi = lane >> 5, cb = wid & 3, db0 = 2 * (wid >> 2);
    for (int u = BIDX; u < 2 * 8 * 2; u += gridDim.x) {
        const int kv = u >> 4, bg = (u >> 1) & 7, mt = u & 1;
        const bf16_t* W2 = wl_ptr(p, l, WL_CW2) + (size_t)kv * 128 * 256;
        c2_bf16x8 wf[8][2];
#pragma unroll
        for (int ks = 0; ks < 8; ++ks)
#pragma unroll
            for (int t = 0; t < 2; ++t) wf[ks][t] = *(const c2_bf16x8*)(W2 + (size_t)(32 * (db0 + t) + li) * 256 + 16 * ks + 8 * hi);
        __syncthreads();
#pragma unroll 4
        for (int it = 0; it < 16; ++it) { const int i = TIDX + it * 512; const int r = i >> 6, c4 = (i & 63) * 4; const size_t o = ((size_t)((kv * 8 + bg) * 256 + mt * 128 + r)) * 256 + c4;
            const float4 a0 = *(const float4*)(CP + o), a1 = *(const float4*)(CP + (size_t)16 * 65536 + o), a2 = *(const float4*)(CP + (size_t)32 * 65536 + o), a3 = *(const float4*)(CP + (size_t)48 * 65536 + o);
            const float4 b0_ = *(const float4*)(bias + kv * 256 + c4), b1_ = *(const float4*)(bias + 1024 + kv * 256 + c4), b2_ = *(const float4*)(bias + 2048 + kv * 256 + c4), b3_ = *(const float4*)(bias + 3072 + kv * 256 + c4);
            const float4 bb = make_float4((b0_.x + b1_.x) + (b2_.x + b3_.x), (b0_.y + b1_.y) + (b2_.y + b3_.y), (b0_.z + b1_.z) + (b2_.z + b3_.z), (b0_.w + b1_.w) + (b2_.w + b3_.w));
            uint2 w; w.x = pk2(gelu_tanh_f((a0.x + a1.x) + (a2.x + a3.x) + bb.x), gelu_tanh_f((a0.y + a1.y) + (a2.y + a3.y) + bb.y)); w.y = pk2(gelu_tanh_f((a0.z + a1.z) + (a2.z + a3.z) + bb.z), gelu_tanh_f((a0.w + a1.w) + (a2.w + a3.w) + bb.w));
            *(uint2*)(hid + r * HP + c4) = w; }
        __syncthreads();
        const LDSF bf16_t* hl = (const LDSF bf16_t*)(LDSF unsigned char*)(smem + 32768);
        c2_f32x16 acc[2];
#pragma unroll
        for (int r = 0; r < 16; ++r) { acc[0][r] = 0.f; acc[1][r] = 0.f; }
#pragma unroll
        for (int kh = 0; kh < 2; ++kh) {
            if (kh == 1) {
#pragma unroll
                for (int ks = 0; ks < 8; ++ks)
#pragma unroll
                    for (int t = 0; t < 2; ++t) wf[ks][t] = *(const c2_bf16x8*)(W2 + (size_t)(32 * (db0 + t) + li) * 256 + 128 + 16 * ks + 8 * hi); }
#pragma unroll
            for (int ks = 0; ks < 8; ++ks) { const c2_bf16x8 hf = *(const LDSF c2_bf16x8*)(hl + (32 * cb + li) * HP + 128 * kh + 16 * ks + 8 * hi);
#pragma unroll
                for (int t = 0; t < 2; ++t) acc[t] = kv ? __builtin_amdgcn_mfma_f32_32x32x16_bf16(hf, wf[ks][t], acc[t], 0, 0, 0) : __builtin_amdgcn_mfma_f32_32x32x16_bf16(wf[ks][t], hf, acc[t], 0, 0, 0); } }
        bf16_t* kc = (bf16_t*)(p.ws + WS_KC) + (size_t)bg * 256 * 128; bf16_t* vct = (bf16_t*)(p.ws + WS_VC) + (size_t)bg * 128 * 256;
        if (kv == 0) { const int g = mt * 128 + 32 * cb + li;
#pragma unroll
            for (int t = 0; t < 2; ++t)
#pragma unroll
                for (int rq = 0; rq < 4; ++rq) { uint2 w; w.x = pk2(acc[t][4 * rq], acc[t][4 * rq + 1]); w.y = pk2(acc[t][4 * rq + 2], acc[t][4 * rq + 3]); if (g == 255) { w.x = 0u; w.y = 0u; }
                    *(uint2*)(kc + (size_t)g * 128 + 32 * (db0 + t) + 8 * rq + 4 * hi) = w; } }
        else {
#pragma unroll
            for (int t = 0; t < 2; ++t)
#pragma unroll
                for (int h2 = 0; h2 < 2; ++h2) { const int base = mt * 128 + 32 * cb + 16 * h2 + 8 * hi;
                    c2_u4 w; w.x = pk2(acc[t][8 * h2 + 0], acc[t][8 * h2 + 1]); w.y = pk2(acc[t][8 * h2 + 2], acc[t][8 * h2 + 3]); w.z = pk2(acc[t][8 * h2 + 4], acc[t][8 * h2 + 5]); w.w = pk2(acc[t][8 * h2 + 6], acc[t][8 * h2 + 7]);
                    if (base + 7 == 255) w.w &= 0x0000ffffu;
                    *(c2_u4*)(vct + (size_t)(32 * (db0 + t) + li) * 256 + base) = w; } }
    }
}

DI void st_scan(const Params& p, int l, const int WV) {
    const int TIDX = opq_tid(WV); const int BIDX = opq_bid(); (void)TIDX; (void)BIDX;
    const float* KVC = (const float*)(p.ws + WS_KVC); bf16_t* STB = (bf16_t*)(p.ws + WS_STATEB);
    for (size_t i = (size_t)BIDX * 512 + TIDX; i < (size_t)16 * 16384; i += (size_t)gridDim.x * 512) {
        const int bh = (int)(i >> 14), ed = (int)(i & 16383); const float cd = ret_chunkdecay(bh & 3);
        float kv[32];
#pragma unroll
        for (int c = 0; c < 32; ++c) kv[c] = KVC[(size_t)(bh * 32 + c) * 16384 + ed];
        float st = 0.f;
#pragma unroll
        for (int c = 0; c < 32; ++c) { STB[(size_t)(bh * 32 + c) * 16384 + ed] = f2bf(st); st = st * cd + kv[c]; }
    }
}


DI void pad_offsets(const unsigned* CNT, int* po, const int WV) {
    const int TIDX = opq_tid(WV); const int BIDX = opq_bid(); (void)TIDX; (void)BIDX;
    if (TIDX < 64) { const int pad = (int)((CNT[TIDX] + 255u) >> 8) << 8; int inc = pad;
#pragma unroll
        for (int o = 1; o < 64; o <<= 1) { const int v = __shfl_up(inc, o); if (TIDX >= o) inc += v; }
        po[TIDX] = inc - pad; if (TIDX == 63) po[64] = inc; }
    __syncthreads();
}
DI int blk_expert(const int* po, int blk) { int e = 0; while (e < 63 && po[e + 1] <= blk * 256) ++e; return e; }
typedef unsigned u2v_t __attribute__((ext_vector_type(2)));
typedef unsigned u4w_t __attribute__((ext_vector_type(4)));
DI void st_combine(const Params& p, int l, unsigned char* smem, const int WV) {
    const int TIDX = opq_tid(WV); const int BIDX = opq_bid(); (void)TIDX; (void)BIDX;
    bf16_t* X2 = (bf16_t*)(p.ws + WS_X2);
    LDSF float* tg2 = (LDSF float*)(LDSF unsigned char*)smem; LDSF float* tgs = tg2 + 4 * DM; LDSF float* tsh = tgs + 4 * DM;
#pragma unroll
    for (int it = 0; it < 4 * DM / 512; ++it) { const int i = TIDX + it * 512; tg2[i] = mod_ptr(p, l, i >> 11, 5)[i & (DM - 1)]; }
    if (l + 1 < NL) norm_tables(p, l + 1, 0, p.norm1_g + (size_t)(l + 1) * DM, tgs, tsh, TIDX); else for (int i = TIDX; i < DM; i += 512) tgs[i] = p.final_g[i];
    __syncthreads();
    const int* TOPE = (const int*)(p.ws + WS_TOPE); const int* RANK = (const int*)(p.ws + WS_RANK); const float* TOPW = (const float*)(p.ws + WS_TOPW);
    int* po = (int*)(smem + 100 * 1024); pad_offsets((const unsigned*)(p.ws + WS_CTL) + CW_CNT + l * 64, po, WV);
    const int lane = TIDX & 63, wave = __builtin_amdgcn_readfirstlane(TIDX >> 6);
    const __amdgpu_buffer_rsrc_t rys = __builtin_amdgcn_make_buffer_rsrc((void*)(p.ws + WS_YS), 0, (int)((size_t)NROWS_E * DM), 0x00020000);
    const __amdgpu_buffer_rsrc_t rx1 = __builtin_amdgcn_make_buffer_rsrc((void*)(p.ws + WS_X1), 0, (int)((size_t)NT * DM * 2), 0x00020000);
    const int lane0 = lane;
    for (int t = BIDX * 8 + wave; t < NT; t += gridDim.x * 8) {
        int lane = opq_tid(WV) & 63;
        const int b = t / SEQ; float4 acc[8];
        const int lo4 = lane * 4;
        { const int so = (NSLOT + t) * DM;
#pragma unroll
          for (int j = 0; j < 8; ++j) { const int w = (int)__builtin_amdgcn_raw_buffer_load_b32(rys, lo4 + j * 256, so, 2);
              acc[j] = make_float4(__builtin_amdgcn_cvt_f32_fp8(w, 0), __builtin_amdgcn_cvt_f32_fp8(w, 1), __builtin_amdgcn_cvt_f32_fp8(w, 2), __builtin_amdgcn_cvt_f32_fp8(w, 3)); } }
        { const int sv = po[TOPE[(size_t)t * 8 + (lane & 7)]] + RANK[(size_t)t * 8 + (lane & 7)]; const float wv = TOPW[(size_t)t * 8 + (lane & 7)];
#pragma unroll 1
          for (int kk = 0; kk < 8; kk += 4) { int w[4][8];
#pragma unroll
              for (int k2 = 0; k2 < 4; ++k2) { const int so = __builtin_amdgcn_readlane(sv, kk + k2) * DM;
#pragma unroll
                  for (int j = 0; j < 8; ++j) w[k2][j] = (int)__builtin_amdgcn_raw_buffer_load_b32(rys, lo4 + j * 256, so, 2); }
#pragma unroll
              for (int k2 = 0; k2 < 4; ++k2) { const float wk = __uint_as_float(__builtin_amdgcn_readlane(__float_as_uint(wv), kk + k2));
#pragma unroll
                  for (int j = 0; j < 8; ++j) { acc[j].x += wk * __builtin_amdgcn_cvt_f32_fp8(w[k2][j], 0); acc[j].y += wk * __builtin_amdgcn_cvt_f32_fp8(w[k2][j], 1); acc[j].z += wk * __builtin_amdgcn_cvt_f32_fp8(w[k2][j], 2); acc[j].w += wk * __builtin_amdgcn_cvt_f32_fp8(w[k2][j], 3); } }
              asm volatile("" ::: "memory"); } }
        asm volatile("" : "+v"(lane));
        float4 v[8];
#pragma unroll
        for (int j = 0; j < 8; ++j) { const u2v_t xw = __builtin_amdgcn_raw_buffer_load_b64(rx1, lane * 8 + j * 512, t * (DM * 2), 0); const f4v_t gg = *(const LDSF f4v_t*)(tg2 + b * DM + ((unsigned)j * 64u + (unsigned)lane) * 4u);
            v[j] = make_float4(__uint_as_float(xw.x << 16) + gg.x * acc[j].x, __uint_as_float(xw.x & 0xffff0000u) + gg.y * acc[j].y, __uint_as_float(xw.y << 16) + gg.z * acc[j].z, __uint_as_float(xw.y & 0xffff0000u) + gg.w * acc[j].w);
            if ((j & 3) == 3) asm volatile("" ::: "memory"); }
        if (l + 1 < NL) {
#pragma unroll
            for (int j = 0; j < 8; ++j) { uint2 o; o.x = pk2(v[j].x, v[j].y); o.y = pk2(v[j].z, v[j].w); *(uint2*)(X2 + (size_t)t * DM + ((unsigned)j * 64u + (unsigned)lane) * 4u) = o; }
            norm_row_store(v, lane, tgs + b * DM, tsh + b * DM, (bf16_t*)(p.ws + WS_H) + (size_t)t * DM, nullptr);
        } else {
            float ss = 0.f;
#pragma unroll
            for (int j = 0; j < 8; ++j) ss += v[j].x * v[j].x + v[j].y * v[j].y + v[j].z * v[j].z + v[j].w * v[j].w;
            const float r = rsqrtf(wave_sum(ss) * (1.f / DM) + EPS);
#pragma unroll
            for (int j = 0; j < 8; ++j) { const unsigned e = ((unsigned)j * 64u + (unsigned)lane) * 4u; const f4v_t gg = *(const LDSF f4v_t*)(tgs + e);
                *(float4*)(p.out + (size_t)t * DM + e) = make_float4(v[j].x * r * gg.x, v[j].y * r * gg.y, v[j].z * r * gg.z, v[j].w * r * gg.w); }
        }
    }
}


namespace pg8 {
#define PG8_LAS __attribute__((address_space(3)))
typedef short bf16x8 __attribute__((ext_vector_type(8)));
typedef float f32x4 __attribute__((ext_vector_type(4)));
typedef unsigned u32x4 __attribute__((ext_vector_type(4)));
constexpr int BM = 256, BK = 64, HALF = 128, HTB = HALF * BK * 2, STAGE_BYTES = 8 * HTB, NXCD = 8, WGM = 8;
__host__ __device__ __forceinline__ int lds_byte(int r, int c) { const int st = (r >> 4) * 2 + (c >> 5), rr = r & 15, cc = c & 31, ob = rr * 64 + cc * 2; return st * 1024 + (ob ^ (((ob >> 9) & 1) << 5)); }
__host__ __device__ __forceinline__ void stage_rc(int b, int& R, int& C) { const int st = b / 1024, sb = b % 1024, swz = sb ^ (((sb >> 9) & 1) << 5); R = (st >> 1) * 16 + swz / 64; C = (st & 1) * 32 + (swz % 64) / 2; }
__host__ __device__ __forceinline__ int perm32(int rho) { const int n = rho >> 4, i = rho & 15; return 8 * (i >> 2) + 4 * n + (i & 3); }
struct Unit { const char* A; const char* B; int i0, i1; };
__device__ __forceinline__ unsigned cvt_pk_bf16(float lo, float hi) { unsigned r; asm volatile("v_cvt_pk_bf16_f32 %0, %1, %2" : "=v"(r) : "v"(lo), "v"(hi)); return r; }
template <class Epi, class Sched, bool GATHER = false>
__device__ __forceinline__ void gemm_phase(PG8_LAS unsigned char* lds, const int K, const Sched& S, const Epi& E, const int tid, const size_t pitchA = 0, const size_t segA = 256, const size_t pitchB = 0) {
    const int wid = __builtin_amdgcn_readfirstlane(tid >> 6), lane = tid & 63, wr = wid >> 2, wc = wid & 3, fr = lane & 15, fq = lane >> 4;
    const int nt = K / BK;
    unsigned voffB[2], cva[2][2], nva[2][2]; int RA[2]; unsigned CA[2];
    const size_t pA = pitchA ? pitchA : (size_t)K * 2;
#pragma unroll
    for (int i = 0; i < 2; ++i) { int R, C; stage_rc(tid * 16 + i * 8192, R, C);
        const int Rb = Epi::BP16 ? (64 * (R >> 5) + 16 * ((R >> 2) & 3) + 4 * ((R >> 4) & 1) + (R & 3)) : (Epi::PERM ? ((R & ~31) + perm32(R & 31)) : R);
        RA[i] = R; CA[i] = (unsigned)C * 2u; voffB[i] = (unsigned)((size_t)Rb * (pitchB ? pitchB : (size_t)K * 2)) + (unsigned)C * 2u;
        cva[0][i] = (unsigned)((size_t)R * pA) + CA[i]; cva[1][i] = (unsigned)((size_t)(R + HALF) * pA) + CA[i]; nva[0][i] = cva[0][i]; nva[1][i] = cva[1][i]; }
    const size_t kstep = (size_t)(BK * 2);
    const size_t hstep = (size_t)(Epi::BP16 ? 8 : HALF) * (pitchB ? pitchB : (size_t)K * 2);
    const unsigned ldsw = (unsigned)wid * 1024u;
    const int aoff = lds_byte(wr * 64 + fr, fq * 8), boff = lds_byte(wc * 32 + fr, fq * 8);
#define PG8_SA(b, h) (((b) * 2 + (h)) * HTB)
#define PG8_SB(b, h) ((4 + (b) * 2 + (h)) * HTB)
#define PG8_STAGE(bufoff, gbase, voff) do { _Pragma("unroll") for (int _i = 0; _i < 2; ++_i) \
        __builtin_amdgcn_global_load_lds((const unsigned*)((const char*)(gbase) + (voff)[_i]), (PG8_LAS unsigned*)(lds + (bufoff) + ldsw + _i * 8192), 16, 0, 0); } while (0)
#define PG8_LDA(dst, b, h) do { _Pragma("unroll") for (int m = 0; m < 4; ++m) _Pragma("unroll") for (int k = 0; k < 2; ++k) dst[m][k] = *(const PG8_LAS bf16x8*)(lds + PG8_SA(b, h) + aoff + m * 2048 + k * 1024); } while (0)
#define PG8_LDB(dst, b, h) do { _Pragma("unroll") for (int n = 0; n < 2; ++n) _Pragma("unroll") for (int k = 0; k < 2; ++k) dst[n][k] = *(const PG8_LAS bf16x8*)(lds + PG8_SB(b, h) + boff + n * 2048 + k * 1024); } while (0)
#define PG8_MMA(ai, bj, At, Bt) do { __builtin_amdgcn_s_setprio(1); _Pragma("unroll") for (int m = 0; m < 4; ++m) _Pragma("unroll") for (int n = 0; n < 2; ++n) _Pragma("unroll") for (int k = 0; k < 2; ++k) \
        acc[ai][bj][m][n] = __builtin_amdgcn_mfma_f32_16x16x32_bf16(Bt[n][k], At[m][k], acc[ai][bj][m][n], 0, 0, 0); __builtin_amdgcn_s_setprio(0); } while (0)
#define PG8_WAIT_V(n) asm volatile("s_waitcnt vmcnt(" #n ")" ::: "memory")
#define PG8_WAIT_L(n) asm volatile("s_waitcnt lgkmcnt(" #n ")" ::: "memory")
#define PG8_BAR __builtin_amdgcn_s_barrier()
#define PG8_SCHED __builtin_amdgcn_sched_barrier(0)
    Unit cur, nxt; int ui = 0;
    if (!S.next(0, cur)) return;
    f32x4 acc[2][2][4][2];
#pragma unroll
    for (int a = 0; a < 2; ++a)
#pragma unroll
        for (int b = 0; b < 2; ++b)
#pragma unroll
            for (int m = 0; m < 4; ++m)
#pragma unroll
                for (int n = 0; n < 2; ++n) acc[a][b][m][n] = (f32x4){0.f, 0.f, 0.f, 0.f};
    bf16x8 At[4][2], B0[2][2], B1[2][2];
    const char* cA = cur.A; const char* cB = cur.B;
    if constexpr (GATHER) {
#pragma unroll
        for (int h = 0; h < 2; ++h)
#pragma unroll
            for (int i = 0; i < 2; ++i) cva[h][i] = S.rowoff(cur, h * HALF + RA[i]) + CA[i]; }
    S.a_ready(cur);
    PG8_STAGE(PG8_SB(0, 0), cB, voffB); PG8_STAGE(PG8_SA(0, 0), cA, cva[0]); PG8_STAGE(PG8_SB(0, 1), cB + hstep, voffB); PG8_STAGE(PG8_SA(0, 1), cA, cva[1]);
    if (wr == 1) PG8_BAR;
    PG8_WAIT_V(4); PG8_BAR;
    PG8_STAGE(PG8_SB(1, 0), cB + kstep, voffB); PG8_STAGE(PG8_SA(1, 0), cA + kstep, cva[0]); PG8_STAGE(PG8_SB(1, 1), cB + hstep + kstep, voffB);
    PG8_WAIT_V(6); PG8_BAR;
    for (;;) {
        const bool has_next = S.next(ui + 1, nxt);
        if constexpr (GATHER) { if (has_next) {
#pragma unroll
            for (int h = 0; h < 2; ++h)
#pragma unroll
                for (int i = 0; i < 2; ++i) nva[h][i] = S.rowoff(nxt, h * HALF + RA[i]) + CA[i]; } }
        const char* nA = has_next ? nxt.A : cA; const char* nB = has_next ? nxt.B : cB;
        for (int t = 0; t < nt; t += 2) {
            const bool last = (t == nt - 2);
            const char* a1 = cA + (size_t)(t >> 1) * segA + kstep;
            unsigned va2[2][2];
#pragma unroll
            for (int h = 0; h < 2; ++h)
#pragma unroll
                for (int i = 0; i < 2; ++i) va2[h][i] = (GATHER && last) ? nva[h][i] : cva[h][i];
            const char* a2 = last ? nA : cA + (size_t)((t >> 1) + 1) * segA; const char* b2 = last ? nB : cB + (size_t)(t + 2) * kstep;
            const char* a3 = a2 + kstep; const char* b3 = b2 + kstep;
            if (last && has_next) S.a_ready(nxt);
            PG8_LDB(B0, 0, 0); PG8_SCHED; PG8_LDA(At, 0, 0); PG8_STAGE(PG8_SA(1, 1), a1, cva[1]);
            PG8_WAIT_L(8); PG8_BAR; PG8_WAIT_L(0); PG8_MMA(0, 0, At, B0); PG8_BAR; PG8_SCHED;
            PG8_LDB(B1, 0, 1); PG8_STAGE(PG8_SB(0, 0), b2, voffB);
            PG8_BAR; PG8_WAIT_L(0); PG8_MMA(0, 1, At, B1); PG8_BAR;
            PG8_LDA(At, 0, 1); PG8_STAGE(PG8_SA(0, 0), a2, va2[0]);
            PG8_BAR; PG8_WAIT_L(0); PG8_MMA(1, 0, At, B0); PG8_BAR; PG8_SCHED;
            PG8_STAGE(PG8_SB(0, 1), b2 + hstep, voffB);
            PG8_WAIT_V(6); PG8_BAR; PG8_MMA(1, 1, At, B1); PG8_BAR;
            PG8_LDB(B0, 1, 0); PG8_SCHED; PG8_LDA(At, 1, 0); PG8_STAGE(PG8_SA(0, 1), a2, va2[1]);
            PG8_WAIT_L(8); PG8_BAR; PG8_WAIT_L(0); PG8_MMA(0, 0, At, B0); PG8_BAR; PG8_SCHED;
            PG8_LDB(B1, 1, 1); PG8_STAGE(PG8_SB(1, 0), b3, voffB);
            PG8_BAR; PG8_WAIT_L(0); PG8_MMA(0, 1, At, B1); PG8_BAR;
            PG8_LDA(At, 1, 1); PG8_STAGE(PG8_SA(1, 0), a3, va2[0]);
            PG8_BAR; PG8_WAIT_L(0); PG8_MMA(1, 0, At, B0); PG8_BAR; PG8_SCHED;
            PG8_STAGE(PG8_SB(1, 1), b3 + hstep, voffB);
            PG8_WAIT_V(6); PG8_BAR; PG8_MMA(1, 1, At, B1); PG8_BAR;
        }
        if (wr == 0) PG8_BAR;
        if constexpr (!Epi::AFTER_DRAIN) { E(acc, cur, wr, wc, fr, fq); S.done(cur); }
        if (!has_next) break;
#pragma unroll
        for (int a = 0; a < 2; ++a)
#pragma unroll
            for (int b = 0; b < 2; ++b)
#pragma unroll
                for (int m = 0; m < 4; ++m)
#pragma unroll
                    for (int n = 0; n < 2; ++n) acc[a][b][m][n] = (f32x4){0.f, 0.f, 0.f, 0.f};
        cur = nxt; cA = nA; cB = nB; ++ui;
        if constexpr (GATHER) {
#pragma unroll
            for (int h = 0; h < 2; ++h)
#pragma unroll
                for (int i = 0; i < 2; ++i) cva[h][i] = nva[h][i]; }
        if (wr == 1) PG8_BAR;
    }
    PG8_WAIT_V(0);
    PG8_BAR;
    if constexpr (Epi::AFTER_DRAIN) { E.fused(acc, cur, wr, wc, fr, fq, lds, wid, lane); S.done(cur); }
#undef PG8_SA
#undef PG8_SB
#undef PG8_STAGE
#undef PG8_LDA
#undef PG8_LDB
#undef PG8_MMA
#undef PG8_WAIT_V
#undef PG8_WAIT_L
#undef PG8_BAR
#undef PG8_SCHED
}

struct GridOrder {
    int nM, nN, nwg, G, c; const char* A; const char* B; size_t tstep;
    __device__ __forceinline__ void init(int M, int N, int K, int G_, int c_, const void* A_, const void* B_) { nM = M / BM; nN = N / BM; nwg = nM * nN; G = G_; c = c_; A = (const char*)A_; B = (const char*)B_; tstep = (size_t)BM * K * 2; }
    __device__ __forceinline__ bool next(int i, Unit& u) const {
        const long L = (long)i * G + c; if (L >= nwg) return false;
        int wgid = (int)L; { const int q = nwg / NXCD, r = nwg % NXCD, xcd = wgid % NXCD, off = wgid / NXCD; wgid = (xcd < r ? xcd * (q + 1) : r * (q + 1) + (xcd - r) * q) + off; }
        const int nig = WGM * nN, gid = wgid / nig, fm = gid * WGM, gsz = (nM - fm) < WGM ? (nM - fm) : WGM;
        const int pm = fm + ((wgid % nig) % gsz), pn = (wgid % nig) / gsz;
        u.A = A + (size_t)pm * tstep; u.B = B + (size_t)pn * tstep; u.i0 = pm * BM; u.i1 = pn; return true;
    }
    __device__ __forceinline__ void a_ready(const Unit&) const {}
    __device__ __forceinline__ void done(const Unit&) const {}
};
struct MoeOrder {
    int G, c, nblk, npn; const PG8_LAS int* be; const char* XS; const char* HS; const char* W; size_t a_tile, w_exp, w_tile;
    __device__ __forceinline__ bool next(int i, Unit& u) const {
        int blk, pn;
        if ((G & 7) == 0) { const int x = c & 7, r = c >> 3, W = G >> 3, nb = nblk + NT / 256, q = nb >> 3, rem = nb & 7;
            const int b0 = x * q + (x < rem ? x : rem), cntb = q + (x < rem ? 1 : 0); const long kk = (long)i * W + r; if (kk >= (long)cntb * npn) return false;
            blk = b0 + (int)(kk / npn); pn = (int)(kk % npn); }
        else { const long L = (long)i * G + c; if (L >= (long)(nblk + NT / 256) * npn) return false; blk = (int)(L / npn); pn = (int)(L % npn); }
        int e;
        if (blk < nblk) { e = be[blk]; u.A = XS + (size_t)blk * a_tile; u.i0 = blk * 256; }
        else { e = 64; u.A = HS + (size_t)(blk - nblk) * a_tile; u.i0 = NSLOT + (blk - nblk) * 256; }
        if (tokof) u.A = HS;
        u.B = W + (size_t)e * w_exp + (size_t)pn * w_tile; u.i1 = pn; return true;
    }
    __device__ __forceinline__ void a_ready(const Unit&) const {}
    __device__ __forceinline__ void done(const Unit&) const {}
    const int* tokof; unsigned rowbytes; const PG8_LAS int* po; const PG8_LAS int* lc;
    __device__ __forceinline__ unsigned rowoff(const Unit& u, int r) const {
        int t;
        if (u.i0 < NSLOT) { const int e = be[u.i0 >> 8], rk = u.i0 - po[e] + r, c = lc[e]; const int tt = tokof[(size_t)e * NT + (rk < c ? rk : 0)]; t = rk < c ? tt : 0; }
        else t = u.i0 - NSLOT + r;
        return (unsigned)t * rowbytes; }
};
template <bool NT_ST = false> struct EpiStoreBf16T {
    static constexpr bool BP16 = false; static constexpr bool PERM = true, AFTER_DRAIN = false;
    bf16_t* O; int ldc;
    __device__ __forceinline__ void operator()(const f32x4 (&acc)[2][2][4][2], const Unit& u, int wr, int wc, int fr, int fq) const {
        bf16_t* base = O + (size_t)(u.i0 + wr * 64 + fr) * ldc + u.i1 * BM + wc * 32 + 8 * fq;
#pragma unroll
        for (int ai = 0; ai < 2; ++ai)
#pragma unroll
            for (int m = 0; m < 4; ++m) { bf16_t* rowp = base + (size_t)(ai * HALF + m * 16) * ldc;
#pragma unroll
                for (int bj = 0; bj < 2; ++bj) { const f32x4 v0 = acc[ai][bj][m][0], v1 = acc[ai][bj][m][1];
                    u32x4 w; w.x = cvt_pk_bf16(v0[0], v0[1]); w.y = cvt_pk_bf16(v0[2], v0[3]); w.z = cvt_pk_bf16(v1[0], v1[1]); w.w = cvt_pk_bf16(v1[2], v1[3]);
                    if constexpr (NT_ST) __builtin_nontemporal_store(w, (u32x4*)(rowp + bj * HALF)); else *(u32x4*)(rowp + bj * HALF) = w; } }
    }
};
typedef EpiStoreBf16T<false> EpiStoreBf16;
struct EpiSwiglu {
    static constexpr bool BP16 = false; static constexpr bool PERM = true, AFTER_DRAIN = false;
    bf16_t* O;
    __device__ __forceinline__ void operator()(const f32x4 (&acc)[2][2][4][2], const Unit& u, int wr, int wc, int fr, int fq) const {
        bf16_t* base = O + (size_t)(u.i0 + wr * 64 + fr) * 512 + u.i1 * 128 + wc * 32 + 8 * fq;
#pragma unroll
        for (int ai = 0; ai < 2; ++ai)
#pragma unroll
            for (int m = 0; m < 4; ++m) { float r[8];
#pragma unroll
                for (int n = 0; n < 2; ++n)
#pragma unroll
                    for (int j = 0; j < 4; ++j) { const float g = acc[ai][0][m][n][j], up = acc[ai][1][m][n][j]; r[n * 4 + j] = g * __builtin_amdgcn_rcpf(1.f + __expf(-g)) * up; }
                u32x4 w; w.x = cvt_pk_bf16(r[0], r[1]); w.y = cvt_pk_bf16(r[2], r[3]); w.z = cvt_pk_bf16(r[4], r[5]); w.w = cvt_pk_bf16(r[6], r[7]);
                *(u32x4*)(base + (size_t)(ai * HALF + m * 16) * 512) = w; }
    }
};
struct EpiResid {
    static constexpr bool BP16 = false, PACED = false; static constexpr bool PERM = true, AFTER_DRAIN = false;
    const float* xin; const bf16_t* xinb; bf16_t* xo; const float* mod_g1;
    __device__ __forceinline__ void operator()(const f32x4 (&acc)[2][2][4][2], const Unit& u, int wr, int wc, int fr, int fq) const {
        const int col0 = u.i1 * BM + wc * 32 + 8 * fq; const float* g1 = mod_g1 + (size_t)(u.i0 / SEQ) * 12288 + col0;
        f32x4 gv[2][2];
#pragma unroll
        for (int bj = 0; bj < 2; ++bj)
#pragma unroll
            for (int n = 0; n < 2; ++n) gv[bj][n] = *(const f32x4*)(g1 + bj * HALF + n * 4);
        const bool xb = xinb != nullptr;
#pragma unroll
        for (int ai = 0; ai < 2; ++ai)
#pragma unroll
            for (int m = 0; m < 4; ++m) { const size_t off = (size_t)(u.i0 + wr * 64 + fr + ai * HALF + m * 16) * DM + col0;
#pragma unroll
                for (int bj = 0; bj < 2; ++bj) { f32x4 x0, x1;
                    if (xb) { const u32x4 w = *(const u32x4*)(xinb + off + bj * HALF);
                        x0 = (f32x4){__uint_as_float(w.x << 16), __uint_as_float(w.x & 0xffff0000u), __uint_as_float(w.y << 16), __uint_as_float(w.y & 0xffff0000u)};
                        x1 = (f32x4){__uint_as_float(w.z << 16), __uint_as_float(w.z & 0xffff0000u), __uint_as_float(w.w << 16), __uint_as_float(w.w & 0xffff0000u)}; }
                    else { x0 = *(const f32x4*)(xin + off + bj * HALF); x1 = *(const f32x4*)(xin + off + bj * HALF + 4); }
                    const f32x4 r0 = x0 + gv[bj][0] * acc[ai][bj][m][0], r1 = x1 + gv[bj][1] * acc[ai][bj][m][1];
                    u32x4 o; o.x = cvt_pk_bf16(r0[0], r0[1]); o.y = cvt_pk_bf16(r0[2], r0[3]); o.z = cvt_pk_bf16(r1[0], r1[1]); o.w = cvt_pk_bf16(r1[2], r1[3]);
                    *(u32x4*)(xo + off + bj * HALF) = o; }
                if (m & 1) asm volatile("" ::: "memory"); }
    }
};
}

namespace pg8 {
struct EpiStoreFp8 {
    static constexpr bool BP16 = true, PERM = true, AFTER_DRAIN = false;
    unsigned char* O;
    __device__ __forceinline__ static unsigned pk4(const f32x4 v) {
        int w = __builtin_amdgcn_cvt_pk_fp8_f32(__builtin_amdgcn_fmed3f(v[0], -448.f, 448.f), __builtin_amdgcn_fmed3f(v[1], -448.f, 448.f), 0, false);
        w = __builtin_amdgcn_cvt_pk_fp8_f32(__builtin_amdgcn_fmed3f(v[2], -448.f, 448.f), __builtin_amdgcn_fmed3f(v[3], -448.f, 448.f), w, true); return (unsigned)w; }
    __device__ __forceinline__ void operator()(const f32x4 (&acc)[2][2][4][2], const Unit& u, int wr, int wc, int fr, int fq) const {
        unsigned char* base = O + (size_t)(u.i0 + wr * 64 + fr) * DM + u.i1 * BM + wc * 64 + 16 * fq;
#pragma unroll
        for (int ai = 0; ai < 2; ++ai)
#pragma unroll
            for (int m = 0; m < 4; ++m) { u32x4 w; w.x = pk4(acc[ai][0][m][0]); w.y = pk4(acc[ai][0][m][1]); w.z = pk4(acc[ai][1][m][0]); w.w = pk4(acc[ai][1][m][1]);
                *(u32x4*)(base + (size_t)(ai * HALF + m * 16) * DM) = w; }
    }
};
}
constexpr int LDS_PO = 148 * 1024;
constexpr int LDS_BE = 148 * 1024 + 512;
constexpr int LDS_BST = 148 * 1024 + 3072;
constexpr int LDS_LC = 148 * 1024 + 3200;
DI void st_inproj_mm(const Params& p, int l, unsigned char* smem, const int WV) {
    const int TIDX = opq_tid(WV), BIDX = opq_bid();
    pg8::GridOrder S; S.init(NT, 6144, DM, gridDim.x, BIDX, p.ws + WS_H, wl_ptr(p, l, WL_WIN));
    pg8::EpiStoreBf16 E{(bf16_t*)(p.ws + WS_Y), LDY};
    pg8::gemm_phase(( PG8_LAS unsigned char*)smem, DM, S, E, TIDX);
}
DI void st_outproj_mm(const Params& p, int l, const float* xin, const bf16_t* xinb, unsigned char* smem, const int WV) {
    const int TIDX = opq_tid(WV), BIDX = opq_bid();
    pg8::GridOrder S; S.init(NT, DM, DM, gridDim.x, BIDX, p.ws + WS_YMIX, wl_ptr(p, l, WL_WOUT));
    pg8::EpiResid E{xin, xinb, (bf16_t*)(p.ws + WS_X1), mod_ptr(p, l, 0, 2)};
    pg8::gemm_phase((PG8_LAS unsigned char*)smem, DM, S, E, TIDX);
}
DI void moe_offsets(const Params& p, int l, unsigned char* smem, int TIDX) {
    const unsigned* CNT = (const unsigned*)(p.ws + WS_CTL) + CW_CNT + l * 64; int* po = (int*)(smem + LDS_PO);
    __syncthreads();
    if (TIDX < 64) { const int pad = (int)((CNT[TIDX] + 255u) >> 8) << 8; int inc = pad;
        ((int*)(smem + LDS_LC))[TIDX] = (int)CNT[TIDX];
#pragma unroll
        for (int o = 1; o < 64; o <<= 1) { const int v = __shfl_up(inc, o); if (TIDX >= o) inc += v; }
        po[TIDX] = inc - pad; if (TIDX == 63) po[64] = inc; }
    __syncthreads();
    int* be = (int*)(smem + LDS_BE);
    for (int blk = TIDX; blk < 576; blk += 512) { int e = 0;
#pragma unroll 1
        while (e < 63 && po[e + 1] <= blk * 256) ++e;
        be[blk] = e; }
    __syncthreads();
}
DI void st_gemm1_mm(const Params& p, int l, unsigned char* smem, const int WV) {
    const int TIDX = opq_tid(WV), BIDX = opq_bid();
    moe_offsets(p, l, smem, TIDX);
    const PG8_LAS int* po = (const PG8_LAS int*)(PG8_LAS unsigned char*)(smem + LDS_PO);
    pg8::MoeOrder S; S.tokof = (const int*)(p.ws + WS_XS); S.po = po; S.lc = (const PG8_LAS int*)(PG8_LAS unsigned char*)(smem + LDS_LC); S.rowbytes = DM * 2; S.G = gridDim.x; S.c = BIDX; S.nblk = po[64] / 256; S.npn = 4; S.be = (const PG8_LAS int*)(PG8_LAS unsigned char*)(smem + LDS_BE); S.XS = (const char*)(p.ws + WS_XS); S.HS = (const char*)(p.ws + WS_H); S.W = (const char*)wl_ptr(p, l, WL_EGU);
    S.a_tile = (size_t)256 * DM * 2; S.w_exp = (size_t)1024 * DM * 2; S.w_tile = (size_t)256 * DM * 2;
    pg8::EpiSwiglu E{(bf16_t*)(p.ws + WS_ACT)};
    pg8::gemm_phase<pg8::EpiSwiglu, pg8::MoeOrder, true>((PG8_LAS unsigned char*)smem, DM, S, E, TIDX);
}
DI void st_gemm2_mm(const Params& p, int l, unsigned char* smem, const int WV) {
    const int TIDX = opq_tid(WV), BIDX = opq_bid();
    moe_offsets(p, l, smem, TIDX);
    const PG8_LAS int* po = (const PG8_LAS int*)(PG8_LAS unsigned char*)(smem + LDS_PO);
    pg8::MoeOrder S; S.tokof = nullptr; S.po = po; S.lc = (const PG8_LAS int*)(PG8_LAS unsigned char*)(smem + LDS_LC); S.rowbytes = 0; S.G = gridDim.x; S.c = BIDX; S.nblk = po[64] / 256; S.npn = 8; S.be = (const PG8_LAS int*)(PG8_LAS unsigned char*)(smem + LDS_BE); S.XS = (const char*)(p.ws + WS_ACT); S.HS = (const char*)(p.ws + WS_ACT) + (size_t)NSLOT * 512 * 2; S.W = (const char*)wl_ptr(p, l, WL_EDN);
    S.a_tile = (size_t)256 * 512 * 2; S.w_exp = (size_t)DM * 512 * 2; S.w_tile = (size_t)256 * 512 * 2;
    pg8::EpiStoreFp8 E{(unsigned char*)(p.ws + WS_YS)};
    pg8::gemm_phase((PG8_LAS unsigned char*)smem, 512, S, E, TIDX);
}

typedef short bf16x8_t __attribute__((ext_vector_type(8)));
typedef float f32x16_t __attribute__((ext_vector_type(16)));
#define LASP __attribute__((address_space(3)))
DI void st_vt(const Params& p, int l, unsigned char* smem, const int WV) {
    const int TIDX = opq_tid(WV), BIDX = opq_bid();
    const bf16_t* Y = (const bf16_t*)(p.ws + WS_Y); bf16_t* VT = (bf16_t*)(p.ws + WS_VT);
    LDSF bf16_t* T = (LDSF bf16_t*)(LDSF unsigned char*)smem;
    constexpr int TSZ = 128 * 72;
    for (int u0 = BIDX; u0 < NB * 64 * 4; u0 += 4 * gridDim.x) {
        { const int tok = TIDX & 63, dseg = (TIDX >> 6) * 16; uint4 v[4][2];
#pragma unroll
          for (int k = 0; k < 4; ++k) { const int u = u0 + k * gridDim.x;
              if (u < NB * 64 * 4) { const int b = u >> 8, tile = (u >> 2) & 63, wh = u & 3, br = 1 + (wh >> 1), g = wh & 1;
                  const uint4* src = (const uint4*)(Y + ((size_t)b * SEQ + tile * 64 + tok) * LDY + Y_KV + br * 512 + 256 + g * 128 + dseg); v[k][0] = src[0]; v[k][1] = src[1]; }
              else { v[k][0] = make_uint4(0u, 0u, 0u, 0u); v[k][1] = v[k][0]; } }
          const int pos = (tok & ~15) | kperm16(tok & 15);
#pragma unroll
          for (int k = 0; k < 4; ++k) { const unsigned w[8] = {v[k][0].x, v[k][0].y, v[k][0].z, v[k][0].w, v[k][1].x, v[k][1].y, v[k][1].z, v[k][1].w};
#pragma unroll
              for (int i = 0; i < 8; ++i) { T[k * TSZ + (dseg + 2 * i) * 72 + pos] = (bf16_t)(w[i] & 0xffffu); T[k * TSZ + (dseg + 2 * i + 1) * 72 + pos] = (bf16_t)(w[i] >> 16); } } }
        __syncthreads();
        { const int d = TIDX >> 2, seg = (TIDX & 3) * 16;
          typedef unsigned u4v_t __attribute__((ext_vector_type(4)));
#pragma unroll
          for (int k = 0; k < 4; ++k) { const int u = u0 + k * gridDim.x;
              if (u < NB * 64 * 4) { const int b = u >> 8, tile = (u >> 2) & 63, wh = u & 3, br = 1 + (wh >> 1), g = wh & 1;
                  const LDSF u4v_t* sp = (const LDSF u4v_t*)(T + k * TSZ + d * 72 + seg);
                  u4v_t* dst = (u4v_t*)(VT + ((size_t)((b * 2 + g) * 2 + (br - 1)) * 128 + d) * SEQ + tile * 64 + seg); const u4v_t s0 = sp[0], s1 = sp[1]; dst[0] = s0; dst[1] = s1; } } }
        __syncthreads();
    }
}
DI float fast_exp2(float x) { return __builtin_amdgcn_exp2f(x); }
#define DSR(dst, addr, off) asm volatile("ds_read_b128 %0, %1 offset:%2" : "=v"(dst) : "v"(addr), "i"(off) : "memory")
#define LWAIT(n, var) asm volatile("s_waitcnt lgkmcnt(" #n ")" : "+v"(var) :: "memory")
DI void qk_tile_pipe(f32x16_t& s0, f32x16_t& s1, const unsigned kb, const int xh, const bf16x8_t (&qf)[8]) {
    bf16x8_t f0, f1, f2, f3;
#pragma unroll
    for (int r = 0; r < 16; ++r) { s0[r] = 0.f; s1[r] = 0.f; }
    DSR(f0, (kb + (unsigned)((0 ^ xh) << 5)), 0);
    DSR(f1, (kb + (unsigned)((0 ^ xh) << 5)), 8192);
    DSR(f2, (kb + (unsigned)((1 ^ xh) << 5)), 0);
    DSR(f3, (kb + (unsigned)((1 ^ xh) << 5)), 8192);
    LWAIT(3, f0); s0 = __builtin_amdgcn_mfma_f32_32x32x16_bf16(f0, qf[0], s0, 0, 0, 0); DSR(f0, (kb + (unsigned)((2 ^ xh) << 5)), 0);
    LWAIT(3, f1); s1 = __builtin_amdgcn_mfma_f32_32x32x16_bf16(f1, qf[0], s1, 0, 0, 0); DSR(f1, (kb + (unsigned)((2 ^ xh) << 5)), 8192);
    LWAIT(3, f2); s0 = __builtin_amdgcn_mfma_f32_32x32x16_bf16(f2, qf[1], s0, 0, 0, 0); DSR(f2, (kb + (unsigned)((3 ^ xh) << 5)), 0);
    LWAIT(3, f3); s1 = __builtin_amdgcn_mfma_f32_32x32x16_bf16(f3, qf[1], s1, 0, 0, 0); DSR(f3, (kb + (unsigned)((3 ^ xh) << 5)), 8192);
    LWAIT(3, f0); s0 = __builtin_amdgcn_mfma_f32_32x32x16_bf16(f0, qf[2], s0, 0, 0, 0); DSR(f0, (kb + (unsigned)((4 ^ xh) << 5)), 0);
    LWAIT(3, f1); s1 = __builtin_amdgcn_mfma_f32_32x32x16_bf16(f1, qf[2], s1, 0, 0, 0); DSR(f1, (kb + (unsigned)((4 ^ xh) << 5)), 8192);
    LWAIT(3, f2); s0 = __builtin_amdgcn_mfma_f32_32x32x16_bf16(f2, qf[3], s0, 0, 0, 0); DSR(f2, (kb + (unsigned)((5 ^ xh) << 5)), 0);
    LWAIT(3, f3); s1 = __builtin_amdgcn_mfma_f32_32x32x16_bf16(f3, qf[3], s1, 0, 0, 0); DSR(f3, (kb + (unsigned)((5 ^ xh) << 5)), 8192);
    LWAIT(3, f0); s0 = __builtin_amdgcn_mfma_f32_32x32x16_bf16(f0, qf[4], s0, 0, 0, 0); DSR(f0, (kb + (unsigned)((6 ^ xh) << 5)), 0);
    LWAIT(3, f1); s1 = __builtin_amdgcn_mfma_f32_32x32x16_bf16(f1, qf[4], s1, 0, 0, 0); DSR(f1, (kb + (unsigned)((6 ^ xh) << 5)), 8192);
    LWAIT(3, f2); s0 = __builtin_amdgcn_mfma_f32_32x32x16_bf16(f2, qf[5], s0, 0, 0, 0); DSR(f2, (kb + (unsigned)((7 ^ xh) << 5)), 0);
    LWAIT(3, f3); s1 = __builtin_amdgcn_mfma_f32_32x32x16_bf16(f3, qf[5], s1, 0, 0, 0); DSR(f3, (kb + (unsigned)((7 ^ xh) << 5)), 8192);
    LWAIT(3, f0); s0 = __builtin_amdgcn_mfma_f32_32x32x16_bf16(f0, qf[6], s0, 0, 0, 0);
    LWAIT(2, f1); s1 = __builtin_amdgcn_mfma_f32_32x32x16_bf16(f1, qf[6], s1, 0, 0, 0);
    LWAIT(1, f2); s0 = __builtin_amdgcn_mfma_f32_32x32x16_bf16(f2, qf[7], s0, 0, 0, 0);
    LWAIT(0, f3); s1 = __builtin_amdgcn_mfma_f32_32x32x16_bf16(f3, qf[7], s1, 0, 0, 0);
}
DI void pv_tile_pipe(f32x16_t (&O)[4], const unsigned vb, const int yh, const bf16x8_t (&pf)[4]) {
    bf16x8_t f0, f1, f2, f3;
    const unsigned av0 = vb + (unsigned)((0 ^ yh) << 5), av1 = vb + (unsigned)((1 ^ yh) << 5), av2 = vb + (unsigned)((2 ^ yh) << 5), av3 = vb + (unsigned)((3 ^ yh) << 5);
    DSR(f0, av0, 0);
    DSR(f1, av0, 4096);
    DSR(f2, av0, 8192);
    DSR(f3, av0, 12288);
    LWAIT(3, f0); O[0] = __builtin_amdgcn_mfma_f32_32x32x16_bf16(f0, pf[0], O[0], 0, 0, 0); DSR(f0, av1, 0);
    LWAIT(3, f1); O[1] = __builtin_amdgcn_mfma_f32_32x32x16_bf16(f1, pf[0], O[1], 0, 0, 0); DSR(f1, av1, 4096);
    LWAIT(3, f2); O[2] = __builtin_amdgcn_mfma_f32_32x32x16_bf16(f2, pf[0], O[2], 0, 0, 0); DSR(f2, av1, 8192);
    LWAIT(3, f3); O[3] = __builtin_amdgcn_mfma_f32_32x32x16_bf16(f3, pf[0], O[3], 0, 0, 0); DSR(f3, av1, 12288);
    LWAIT(3, f0); O[0] = __builtin_amdgcn_mfma_f32_32x32x16_bf16(f0, pf[1], O[0], 0, 0, 0); DSR(f0, av2, 0);
    LWAIT(3, f1); O[1] = __builtin_amdgcn_mfma_f32_32x32x16_bf16(f1, pf[1], O[1], 0, 0, 0); DSR(f1, av2, 4096);
    LWAIT(3, f2); O[2] = __builtin_amdgcn_mfma_f32_32x32x16_bf16(f2, pf[1], O[2], 0, 0, 0); DSR(f2, av2, 8192);
    LWAIT(3, f3); O[3] = __builtin_amdgcn_mfma_f32_32x32x16_bf16(f3, pf[1], O[3], 0, 0, 0); DSR(f3, av2, 12288);
    LWAIT(3, f0); O[0] = __builtin_amdgcn_mfma_f32_32x32x16_bf16(f0, pf[2], O[0], 0, 0, 0); DSR(f0, av3, 0);
    LWAIT(3, f1); O[1] = __builtin_amdgcn_mfma_f32_32x32x16_bf16(f1, pf[2], O[1], 0, 0, 0); DSR(f1, av3, 4096);
    LWAIT(3, f2); O[2] = __builtin_amdgcn_mfma_f32_32x32x16_bf16(f2, pf[2], O[2], 0, 0, 0); DSR(f2, av3, 8192);
    LWAIT(3, f3); O[3] = __builtin_amdgcn_mfma_f32_32x32x16_bf16(f3, pf[2], O[3], 0, 0, 0); DSR(f3, av3, 12288);
    LWAIT(3, f0); O[0] = __builtin_amdgcn_mfma_f32_32x32x16_bf16(f0, pf[3], O[0], 0, 0, 0);
    LWAIT(2, f1); O[1] = __builtin_amdgcn_mfma_f32_32x32x16_bf16(f1, pf[3], O[1], 0, 0, 0);
    LWAIT(1, f2); O[2] = __builtin_amdgcn_mfma_f32_32x32x16_bf16(f2, pf[3], O[2], 0, 0, 0);
    LWAIT(0, f3); O[3] = __builtin_amdgcn_mfma_f32_32x32x16_bf16(f3, pf[3], O[3], 0, 0, 0);
}
#undef DSR
#undef LWAIT
template <int BR>
DI float attn_mask_max(f32x16_t& s0, f32x16_t& s1, int j, int qb, int qoff, int hi, unsigned long long sel) {
    constexpr float C2 = 0.08838834764831845f * 1.4426950408889634f;
    const float NEGINF = -__builtin_inff();
    if (j == qb) {
#pragma unroll
        for (int r = 0; r < 16; ++r) { const int kk = (r & 3) + 8 * (r >> 2) + 4 * hi; if (kk > qoff) s0[r] = NEGINF; if (kk + 32 > qoff) s1[r] = NEGINF; }
    } else if (BR == 1) { const bool on = (sel >> j) & 1ull;
        if (!__all(on)) {
#pragma unroll
            for (int r = 0; r < 16; ++r) { s0[r] = on ? s0[r] : NEGINF; s1[r] = on ? s1[r] : NEGINF; } }
    } else if (j == qb - 8) {
#pragma unroll
        for (int r = 0; r < 16; ++r) { const int kk = (r & 3) + 8 * (r >> 2) + 4 * hi; if (kk <= qoff) s0[r] = NEGINF; if (kk + 32 <= qoff) s1[r] = NEGINF; }
    }
    float mx = s0[0];
#pragma unroll
    for (int r = 1; r < 16; ++r) mx = fmaxf(mx, s0[r]);
#pragma unroll
    for (int r = 0; r < 16; ++r) mx = fmaxf(mx, s1[r]);
    auto sw = __builtin_amdgcn_permlane32_swap(__float_as_uint(mx), __float_as_uint(mx), false, false);
    return fmaxf(__uint_as_float(sw[0]), __uint_as_float(sw[1])) * C2;
}
template <int BR>
DI void attn_branch(LASP unsigned char* ldsw, const bf16_t* yb, const bf16_t* vtb, int g, int qb, int half, int qi, int hi, int wid, int lane, const bf16x8_t (&qf)[8], unsigned long long sel, unsigned long long tiles, f32x16_t (&O)[4]) {
    constexpr float C2 = 0.08838834764831845f * 1.4426950408889634f;
    const LASP unsigned char* lds = ldsw;
    const bool grpB = wid >= 4;
    unsigned kgo[2], vgo[2];
#pragma unroll
    for (int i = 0; i < 2; ++i) { const int pp = (2 * wid + i) * 64 + lane; const int key = pp >> 4, c = (pp & 15) ^ (key & 15); kgo[i] = (unsigned)(key * (LDY * 2) + c * 16);
        const int d = pp >> 3, cv = (pp & 7) ^ ((d >> 1) & 7); vgo[i] = (unsigned)(d * (SEQ * 2) + cv * 16); }
    const char* kbase = (const char*)(yb + Y_KV + BR * 512 + g * 128);
    const char* vbase = (const char*)(vtb + (size_t)(BR - 1) * 128 * SEQ);
#define DMA_TILE(jj, buf) do { const char* kb_ = kbase + (size_t)(jj) * (64 * LDY * 2); const char* vb_ = vbase + (size_t)(jj) * 128; \
        _Pragma("unroll") for (int i_ = 0; i_ < 2; ++i_) { \
            __builtin_amdgcn_global_load_lds((const unsigned*)(kb_ + kgo[i_]), (LASP unsigned*)(ldsw + (buf) * 32768u + (unsigned)((2 * wid + i_) * 1024)), 16, 0, 0); \
            __builtin_amdgcn_global_load_lds((const unsigned*)(vb_ + vgo[i_]), (LASP unsigned*)(ldsw + (buf) * 32768u + 16384u + (unsigned)((2 * wid + i_) * 1024)), 16, 0, 0); } } while (0)
#define BAR_ONLY() do { asm volatile("" ::: "memory"); __builtin_amdgcn_s_barrier(); asm volatile("" ::: "memory"); } while (0)
#define WAIT_DMA(newest_in_flight) do { if (newest_in_flight) asm volatile("s_waitcnt vmcnt(4)" ::: "memory"); else asm volatile("s_waitcnt vmcnt(0)" ::: "memory"); } while (0)
    const int x = qi & 15, xh = x >> 1; const unsigned kra = (unsigned)(qi * 256 + (((hi ^ x) & 1) << 4));
    const int yv = (qi >> 1) & 7, yh = yv >> 1; const unsigned vra = (unsigned)(16384 + qi * 128 + (((hi ^ yv) & 1) << 4));
    const int qoff = 32 * half + qi;
    float m_run = -1.0e30f, l_run = 0.f;
#pragma unroll
    for (int dt = 0; dt < 4; ++dt)
#pragma unroll
        for (int r = 0; r < 16; ++r) O[dt][r] = 0.f;
    unsigned long long rem = tiles;
    int jc = __builtin_ctzll(rem); rem &= rem - 1;
    int j1 = rem ? __builtin_ctzll(rem) : -1; rem &= rem - 1;
    int j2 = rem ? __builtin_ctzll(rem) : -1; rem &= rem - 1;
    asm volatile("s_waitcnt vmcnt(0)" ::: "memory");
    DMA_TILE(jc, 0u);
    if (j1 >= 0) DMA_TILE(j1, 1u);
    if (j2 >= 0) DMA_TILE(j2, 2u);
    WAIT_DMA(j2 >= 0);
    BAR_ONLY();
    f32x16_t s0, s1;
    qk_tile_pipe(s0, s1, (unsigned)(uintptr_t)ldsw + kra, xh, qf);
    m_run = fmaxf(m_run, attn_mask_max<BR>(s0, s1, jc, qb, qoff, hi, sel));
    if (grpB) BAR_ONLY();
    unsigned cur = 0;
    for (;;) {
        const int j3 = rem ? __builtin_ctzll(rem) : -1; rem &= rem - 1;
        if (grpB && j3 >= 0) DMA_TILE(j3, ((cur + 3u) & 3u));
        float ps = 0.f;
#pragma unroll
        for (int r = 0; r < 16; ++r) { s0[r] = fast_exp2(s0[r] * C2 - m_run); s1[r] = fast_exp2(s1[r] * C2 - m_run); ps += s0[r] + s1[r]; }
        l_run += ps;
        bf16x8_t pf[4];
#pragma unroll
        for (int s = 0; s < 4; ++s) { const f32x16_t& sv = (s < 2) ? s0 : s1; const int o = (s & 1) * 8;
            typedef unsigned u4_t __attribute__((ext_vector_type(4))); u4_t ww = {pg8::cvt_pk_bf16(sv[o + 0], sv[o + 1]), pg8::cvt_pk_bf16(sv[o + 2], sv[o + 3]), pg8::cvt_pk_bf16(sv[o + 4], sv[o + 5]), pg8::cvt_pk_bf16(sv[o + 6], sv[o + 7])};
            pf[s] = *reinterpret_cast<bf16x8_t*>(&ww); }
        if (!grpB) WAIT_DMA(j2 >= 0);
        BAR_ONLY();
        if (!grpB && j3 >= 0) DMA_TILE(j3, ((cur + 3u) & 3u));
        __builtin_amdgcn_s_setprio(1);
        const unsigned lbase = (unsigned)(uintptr_t)ldsw;
        pv_tile_pipe(O, lbase + cur * 32768u + vra, yh, pf);
        if (j1 >= 0) qk_tile_pipe(s0, s1, lbase + ((cur + 1u) & 3u) * 32768u + kra, xh, qf);
        __builtin_amdgcn_s_setprio(0);
        if (grpB) WAIT_DMA(j3 >= 0);
        BAR_ONLY();
        if (j1 < 0) break;
        { const float mx = attn_mask_max<BR>(s0, s1, j1, qb, qoff, hi, sel);
          if (__any(mx > m_run + 8.f)) { const float m_new = fmaxf(m_run, mx), alpha = fast_exp2(m_run - m_new); m_run = m_new; l_run *= alpha;
#pragma unroll
              for (int dt = 0; dt < 4; ++dt)
#pragma unroll
                  for (int r = 0; r < 16; ++r) O[dt][r] *= alpha; } }
        cur = (cur + 1u) & 3u; jc = j1; j1 = j2; j2 = j3;
    }
    if (!grpB) BAR_ONLY();
    asm volatile("s_waitcnt vmcnt(0)" ::: "memory");
    BAR_ONLY();
#undef DMA_TILE
#undef BAR_ONLY
#undef WAIT_DMA
    float lt;
    { auto sw = __builtin_amdgcn_permlane32_swap(__float_as_uint(l_run), __float_as_uint(l_run), false, false); lt = __uint_as_float(sw[0]) + __uint_as_float(sw[1]); }
    const float inv = 1.f / lt;
#pragma unroll
    for (int dt = 0; dt < 4; ++dt)
#pragma unroll
        for (int r = 0; r < 16; ++r) O[dt][r] *= inv;
}
DI void st_attn_mm(const Params& p, int l, unsigned char* smem, const int WV) {
    const int TIDX = opq_tid(WV), BIDX = opq_bid();
    const int wid = __builtin_amdgcn_readfirstlane(TIDX >> 6), lane0 = TIDX & 63, rr = wid >> 1, half = wid & 1;
    const bf16_t* Y = (const bf16_t*)(p.ws + WS_Y); const float* OC = (const float*)(p.ws + WS_OCMP); const unsigned long long* SEL = (const unsigned long long*)(p.ws + WS_SEL);
    bf16_t* YM = (bf16_t*)(p.ws + WS_YMIX); const bf16_t* VT = (const bf16_t*)(p.ws + WS_VT);
    const LASP unsigned char* lds = (const LASP unsigned char*)smem;
    LASP unsigned long long* sor = (LASP unsigned long long*)(LASP unsigned char*)(smem + 131072);
    for (int item = BIDX; item < 256; item += gridDim.x) {
        const int bg = item & 7, pr = item >> 3, b = bg >> 1, g = bg & 1, h = g * 4 + rr;
        const bf16_t* yb = Y + (size_t)b * SEQ * LDY; const bf16_t* vtb = VT + (size_t)bg * 2 * 128 * SEQ;
#pragma unroll 1
        for (int pass = 0; pass < 2; ++pass) {
            int lane = lane0; asm volatile("" : "+v"(lane));
            const int qi = lane & 31, hi = lane >> 5;
            const int qb = pass ? pr : 63 - pr, t = qb * 64 + 32 * half + qi;
            const bf16_t* yrow = yb + (size_t)t * LDY;
            bf16x8_t qf[8];
#pragma unroll
            for (int ks = 0; ks < 8; ++ks) qf[ks] = *(const bf16x8_t*)(yrow + Y_QN + h * 128 + 16 * ks + 8 * hi);
            const unsigned long long sel = SEL[(size_t)bg * SEQ + t];
            { unsigned lo = (unsigned)sel, hi32 = (unsigned)(sel >> 32);
#pragma unroll
              for (int o = 1; o < 32; o <<= 1) { lo |= __shfl_xor(lo, o); hi32 |= __shfl_xor(hi32, o); }
              if (wid < 2 && lane == 0) sor[wid] = ((unsigned long long)hi32 << 32) | lo; }
            __syncthreads();
            const unsigned long long lowmask = (qb == 63) ? ~0ull : ((2ull << qb) - 1ull);
            const unsigned long long tiles_s = (sor[0] | sor[1] | 1ull | (1ull << qb)) & lowmask;
            const int jlo = qb >= 8 ? qb - 8 : 0; const unsigned long long tiles_w = lowmask & ~((1ull << jlo) - 1ull);
            f32x16_t O[4];
            const float* gp_ = (const float*)(p.ws + WS_GATEP) + ((size_t)b * SEQ + t) * 256 + h * 3;
            const float g0 = sigmoid_f(gp_[0] + gp_[(size_t)NT * 256]), g1 = sigmoid_f(gp_[1] + gp_[(size_t)NT * 256 + 1]), g2 = sigmoid_f(gp_[2] + gp_[(size_t)NT * 256 + 2]);
            const float* ocrow = OC + ((size_t)b * SEQ + t) * 1024 + h * 128 + 4 * hi; float* ptrow = (float*)(p.ws + WS_PART) + ((size_t)b * SEQ + t) * 1024 + h * 128 + 4 * hi;
            attn_branch<1>((LASP unsigned char*)smem, yb, vtb, g, qb, half, qi, hi, wid, lane, qf, sel, tiles_s, O);
            { float4 cc[16];
#pragma unroll
              for (int i = 0; i < 16; ++i) cc[i] = *(const float4*)(ocrow + 32 * (i >> 2) + 8 * (i & 3));
#pragma unroll
              for (int i = 0; i < 16; ++i) { const int dt = i >> 2, rq = i & 3; float4 c = cc[i];
                  c.x = g0 * c.x + g1 * O[dt][4 * rq + 0]; c.y = g0 * c.y + g1 * O[dt][4 * rq + 1]; c.z = g0 * c.z + g1 * O[dt][4 * rq + 2]; c.w = g0 * c.w + g1 * O[dt][4 * rq + 3];
                  *(float4*)(ptrow + 32 * dt + 8 * rq) = c; } }
            attn_branch<2>((LASP unsigned char*)smem, yb, vtb, g, qb, half, qi, hi, wid, lane, qf, sel, tiles_w, O);
            float ss = 0.f;
            { float4 cc[16];
#pragma unroll
              for (int i = 0; i < 16; ++i) cc[i] = *(const float4*)(ptrow + 32 * (i >> 2) + 8 * (i & 3));
#pragma unroll
              for (int i = 0; i < 16; ++i) { const int dt = i >> 2, rq = i & 3; const float4 c = cc[i];
                  O[dt][4 * rq + 0] = c.x + g2 * O[dt][4 * rq + 0]; O[dt][4 * rq + 1] = c.y + g2 * O[dt][4 * rq + 1]; O[dt][4 * rq + 2] = c.z + g2 * O[dt][4 * rq + 2]; O[dt][4 * rq + 3] = c.w + g2 * O[dt][4 * rq + 3];
                  ss += O[dt][4 * rq + 0] * O[dt][4 * rq + 0] + O[dt][4 * rq + 1] * O[dt][4 * rq + 1] + O[dt][4 * rq + 2] * O[dt][4 * rq + 2] + O[dt][4 * rq + 3] * O[dt][4 * rq + 3]; } }
            { auto sw = __builtin_amdgcn_permlane32_swap(__float_as_uint(ss), __float_as_uint(ss), false, false); ss = __uint_as_float(sw[0]) + __uint_as_float(sw[1]); }
            const float rn = rsqrtf(ss * (1.f / 128.f) + EPS);
            const float* ng = p.nsa_g + (size_t)l * 1024 + h * 128 + 4 * hi; bf16_t* orow = YM + ((size_t)b * SEQ + t) * DM + 512 + h * 128 + 4 * hi;
            { float4 gg[16];
#pragma unroll
              for (int i = 0; i < 16; ++i) gg[i] = *(const float4*)(ng + 32 * (i >> 2) + 8 * (i & 3));
#pragma unroll
              for (int i = 0; i < 16; ++i) { const int dt = i >> 2, rq = i & 3;
                  uint2 w; w.x = pg8::cvt_pk_bf16(O[dt][4 * rq + 0] * rn * gg[i].x, O[dt][4 * rq + 1] * rn * gg[i].y); w.y = pg8::cvt_pk_bf16(O[dt][4 * rq + 2] * rn * gg[i].z, O[dt][4 * rq + 3] * rn * gg[i].w);
                  *(uint2*)(orow + 32 * dt + 8 * rq) = w; } }
        }
    }
}

constexpr int RP = 136;
DI int kv_unit(int c, int i, int G) {
    if (G == 256) { if (c < 192) return i == 0 ? c : -1; return i < 5 ? 192 + (c - 192) * 5 + i : -1; }
    const int u = c + i * G; return u < 16 * 32 ? u : -1;
}
DI void st_kvchunk_mm(const Params& p, int l, unsigned char* smem, const int WV) {
    const int TIDX = opq_tid(WV), BIDX = opq_bid();
    const int wid = __builtin_amdgcn_readfirstlane(TIDX >> 6), lane = TIDX & 63, li = lane & 31, hi = lane >> 5;
    const bf16_t* Y = (const bf16_t*)(p.ws + WS_Y); float* KVC = (float*)(p.ws + WS_KVC);
    LDSF bf16_t* KT = (LDSF bf16_t*)smem; LDSF bf16_t* VTt = KT + 128 * RP;
    const int m = TIDX >> 2, seg = (TIDX & 3) * 32;
    uint4 kq[4], vq[4];
    const int G = gridDim.x; int u = kv_unit(BIDX, 0, G);
    if (u >= 0) { const int bh = u >> 5, c = u & 31, b = bh >> 2, h = bh & 3; const bf16_t* row = Y + ((size_t)b * SEQ + c * 128 + m) * LDY;
        const uint4* ks = (const uint4*)(row + Y_KR + h * 128 + seg); const uint4* vs = (const uint4*)(row + Y_VR + h * 128 + seg);
#pragma unroll
        for (int q4 = 0; q4 < 4; ++q4) { kq[q4] = ks[q4]; vq[q4] = vs[q4]; } }
    for (int it = 0; u >= 0; ++it) {
        const int bh = u >> 5, c = u & 31, h = bh & 3; const float lg = ret_loggamma(h);
        { const float z = __expf((float)(127 - m) * lg) * 0.08838834764831845f;
#pragma unroll
          for (int q4 = 0; q4 < 4; ++q4) { const uint4 kk = kq[q4], vv = vq[q4]; const unsigned kw[4] = {kk.x, kk.y, kk.z, kk.w}, vw[4] = {vv.x, vv.y, vv.z, vv.w};
#pragma unroll
              for (int i = 0; i < 4; ++i) { const int d = seg + q4 * 8 + 2 * i;
                  KT[d * RP + m] = f2bf(__uint_as_float(kw[i] << 16) * z); KT[(d + 1) * RP + m] = f2bf(__uint_as_float(kw[i] & 0xffff0000u) * z);
                  VTt[d * RP + m] = (bf16_t)(vw[i] & 0xffffu); VTt[(d + 1) * RP + m] = (bf16_t)(vw[i] >> 16); } } }
        const int un = kv_unit(BIDX, it + 1, G);
        { if (un >= 0) { const int bh2 = un >> 5, c2 = un & 31, b2 = bh2 >> 2, h2 = bh2 & 3; const bf16_t* row = Y + ((size_t)b2 * SEQ + c2 * 128 + m) * LDY;
              const uint4* ks = (const uint4*)(row + Y_KR + h2 * 128 + seg); const uint4* vs = (const uint4*)(row + Y_VR + h2 * 128 + seg);
#pragma unroll
              for (int q4 = 0; q4 < 4; ++q4) { kq[q4] = ks[q4]; vq[q4] = vs[q4]; } } }
        __syncthreads();
        const int db = wid & 3, eb0 = 2 * (wid >> 2);
        f32x16_t acc[2];
#pragma unroll
        for (int r = 0; r < 16; ++r) { acc[0][r] = 0.f; acc[1][r] = 0.f; }
#pragma unroll
        for (int ks = 0; ks < 8; ++ks) { const bf16x8_t a = *(const LDSF bf16x8_t*)(KT + (32 * db + li) * RP + 16 * ks + 8 * hi);
#pragma unroll
            for (int t = 0; t < 2; ++t) { const bf16x8_t bb = *(const LDSF bf16x8_t*)(VTt + (32 * (eb0 + t) + li) * RP + 16 * ks + 8 * hi); acc[t] = __builtin_amdgcn_mfma_f32_32x32x16_bf16(a, bb, acc[t], 0, 0, 0); } }
#pragma unroll
        for (int t = 0; t < 2; ++t) { float* orow = KVC + ((size_t)(bh * 32 + c) * 128 + 32 * (eb0 + t) + li) * 128 + 32 * db + 4 * hi;
#pragma unroll
            for (int rq = 0; rq < 4; ++rq) *(float4*)(orow + 8 * rq) = make_float4(acc[t][4 * rq], acc[t][4 * rq + 1], acc[t][4 * rq + 2], acc[t][4 * rq + 3]); }
        __syncthreads();
        u = un;
    }
}
DI void st_retout_mm(const Params& p, int l, unsigned char* smem, const int WV) {
    const int TIDX = opq_tid(WV), BIDX = opq_bid();
    const int wid = __builtin_amdgcn_readfirstlane(TIDX >> 6), lane = TIDX & 63, li = lane & 31, hi = lane >> 5, nb = wid & 3, eh = wid >> 2;
    const bf16_t* Y = (const bf16_t*)(p.ws + WS_Y); const bf16_t* STB = (const bf16_t*)(p.ws + WS_STATEB); bf16_t* YM = (bf16_t*)(p.ws + WS_YMIX);
    LDSF bf16_t* KL = (LDSF bf16_t*)smem; LDSF bf16_t* VL = KL + 128 * RP; LDSF bf16_t* SL = VL + 128 * RP; LDSF float* ssq = (LDSF float*)(SL + 128 * RP);
    typedef unsigned u4v_t __attribute__((ext_vector_type(4)));
    const int m = TIDX >> 2, seg = (TIDX & 3) * 32;
    u4v_t kq[4], sq[4]; uint4 vq[4]; bf16x8_t qn[8];
    if (BIDX < 16 * 32) { const int bh = BIDX >> 5, c = BIDX & 31, b = bh >> 2, h = bh & 3; const bf16_t* row = Y + ((size_t)b * SEQ + c * 128 + m) * LDY;
        const u4v_t* ks = (const u4v_t*)(row + Y_KR + h * 128 + seg); const uint4* vs = (const uint4*)(row + Y_VR + h * 128 + seg);
        const u4v_t* ss = (const u4v_t*)(STB + (size_t)(bh * 32 + c) * 16384 + (size_t)m * 128 + seg);
        const bf16_t* qrow = Y + ((size_t)b * SEQ + c * 128 + 32 * nb + li) * LDY;
#pragma unroll
        for (int q4 = 0; q4 < 4; ++q4) { kq[q4] = ks[q4]; sq[q4] = ss[q4]; vq[q4] = vs[q4]; }
#pragma unroll
        for (int ks2 = 0; ks2 < 8; ++ks2) qn[ks2] = *(const bf16x8_t*)(qrow + Y_QR + h * 128 + 16 * ks2 + 8 * hi); }
    for (int u = BIDX; u < 16 * 32; u += gridDim.x) {
        const int bh = u >> 5, c = u & 31, b = bh >> 2, h = bh & 3; const float lg2 = ret_loggamma(h) * 1.4426950408889634f;
        { const int pos = (m & ~15) | kperm16(m & 15);
#pragma unroll
          for (int q4 = 0; q4 < 4; ++q4) { *(LDSF u4v_t*)(KL + m * RP + seg + q4 * 8) = kq[q4]; *(LDSF u4v_t*)(SL + m * RP + seg + q4 * 8) = sq[q4];
              const uint4 vv = vq[q4]; const unsigned vw[4] = {vv.x, vv.y, vv.z, vv.w};
#pragma unroll
              for (int i = 0; i < 4; ++i) { const int e = seg + q4 * 8 + 2 * i; VL[e * RP + pos] = (bf16_t)(vw[i] & 0xffffu); VL[(e + 1) * RP + pos] = (bf16_t)(vw[i] >> 16); } } }
        const int n = 32 * nb + li; const bf16_t* qrow = Y + ((size_t)b * SEQ + c * 128 + n) * LDY;
        bf16x8_t qf[8];
#pragma unroll
        for (int ks = 0; ks < 8; ++ks) qf[ks] = qn[ks];
        { const int un = u + gridDim.x;
          if (un < 16 * 32) { const int bh2 = un >> 5, c2 = un & 31, b2 = bh2 >> 2, h2 = bh2 & 3; const bf16_t* row = Y + ((size_t)b2 * SEQ + c2 * 128 + m) * LDY;
              const u4v_t* ks = (const u4v_t*)(row + Y_KR + h2 * 128 + seg); const uint4* vs = (const uint4*)(row + Y_VR + h2 * 128 + seg);
              const u4v_t* ss = (const u4v_t*)(STB + (size_t)(bh2 * 32 + c2) * 16384 + (size_t)m * 128 + seg);
              const bf16_t* qrow2 = Y + ((size_t)b2 * SEQ + c2 * 128 + n) * LDY;
#pragma unroll
              for (int q4 = 0; q4 < 4; ++q4) { kq[q4] = ks[q4]; sq[q4] = ss[q4]; vq[q4] = vs[q4]; }
#pragma unroll
              for (int ks2 = 0; ks2 < 8; ++ks2) qn[ks2] = *(const bf16x8_t*)(qrow2 + Y_QR + h2 * 128 + 16 * ks2 + 8 * hi); } }
        __syncthreads();
        f32x16_t O[2];
#pragma unroll
        for (int r = 0; r < 16; ++r) { O[0][r] = 0.f; O[1][r] = 0.f; }
#pragma unroll
        for (int ks = 0; ks < 8; ++ks)
#pragma unroll
            for (int dt = 0; dt < 2; ++dt) { const bf16x8_t a = *(const LDSF bf16x8_t*)(SL + (64 * eh + 32 * dt + li) * RP + 16 * ks + 8 * hi); O[dt] = __builtin_amdgcn_mfma_f32_32x32x16_bf16(a, qf[ks], O[dt], 0, 0, 0); }
        { const float xi = fast_exp2((float)(n + 1) * lg2);
#pragma unroll
          for (int r = 0; r < 16; ++r) { O[0][r] *= xi; O[1][r] *= xi; } }
        for (int ms = 0; ms <= nb; ++ms) {
            f32x16_t s;
#pragma unroll
            for (int r = 0; r < 16; ++r) s[r] = 0.f;
#pragma unroll
            for (int ks = 0; ks < 8; ++ks) { const bf16x8_t a = *(const LDSF bf16x8_t*)(KL + (32 * ms + li) * RP + 16 * ks + 8 * hi); s = __builtin_amdgcn_mfma_f32_32x32x16_bf16(a, qf[ks], s, 0, 0, 0); }
#pragma unroll
            for (int r = 0; r < 16; ++r) { const int m = 32 * ms + (r & 3) + 8 * (r >> 2) + 4 * hi; const int df = n - m;
                s[r] = df >= 0 ? s[r] * 0.08838834764831845f * fast_exp2((float)df * lg2) : 0.f; }
#pragma unroll
            for (int sp = 0; sp < 2; ++sp) { const int o = sp * 8;
                typedef unsigned u4_t __attribute__((ext_vector_type(4))); u4_t ww = {pg8::cvt_pk_bf16(s[o + 0], s[o + 1]), pg8::cvt_pk_bf16(s[o + 2], s[o + 3]), pg8::cvt_pk_bf16(s[o + 4], s[o + 5]), pg8::cvt_pk_bf16(s[o + 6], s[o + 7])};
                const bf16x8_t pf = *reinterpret_cast<bf16x8_t*>(&ww);
#pragma unroll
                for (int dt = 0; dt < 2; ++dt) { const bf16x8_t a = *(const LDSF bf16x8_t*)(VL + (64 * eh + 32 * dt + li) * RP + 32 * ms + 16 * sp + 8 * hi); O[dt] = __builtin_amdgcn_mfma_f32_32x32x16_bf16(a, pf, O[dt], 0, 0, 0); } }
        }
        float ss = 0.f;
#pragma unroll
        for (int r = 0; r < 16; ++r) ss += O[0][r] * O[0][r] + O[1][r] * O[1][r];
        ss += __shfl_xor(ss, 32);
        if (hi == 0) ssq[wid * 32 + li] = ss;
        __syncthreads();
        const float rn = rsqrtf((ss + ssq[(wid ^ 4) * 32 + li]) * (1.f / 128.f) + EPS);
        const int e0 = 64 * eh + 4 * hi; const float* rg = p.ret_g + (size_t)l * 512 + h * 128 + e0; bf16_t* orow = YM + ((size_t)b * SEQ + c * 128 + n) * DM + 1536 + h * 128 + e0;
#pragma unroll
        for (int dt = 0; dt < 2; ++dt)
#pragma unroll
            for (int rq = 0; rq < 4; ++rq) { const int eo = 32 * dt + 8 * rq; const float4 gg = *(const float4*)(rg + eo); const uint2 gw = *(const uint2*)(qrow + Y_GR + h * 128 + e0 + eo);
                const float g0 = __uint_as_float(gw.x << 16), g1 = __uint_as_float(gw.x & 0xffff0000u), g2 = __uint_as_float(gw.y << 16), g3 = __uint_as_float(gw.y & 0xffff0000u);
                uint2 w; w.x = pg8::cvt_pk_bf16(silu_f(g0) * O[dt][4 * rq] * rn * gg.x, silu_f(g1) * O[dt][4 * rq + 1] * rn * gg.y);
                w.y = pg8::cvt_pk_bf16(silu_f(g2) * O[dt][4 * rq + 2] * rn * gg.z, silu_f(g3) * O[dt][4 * rq + 3] * rn * gg.w);
                *(uint2*)(orow + eo) = w; }
        __syncthreads();
    }
}

DI void st_cmpattn_mm(const Params& p, int l, unsigned char* smem, const int WV) {
    const int TIDX = opq_tid(WV), BIDX = opq_bid();
    const int wid = __builtin_amdgcn_readfirstlane(TIDX >> 6), lane = TIDX & 63, qi = lane & 31, hi = lane >> 5, rr = wid >> 1, half = wid & 1;
    constexpr float C2 = 0.08838834764831845f * 1.4426950408889634f;
    const float NEGINF = -__builtin_inff();
    const bf16_t* Y = (const bf16_t*)(p.ws + WS_Y); const bf16_t* KC = (const bf16_t*)(p.ws + WS_KC); const bf16_t* VCT = (const bf16_t*)(p.ws + WS_VC);
    float* OC = (float*)(p.ws + WS_OCMP); unsigned long long* SEL = (unsigned long long*)(p.ws + WS_SEL);
    const LASP unsigned char* lds = (const LASP unsigned char*)smem; LASP unsigned char* ldsw = (LASP unsigned char*)smem;
    int* impL = (int*)(smem + 131072);
    typedef unsigned u4v_t __attribute__((ext_vector_type(4)));
    const int skey = TIDX >> 3, scp = TIDX & 7; const unsigned kwa = (unsigned)(skey * 256 + (((2 * scp) ^ (skey & 15)) << 4));
    const int sd = TIDX >> 2, vcp = TIDX & 3; const unsigned vwa = (unsigned)(65536 + sd * 128 + (((2 * vcp) ^ ((sd >> 1) & 7)) << 4));
    const int x = qi & 15, xh = x >> 1; const unsigned kra = (unsigned)(qi * 256 + (((hi ^ x) & 1) << 4));
    const int yv = (qi >> 1) & 7, yh = yv >> 1; const unsigned vra = (unsigned)(65536 + qi * 128 + (((hi ^ yv) & 1) << 4));
    for (int item = BIDX; item < 256; item += gridDim.x) {
        const int bg = item & 7, pr = item >> 3, b = bg >> 1, g = bg & 1, h = g * 4 + rr;
#pragma unroll 1
        for (int pass = 0; pass < 2; ++pass) {
            const int qb = pass ? pr : 63 - pr, t = qb * 64 + 32 * half + qi;
            const int ntile = (4 * qb + 3 + 63) >> 6;
            const bf16_t* yrow = Y + ((size_t)b * SEQ + t) * LDY;
            bf16x8_t qf[8];
#pragma unroll
            for (int ks = 0; ks < 8; ++ks) qf[ks] = *(const bf16x8_t*)(yrow + Y_QN + h * 128 + 16 * ks + 8 * hi);
            for (int tl = 0; tl < ntile; ++tl) {
                const u4v_t* ks = (const u4v_t*)(KC + ((size_t)bg * 256 + tl * 64 + skey) * 128 + scp * 16); const u4v_t* vs = (const u4v_t*)(VCT + ((size_t)bg * 128 + sd) * 256 + tl * 64 + vcp * 16);
                const u4v_t k0 = ks[0], k1 = ks[1], v0 = vs[0], v1 = vs[1];
                *(LASP u4v_t*)(ldsw + tl * 16384 + kwa) = k0; *(LASP u4v_t*)(ldsw + tl * 16384 + (kwa ^ 16u)) = k1; *(LASP u4v_t*)(ldsw + tl * 16384 + vwa) = v0; *(LASP u4v_t*)(ldsw + tl * 16384 + (vwa ^ 16u)) = v1; }
            for (int i = TIDX; i < 64 * 64; i += 512) impL[i] = 0;
            __syncthreads();
            const int cmax = t >= 31 ? (t - 31) >> 4 : -1;
            float m_run = -1.0e30f, l_run = 0.f;
            for (int tl = 0; tl < ntile; ++tl) {
                f32x16_t s0, s1;
                qk_tile_pipe(s0, s1, (unsigned)(uintptr_t)lds + (unsigned)(tl * 16384) + kra, xh, qf);
                float mx = NEGINF;
#pragma unroll
                for (int r = 0; r < 16; ++r) { const int c = tl * 64 + (r & 3) + 8 * (r >> 2) + 4 * hi; s0[r] = c <= cmax ? s0[r] * C2 : NEGINF; s1[r] = c + 32 <= cmax ? s1[r] * C2 : NEGINF; mx = fmaxf(mx, fmaxf(s0[r], s1[r])); }
                mx = fmaxf(mx, __shfl_xor(mx, 32));
                const float m_new = fmaxf(m_run, mx); float ps = 0.f;
#pragma unroll
                for (int r = 0; r < 16; ++r) ps += fast_exp2(s0[r] - m_new) + fast_exp2(s1[r] - m_new);
                l_run = l_run * fast_exp2(m_run - m_new) + ps; m_run = m_new;
            }
            l_run += __shfl_xor(l_run, 32);
            const float inv = l_run > 0.f ? 1.f / l_run : 0.f;
            f32x16_t O[4];
#pragma unroll
            for (int dt = 0; dt < 4; ++dt)
#pragma unroll
                for (int r = 0; r < 16; ++r) O[dt][r] = 0.f;
            LASP int* imrow = (LASP int*)(LASP unsigned char*)(smem + 131072) + (32 * half + qi) * 64;
            for (int tl = 0; tl < ntile; ++tl) {
                f32x16_t s0, s1;
                qk_tile_pipe(s0, s1, (unsigned)(uintptr_t)lds + (unsigned)(tl * 16384) + kra, xh, qf);
#pragma unroll
                for (int r = 0; r < 16; ++r) { const int c = tl * 64 + (r & 3) + 8 * (r >> 2) + 4 * hi;
                    s0[r] = c <= cmax ? fast_exp2(s0[r] * C2 - m_run) * inv : 0.f; s1[r] = c + 32 <= cmax ? fast_exp2(s1[r] * C2 - m_run) * inv : 0.f; }
#pragma unroll
                for (int sub = 0; sub < 2; ++sub)
#pragma unroll
                    for (int rq = 0; rq < 4; ++rq) { const f32x16_t& sv = sub ? s1 : s0; const int j = 16 * tl + 8 * sub + 2 * rq + hi;
                        const float hp = 0.5f * sv[4 * rq + 3]; const int ia = (int)((sv[4 * rq] + sv[4 * rq + 1] + sv[4 * rq + 2] + hp) * 67108864.f + 0.5f), ib = (int)(hp * 67108864.f + 0.5f);
                        (void)__hip_atomic_fetch_add(imrow + j, ia, __ATOMIC_RELAXED, __HIP_MEMORY_SCOPE_WORKGROUP); if (j < 63) (void)__hip_atomic_fetch_add(imrow + j + 1, ib, __ATOMIC_RELAXED, __HIP_MEMORY_SCOPE_WORKGROUP); }
                bf16x8_t pf[4];
#pragma unroll
                for (int s = 0; s < 4; ++s) { const f32x16_t& sv = (s < 2) ? s0 : s1; const int o = (s & 1) * 8;
                    u4v_t ww = {pg8::cvt_pk_bf16(sv[o + 0], sv[o + 1]), pg8::cvt_pk_bf16(sv[o + 2], sv[o + 3]), pg8::cvt_pk_bf16(sv[o + 4], sv[o + 5]), pg8::cvt_pk_bf16(sv[o + 6], sv[o + 7])}; pf[s] = *reinterpret_cast<bf16x8_t*>(&ww); }
                pv_tile_pipe(O, (unsigned)(uintptr_t)lds + (unsigned)(tl * 16384) + vra, yh, pf);
            }
            { float* ocrow = OC + ((size_t)b * SEQ + t) * 1024 + h * 128 + 4 * hi;
#pragma unroll
              for (int dt = 0; dt < 4; ++dt)
#pragma unroll
                  for (int rq = 0; rq < 4; ++rq) *(float4*)(ocrow + 32 * dt + 8 * rq) = make_float4(O[dt][4 * rq], O[dt][4 * rq + 1], O[dt][4 * rq + 2], O[dt][4 * rq + 3]); }
            __syncthreads();
            for (int qq = 0; qq < 8; ++qq) { const int q = wid * 8 + qq, tq = qb * 64 + q, jq = qb, j = lane; const int* row = impL + q * 64;
                const int im = row[j]; const bool forced = (j == 0) || (j == jq) || (j == jq - 1); const int v = forced ? 0x7fffffff : (j <= jq ? im : -1);
                int rank = 0;
#pragma unroll 16
                for (int jj = 0; jj < 64; ++jj) { const int o = __builtin_amdgcn_readlane(v, jj); rank += (o > v || (o == v && jj < j)) ? 1 : 0; }
                const unsigned long long msk = __ballot(rank < 16);
                if (lane == 0) SEL[(size_t)bg * SEQ + tq] = msk; }
            __syncthreads();
        }
    }
}

namespace pg8 {
struct EpiF32Plain {
    static constexpr bool BP16 = false; static constexpr bool PERM = false, AFTER_DRAIN = false;
    float* C;
    __device__ __forceinline__ void operator()(const f32x4 (&acc)[2][2][4][2], const Unit& u, int wr, int wc, int fr, int fq) const {
        float* base = C + (size_t)(u.i0 + wr * 64 + fr) * 256 + wc * 32 + 4 * fq;
#pragma unroll
        for (int ai = 0; ai < 2; ++ai)
#pragma unroll
            for (int m = 0; m < 4; ++m) { float* rowp = base + (size_t)(ai * HALF + m * 16) * 256;
#pragma unroll
                for (int bj = 0; bj < 2; ++bj)
#pragma unroll
                    for (int n = 0; n < 2; ++n) *(f32x4*)(rowp + bj * HALF + n * 16) = acc[ai][bj][m][n]; }
    }
};
struct Cmp1Order {
    int G, c; const char* Y; const char* W;
    __device__ __forceinline__ bool next(int i, Unit& u) const {
        const int L = i * G + c; if (L >= 64) return false;
        const int kv = L >> 5, bg = (L >> 2) & 7, ks = L & 3, b = bg >> 1, g = bg & 1;
        u.A = Y + ((size_t)b * SEQ * LDY + (size_t)ks * 8 * LDY + Y_KV + kv * 256 + g * 128) * 2;
        u.B = W + ((size_t)kv * 256 * 4096 + (size_t)ks * 1024) * 2; u.i0 = (ks * 16 + kv * 8 + bg) * 256; u.i1 = 0; return true;
    }
    __device__ __forceinline__ void a_ready(const Unit&) const {}
    __device__ __forceinline__ void done(const Unit&) const {}
};
}
DI void st_cmp1_mm(const Params& p, int l, unsigned char* smem, const int WV) {
    const int TIDX = opq_tid(WV), BIDX = opq_bid();
    pg8::Cmp1Order S; S.G = gridDim.x; S.c = BIDX; S.Y = (const char*)(p.ws + WS_Y); S.W = (const char*)wl_ptr(p, l, WL_CW1);
    pg8::EpiF32Plain E{(float*)(p.ws + WS_CP)};
    pg8::gemm_phase((PG8_LAS unsigned char*)smem, 1024, S, E, TIDX, (size_t)16 * LDY * 2, (size_t)LDY * 2, (size_t)4096 * 2);
}
DI void st_slots(const Params& p, int l, unsigned char* smem, const int WV) {
    const int TIDX = opq_tid(WV), BIDX = opq_bid();
    const int* TOPE = (const int*)(p.ws + WS_TOPE); const int* RANK = (const int*)(p.ws + WS_RANK); int* SLOT = (int*)(p.ws + WS_SLOT); int* TOKOF = (int*)(p.ws + WS_TOKOF);
    const unsigned* CNT = (const unsigned*)(p.ws + WS_CTL) + CW_CNT + l * 64;
    int* po = (int*)smem; pad_offsets(CNT, po, WV);
    for (int i = BIDX * 512 + TIDX; i < NT * 8; i += gridDim.x * 512) { const int slot = po[TOPE[i]] + RANK[i]; SLOT[i] = slot; TOKOF[slot] = i >> 3; }
    for (int e = BIDX; e < 64; e += gridDim.x) { const int a = po[e] + (int)CNT[e], b = po[e + 1]; for (int s = a + TIDX; s < b; s += 512) TOKOF[s] = 0; }
}

namespace pg8 {
struct RouterOrder {
    int G, c; const char* H; const char* HLO; const char* W;
    __device__ __forceinline__ bool next(int i, Unit& u) const {
        const int L = i * G + c; if (L >= 256) return false;
        const int kq = L & 3, pm = L >> 2;
        u.A = H + ((size_t)pm * 256 * DM + (size_t)kq * 512) * 2; u.B = W + (size_t)kq * 512 * 2; u.i0 = kq * NT + pm * 256; u.i1 = 0; return true;
    }
    __device__ __forceinline__ void a_ready(const Unit&) const {}
    __device__ __forceinline__ void done(const Unit&) const {}
};
}
DI void st_rlogit_mm(const Params& p, int l, unsigned char* smem, const int WV) {
    const int TIDX = opq_tid(WV), BIDX = opq_bid();
    pg8::RouterOrder S; S.G = gridDim.x; S.c = BIDX; S.H = (const char*)(p.ws + WS_H); S.HLO = (const char*)(p.ws + WS_HLO); S.W = (const char*)wl_ptr(p, l, WL_RTH);
    pg8::EpiF32Plain E{(float*)(p.ws + WS_LOGP)};
    pg8::gemm_phase((PG8_LAS unsigned char*)smem, 512, S, E, TIDX, (size_t)DM * 2, 256, (size_t)DM * 2);
}
DI void st_route(const Params& p, int l, unsigned char* smem, const int WV, const int cnt_l_off = 0) {
    const int TIDX = opq_tid(WV), BIDX = opq_bid();
    const int wave = __builtin_amdgcn_readfirstlane(TIDX >> 6), lane = TIDX & 63;
    const float* LP = (const float*)(p.ws + WS_LOGP);
    int* TOPE = (int*)(p.ws + WS_TOPE); float* TOPW = (float*)(p.ws + WS_TOPW); int* RANK = (int*)(p.ws + WS_RANK); unsigned* CNT = (unsigned*)(p.ws + WS_CTL) + CW_CNT + (l + cnt_l_off) * 64;
    unsigned* lcnt = (unsigned*)smem; unsigned* lbase = lcnt + 64;
    if (TIDX < 64) lcnt[TIDX] = 0u;
    __syncthreads();
    const float rbias = p.router_bias[l * 64 + lane];
    for (int t = BIDX * 8 + wave; t < NT; t += gridDim.x * 8) {
        float logit = 0.f;
#pragma unroll
        for (int q = 0; q < 4; ++q) logit += LP[(size_t)(q * NT + t) * 256 + lane] + LP[(size_t)(q * NT + t) * 256 + 64 + lane];
        const float score = sigmoid_f(logit); const float biased = score + rbias;
        int rk = 0; const int gb = lane & ~7;
#pragma unroll
        for (int j = 0; j < 8; ++j) { const float o = __shfl(biased, gb + j); rk += (o > biased || (o == biased && (gb + j) < lane)) ? 1 : 0; }
        float gsum = rk < 2 ? biased : 0.f; gsum += __shfl_xor(gsum, 1); gsum += __shfl_xor(gsum, 2); gsum += __shfl_xor(gsum, 4);
        int grk = 0; const int myg = lane >> 3;
#pragma unroll
        for (int gg = 0; gg < 8; ++gg) { const float o = __shfl(gsum, gg * 8); grk += (o > gsum || (o == gsum && gg < myg)) ? 1 : 0; }
        const float masked = grk < 4 ? biased : -__builtin_inff();
        int erk = 0;
#pragma unroll 16
        for (int j = 0; j < 64; ++j) { const float o = __uint_as_float(__builtin_amdgcn_readlane(__float_as_uint(masked), j)); erk += (o > masked || (o == masked && j < lane)) ? 1 : 0; }
        const bool selx = erk < 8; const float wsum = wave_sum(selx ? score : 0.f);
        if (selx) { const unsigned rr = atomicAdd(lcnt + lane, 1u);
            TOPE[(size_t)t * 8 + erk] = lane; TOPW[(size_t)t * 8 + erk] = 2.5f * score / wsum; RANK[(size_t)t * 8 + erk] = (int)rr; }
    }
    __syncthreads();
    if (TIDX < 64) lbase[TIDX] = lcnt[TIDX] ? atomicAdd(CNT + TIDX, lcnt[TIDX]) : 0u;
    asm volatile("s_waitcnt vmcnt(0)" ::: "memory");
    __syncthreads();
    for (int t = BIDX * 8 + wave; t < NT; t += gridDim.x * 8)
        if (lane < 8) { const int e = TOPE[(size_t)t * 8 + lane]; const int rk = RANK[(size_t)t * 8 + lane] + (int)lbase[e]; RANK[(size_t)t * 8 + lane] = rk;
            ((int*)(p.ws + WS_XS))[(size_t)e * NT + rk] = t; }
}

namespace pg8 {
struct GateOrder {
    int G, c; const char* H; const char* W;
    __device__ __forceinline__ bool next(int i, Unit& u) const {
        const int cc = G >= 192 ? (c >= 64 ? c - 64 : c + G - 64) : c;
        const int L = i * G + cc; if (L >= 128) return false;
        const int kh = L & 1, pm = L >> 1;
        u.A = H + ((size_t)pm * 256 * DM + (size_t)kh * 1024) * 2; u.B = W + ((size_t)6144 * DM + (size_t)kh * 1024) * 2; u.i0 = kh * NT + pm * 256; u.i1 = 0; return true;
    }
    __device__ __forceinline__ void a_ready(const Unit&) const {}
    __device__ __forceinline__ void done(const Unit&) const {}
};
}
DI void st_gate_mm(const Params& p, int l, unsigned char* smem, const int WV) {
    const int TIDX = opq_tid(WV), BIDX = opq_bid();
    pg8::GateOrder S; S.G = gridDim.x; S.c = BIDX; S.H = (const char*)(p.ws + WS_H); S.W = (const char*)wl_ptr(p, l, WL_WIN);
    pg8::EpiF32Plain E{(float*)(p.ws + WS_GATEP)};
    pg8::gemm_phase((PG8_LAS unsigned char*)smem, 1024, S, E, TIDX, (size_t)DM * 2, 256, (size_t)DM * 2);
}


#define XB_TMO      128
#define XB_XCNT(j)  (256  + 64 * (j))
#define XB_XSUB(j)  (1280 + 64 * (j))
#define XB_XGEN(j)  (2304 + 64 * (j))
#define XB_TOP      3328
#define XB_TOPGEN   3392
#define XCD_BAR_WORDS 3456
#define XB_SPIN_CAP (1u << 18)
#define LAS __attribute__((address_space(3)))

__device__ __forceinline__ unsigned xb_ld(unsigned* p)              { return __hip_atomic_load(p, __ATOMIC_RELAXED, __HIP_MEMORY_SCOPE_AGENT); }
__device__ __forceinline__ unsigned xb_add(unsigned* p, unsigned v) { return __hip_atomic_fetch_add(p, v, __ATOMIC_RELAXED, __HIP_MEMORY_SCOPE_AGENT); }
__device__ __forceinline__ unsigned xb_xcc_id() { return (unsigned)__builtin_amdgcn_s_getreg((3 << 11) | 20) & 0xFu; }
#define XB_SPIN(cond, bar) do { unsigned _sp = 0; while (cond) { __builtin_amdgcn_s_sleep(1); \
    if ((++_sp & 255u) == 0u) { if (xb_ld(&(bar)[XB_TMO])) break; if (_sp > XB_SPIN_CAP) { atomicAdd(&(bar)[XB_TMO], 1u); break; } } } } while (0)

struct XcdBarrier {
    bool t0;
    unsigned* bar; unsigned x;
    volatile LAS unsigned* st;
};

__device__ __forceinline__ XcdBarrier xcd_barrier_post(unsigned* bar, volatile LAS unsigned* st) {
    XcdBarrier b; b.bar = bar; b.x = xb_xcc_id(); b.st = st;
    if (threadIdx.x == 0) (void)xb_add(&bar[XB_XCNT(b.x)], 1u);
    return b;
}
__device__ __forceinline__ void xcd_barrier_complete(unsigned* bar, unsigned x, unsigned& nloc, unsigned& nx) {
    const unsigned G = gridDim.x * gridDim.y * gridDim.z;
    unsigned sum, cnt, mine, sp = 0u;
    for (;;) {
        sum = 0u; cnt = 0u; mine = 0u;
#pragma unroll
        for (unsigned j = 0; j < 16; ++j) { const unsigned c = xb_ld(&bar[XB_XCNT(j)]); sum += c; cnt += (c > 0u) ? 1u : 0u; mine = (j == x) ? c : mine; }
        if (sum == G) break;
        __builtin_amdgcn_s_sleep(1);
        if ((++sp & 255u) == 0u) { if (xb_ld(&bar[XB_TMO])) break; if (sp > XB_SPIN_CAP) { atomicAdd(&bar[XB_TMO], 1u); break; } }
    }
    nloc = mine > 0u ? mine : 1u; nx = cnt > 0u ? cnt : 1u;
}

__device__ __forceinline__ void xcd_barrier(const XcdBarrier& b) {
    asm volatile("s_waitcnt vmcnt(0)" ::: "memory");
    __syncthreads();
    if (b.t0) {
        unsigned* bar = b.bar;
        __builtin_amdgcn_s_waitcnt(0);
        unsigned nloc = b.st[0], nx = b.st[1];
        if (nloc == 0u) { xcd_barrier_complete(bar, b.x, nloc, nx); b.st[0] = nloc; b.st[1] = nx; }
        const unsigned old = xb_add(&bar[XB_XSUB(b.x)], 1u);
        const unsigned gen = old / nloc;
        if (old + 1u == (gen + 1u) * nloc) {
            __builtin_amdgcn_fence(__ATOMIC_RELEASE, "agent");
            asm volatile("s_waitcnt vmcnt(0)" ::: "memory");
            const unsigned og = xb_add(&bar[XB_TOP], 1u);
            const unsigned tg = og / nx;
            if (og + 1u == (tg + 1u) * nx) xb_add(&bar[XB_TOPGEN], 1u);
            else XB_SPIN(xb_ld(&bar[XB_TOPGEN]) == tg, bar);
            __builtin_amdgcn_fence(__ATOMIC_ACQUIRE, "agent");
            xb_add(&bar[XB_XGEN(b.x)], 1u);
            asm volatile("s_waitcnt vmcnt(0)" ::: "memory");
        } else {
            XB_SPIN(xb_ld(&bar[XB_XGEN(b.x)]) == gen, bar);
            __builtin_amdgcn_fence(__ATOMIC_ACQUIRE, "agent");
            asm volatile("s_waitcnt vmcnt(0)" ::: "memory");
        }
    }
    __syncthreads();
}


DI void launder(Params& q, int& l) {
    long z = 0; asm volatile("" : "+s"(z));
#define L_(f) q.f = (decltype(q.f))((const char*)q.f + z)
    L_(x); L_(c); L_(pos); L_(ada_w); L_(ada_b); L_(norm1_g); L_(norm2_g); L_(w_in); L_(conv_w); L_(conv_g); L_(cmp_pe); L_(cmp_w1); L_(cmp_w2); L_(nsa_g); L_(ret_g); L_(w_out);
    L_(router_w); L_(router_bias); L_(exp_w_gu); L_(exp_w_down); L_(shared_w_gu); L_(shared_w_down); L_(final_g);
#undef L_
    q.out = (float*)((char*)q.out + z); q.ws = q.ws + z;
    asm volatile("" : "+s"(l));
}
constexpr int CW_BAR = 16384;
constexpr int SMEM_MEGA = 152 * 1024;
__global__ void __launch_bounds__(512, 2) k_mega(Params p) {
    extern __shared__ __attribute__((aligned(16))) unsigned char smem[];
    volatile LAS unsigned* bst = (volatile LAS unsigned*)(smem + LDS_BST);
    const int WV = __builtin_amdgcn_readfirstlane(threadIdx.x >> 6);
    if (threadIdx.x < 4) bst[threadIdx.x] = 0u;
    __syncthreads();
    (void)xcd_barrier_post((unsigned*)(p.ws + WS_CTL) + CW_BAR, bst);
#define GRID_BAR() do { Params q = p; int l_ = 0; launder(q, l_); XcdBarrier b_; b_.t0 = (opq_tid(WV) == 0); b_.bar = (unsigned*)(q.ws + WS_CTL) + CW_BAR; b_.x = xb_xcc_id(); b_.st = bst; xcd_barrier(b_); if (MK_PROBE == 18) xcd_barrier(b_); } while (0)
#define STG(call) do { Params q = p; launder(q, l); call; } while (0)
#define REP(n, call) do { if (MK_PROBE == (n)) { STG(call); __syncthreads(); } } while (0)
    { int l = 0; REP(1, st_convert(q, smem, WV)); STG(st_convert(q, smem, WV)); __syncthreads(); REP(17, st_mod(q, smem, WV)); STG(st_mod(q, smem, WV)); GRID_BAR(); REP(17, st_norm(q, 0, q.x, 0, smem, WV)); STG(st_norm(q, 0, q.x, 0, smem, WV)); GRID_BAR(); }
#pragma clang loop unroll(disable)
    for (int l0 = 0; l0 < NL; ++l0) {
        int l = l0;
        REP(8, st_inproj_mm(q, l, smem, WV)); STG(st_inproj_mm(q, l, smem, WV)); GRID_BAR();
        REP(20, st_post(q, l, smem, WV)); REP(20, st_post(q, l, smem, WV, -1.f)); STG(st_post(q, l, smem, WV)); __syncthreads(); REP(15, st_vt(q, l, smem, WV)); STG(st_vt(q, l, smem, WV)); GRID_BAR();
        REP(2, st_cmp1_mm(q, l, smem, WV)); STG(st_cmp1_mm(q, l, smem, WV)); STG(st_gate_mm(q, l, smem, WV)); __syncthreads(); REP(16, st_kvchunk_mm(q, l, smem, WV)); STG(st_kvchunk_mm(q, l, smem, WV)); GRID_BAR();
        REP(16, st_cmp2(q, l, smem, WV)); REP(16, st_scan(q, l, WV)); STG(st_cmp2(q, l, smem, WV)); STG(st_scan(q, l, WV)); GRID_BAR();
        REP(12, st_cmpattn_mm(q, l, smem, WV)); REP(24, st_retout_mm(q, l, smem, WV)); STG(st_cmpattn_mm(q, l, smem, WV)); __syncthreads(); STG(st_retout_mm(q, l, smem, WV)); GRID_BAR();
        REP(14, st_attn_mm(q, l, smem, WV)); STG(st_attn_mm(q, l, smem, WV)); GRID_BAR();
        REP(13, st_outproj_mm(q, l, q.x, l == 0 ? (const bf16_t*)nullptr : (const bf16_t*)(q.ws + WS_X2), smem, WV)); STG(st_outproj_mm(q, l, q.x, l == 0 ? (const bf16_t*)nullptr : (const bf16_t*)(q.ws + WS_X2), smem, WV)); GRID_BAR();
        REP(17, st_norm(q, l, (const float*)(q.ws + WS_X1), 1, smem, WV)); STG(st_norm(q, l, (const float*)(q.ws + WS_X1), 1, smem, WV)); GRID_BAR();
        REP(23, st_rlogit_mm(q, l, smem, WV)); STG(st_rlogit_mm(q, l, smem, WV)); GRID_BAR();
        REP(25, st_route(q, l, smem, WV, 2)); STG(st_route(q, l, smem, WV)); GRID_BAR();
        REP(9, st_gemm1_mm(q, l, smem, WV)); STG(st_gemm1_mm(q, l, smem, WV)); GRID_BAR();
        REP(10, st_gemm2_mm(q, l, smem, WV)); STG(st_gemm2_mm(q, l, smem, WV)); GRID_BAR();
        REP(7, st_combine(q, l, smem, WV)); REP(11, st_combine(q, l, smem, WV)); STG(st_combine(q, l, smem, WV)); if (l0 + 1 < NL) GRID_BAR();
    }
#undef STG
#undef GRID_BAR
}
extern "C" void kernel_launch(void* const* d_in, const int* in_sizes, int n_in, void* d_out, int out_size, void* d_ws, size_t ws_size, hipStream_t stream) {
    if (n_in != 23 || ws_size < WS_END) { fprintf(stderr, "kernel_launch: unexpected n_in %d or ws_size %zu < %zu\n", n_in, ws_size, (size_t)WS_END); return; }
    Params p; memset(&p, 0, sizeof(p));
    p.x = (const float*)d_in[0]; p.c = (const float*)d_in[1]; p.pos = (const int*)d_in[2];
    p.ada_w = (const float*)d_in[3]; p.ada_b = (const float*)d_in[4]; p.norm1_g = (const float*)d_in[5]; p.norm2_g = (const float*)d_in[6]; p.w_in = (const float*)d_in[7];
    p.conv_w = (const float*)d_in[8]; p.conv_g = (const float*)d_in[9]; p.cmp_pe = (const float*)d_in[10]; p.cmp_w1 = (const float*)d_in[11]; p.cmp_w2 = (const float*)d_in[12];
    p.nsa_g = (const float*)d_in[13]; p.ret_g = (const float*)d_in[14]; p.w_out = (const float*)d_in[15]; p.router_w = (const float*)d_in[16]; p.router_bias = (const float*)d_in[17];
    p.exp_w_gu = (const float*)d_in[18]; p.exp_w_down = (const float*)d_in[19]; p.shared_w_gu = (const float*)d_in[20]; p.shared_w_down = (const float*)d_in[21]; p.final_g = (const float*)d_in[22];
    p.out = (float*)d_out; p.ws = (unsigned char*)d_ws;
    (void)hipMemsetAsync((char*)d_ws + WS_CTL, 0, 1 * MiB, stream);
    static int grid = 0;
    if (!grid) {
        int dev = 0, cus = 0, per_cu = 0;
        (void)hipGetDevice(&dev); (void)hipDeviceGetAttribute(&cus, hipDeviceAttributeMultiprocessorCount, dev);
        (void)hipFuncSetAttribute((const void*)k_mega, hipFuncAttributeMaxDynamicSharedMemorySize, SMEM_MEGA);
        if (hipOccupancyMaxActiveBlocksPerMultiprocessor(&per_cu, (const void*)k_mega, 512, SMEM_MEGA) != hipSuccess || per_cu < 1) { fprintf(stderr, "kernel_launch: occupancy query says %d\n", per_cu); (void)hipGetLastError(); }
        grid = cus > 0 ? cus : 256;
    }
    hipLaunchKernelGGL(k_mega, dim3(grid), dim3(512), SMEM_MEGA, stream, p);
}
```

```cpp
#include <hip/hip_runtime.h>
#include <stdint.h>
#include <stdio.h>
#include <string.h>
#ifndef MK_PROBE
#define MK_PROBE 0
#endif

typedef unsigned short bf16_t;
#define DI __device__ __forceinline__
#define LDS_WAIT() asm volatile("s_waitcnt lgkmcnt(0)" ::: "memory")

constexpr int NB = 4, SEQ = 4096, DM = 2048, NT = NB * SEQ, NL = 2;
constexpr int HD = 128;
constexpr int D_IN = 6168, LDY = 6400;
constexpr int Y_CB = 0, Y_CC = 512, Y_CU = 1024, Y_QN = 1536, Y_KV = 2560, Y_QR = 4096, Y_KR = 4608, Y_VR = 5120, Y_GR = 5632, Y_GATE = 6144;
constexpr int NEXP = 64, TOPK = 8, DEXP = 512;
constexpr int NSLOT = 576 * 256;
constexpr int NROWS_E = NSLOT + NT;
constexpr float EPS = 1e-6f;
constexpr int NCMP = 255;

constexpr size_t MiB = 1ull << 20;
constexpr size_t WS_CTL = 0;
constexpr size_t WS_MOD = 1 * MiB;
constexpr size_t WS_CMPB = WS_MOD + 512 * 1024;
constexpr size_t WS_W = 2 * MiB;
constexpr size_t WL_WIN = 0;
constexpr size_t WL_WOUT = WL_WIN + (size_t)LDY * DM * 2;
constexpr size_t WL_CW1 = WL_WOUT + (size_t)DM * DM * 2;
constexpr size_t WL_CW2 = WL_CW1 + (size_t)2 * 256 * 4096 * 2;
constexpr size_t WL_RTH = WL_CW2 + (size_t)2 * 128 * 256 * 2;
constexpr size_t WL_RTL = WL_RTH + (size_t)64 * DM * 2;
constexpr size_t WL_RTZ = WL_RTL + (size_t)64 * DM * 2;
constexpr size_t WL_EGU = WL_RTZ + (size_t)128 * DM * 2;
constexpr size_t WL_EDN = WL_EGU + (size_t)65 * 1024 * DM * 2;
constexpr size_t WL_END = WL_EDN + (size_t)65 * DM * 512 * 2;
constexpr size_t WL_STRIDE = 429 * MiB;
static_assert(WL_END <= WL_STRIDE, "layer weights");
constexpr size_t WS_H = WS_W + NL * WL_STRIDE;
constexpr size_t WS_HLO = WS_H + (size_t)NT * DM * 2;
constexpr size_t WS_Y = WS_HLO + (size_t)NT * DM * 2;
constexpr size_t WS_YMIX = WS_Y + (size_t)NT * LDY * 2;
constexpr size_t WS_X1 = WS_YMIX + (size_t)NT * DM * 2;
constexpr size_t WS_X2 = WS_X1 + (size_t)NT * DM * 4;
constexpr size_t WS_OCMP = WS_X2 + (size_t)NT * DM * 4;
constexpr size_t WS_SEL = WS_OCMP + (size_t)NT * 1024 * 4;
constexpr size_t WS_HID = WS_SEL + (size_t)NB * 2 * SEQ * 8;
constexpr size_t WS_KC = WS_HID + (size_t)2 * 8 * 256 * 256 * 2;
constexpr size_t WS_VC = WS_KC + (size_t)8 * 256 * 128 * 2;
constexpr size_t WS_KVC = WS_VC + (size_t)8 * 256 * 128 * 2;
constexpr size_t WS_STATE = WS_KVC + (size_t)16 * 32 * 16384 * 4;
constexpr size_t WS_TOPE = WS_STATE + (size_t)16 * 32 * 16384 * 4;
constexpr size_t WS_TOPW = WS_TOPE + (size_t)NT * 8 * 4;
constexpr size_t WS_RANK = WS_TOPW + (size_t)NT * 8 * 4;
constexpr size_t WS_SLOT = WS_RANK + (size_t)NT * 8 * 4;
constexpr size_t WS_XS = WS_SLOT + (size_t)NT * 8 * 4;
constexpr size_t WS_GU = WS_XS + (size_t)NSLOT * DM * 2;
constexpr size_t WS_ACT = WS_GU + (size_t)NROWS_E * 1024 * 2;
constexpr size_t WS_YS = WS_ACT + (size_t)NROWS_E * 512 * 2;
constexpr size_t WS_VT = WS_YS + (size_t)NROWS_E * DM * 2;
constexpr size_t WS_STATEB = WS_VT + (size_t)NB * 2 * 2 * 128 * SEQ * 2;
constexpr size_t WS_PART = WS_STATEB + (size_t)16 * 32 * 16384 * 2;
constexpr size_t WS_TOKOF = WS_PART + (size_t)NT * 1024 * 4;
constexpr size_t WS_LOGP = WS_TOKOF + (size_t)NSLOT * 4;
constexpr size_t WS_CP = WS_LOGP + (size_t)4 * NT * 256 * 4;
constexpr size_t WS_GATEP = WS_CP + (size_t)4 * 16 * 256 * 256 * 4;
constexpr size_t WS_END = WS_GATEP + (size_t)2 * NT * 256 * 4;
constexpr int CW_CNT = 8192;

struct Params {
    const float *x, *c; const int* pos;
    const float *ada_w, *ada_b, *norm1_g, *norm2_g, *w_in, *conv_w, *conv_g, *cmp_pe, *cmp_w1, *cmp_w2, *nsa_g, *ret_g, *w_out,
                *router_w, *router_bias, *exp_w_gu, *exp_w_down, *shared_w_gu, *shared_w_down, *final_g;
    float* out; unsigned char* ws;
};

DI float bf2f(bf16_t b) { return __uint_as_float(((unsigned)b) << 16); }
DI bf16_t f2bf(float f) { unsigned u = __float_as_uint(f); u += 0x7fffu + ((u >> 16) & 1u); return (bf16_t)(u >> 16); }
DI unsigned pk2(float lo, float hi) { return (unsigned)f2bf(lo) | ((unsigned)f2bf(hi) << 16); }
DI float wave_sum(float v) {
#pragma unroll
    for (int o = 1; o < 64; o <<= 1) v += __shfl_xor(v, o);
    return v;
}
DI float wave_max(float v) {
#pragma unroll
    for (int o = 1; o < 64; o <<= 1) v = fmaxf(v, __shfl_xor(v, o));
    return v;
}
DI int kperm16(int k) { return (k & ~12) | ((k & 4) << 1) | ((k & 8) >> 1); }
DI float silu_f(float v) { return v / (1.f + __expf(-v)); }
DI float sigmoid_f(float v) { return 1.f / (1.f + __expf(-v)); }
DI float gelu_tanh_f(float v) { const float u = 0.7978845608028654f * (v + 0.044715f * v * v * v); return 0.5f * v * (1.f + tanhf(u)); }
DI bf16_t* wl_ptr(const Params& p, int l, size_t off) { return (bf16_t*)(p.ws + WS_W + (size_t)l * WL_STRIDE + off); }
DI float* mod_ptr(const Params& p, int l, int b, int chunk) { return (float*)(p.ws + WS_MOD) + ((size_t)(l * NB + b) * 6 + chunk) * DM; }
DI float ret_loggamma(int h) { return h == 0 ? -0.0317486983145803f : (h == 1 ? -0.015748356968139168f : (h == 2 ? -0.007843177461025893f : -0.003913899321136329f)); }
DI float ret_chunkdecay(int h) { return h == 0 ? 0.01718302357081791f : (h == 1 ? 0.13321516287964844f : (h == 2 ? 0.3664377159220373f : 0.6059370882290803f)); }

DI int opq_tid(const int WV) { unsigned z = 0u; asm volatile("" : "+v"(z)); int t = (WV << 6) | (int)__builtin_amdgcn_mbcnt_hi(~0u, __builtin_amdgcn_mbcnt_lo(~0u, z)); asm volatile("" : "+v"(t)); return t; }
DI int opq_bid() { int b = blockIdx.x; asm volatile("" : "+s"(b)); return b; }
DI int maprow(int kind, int n) {
    if (kind == 1) return n < 4096 ? n : (n < 4120 ? n + 2048 : n - 24);
    if (kind == 2) { if (n < 512) return (n >> 7) * 256 + (n & 127); const int j = n - 512; return (j >> 7) * 256 + 128 + (j & 127); }
    return n;
}
DI void tr_item(const float* __restrict__ W, int ldw, int ncols, int Kd, bf16_t* WT, int k0, int n0, int kind, float* scr, int lane) {
    const int n4 = (lane & 15) * 4, kr = lane >> 4; const bool inb = (n0 + n4) < ncols;
    float4 v[16];
#pragma unroll
    for (int i = 0; i < 16; ++i) { typedef float f4v_t __attribute__((ext_vector_type(4))); if (inb) { const f4v_t t_ = __builtin_nontemporal_load((const f4v_t*)(W + (size_t)(k0 + 4 * i + kr) * ldw + n0 + n4)); v[i] = make_float4(t_.x, t_.y, t_.z, t_.w); } else v[i] = make_float4(0.f, 0.f, 0.f, 0.f); }
#pragma unroll
    for (int i = 0; i < 16; ++i) { float* s = scr + (4 * i + kr) * 65 + n4; s[0] = v[i].x; s[1] = v[i].y; s[2] = v[i].z; s[3] = v[i].w; }
    LDS_WAIT();
    const int c = lane & 7;
#pragma unroll
    for (int j = 0; j < 8; ++j) { const int nn = (lane >> 3) + 8 * j, n = n0 + nn;
        if (n < ncols) { const float* s = scr + (8 * c) * 65 + nn;
            uint4 o; o.x = pk2(s[0 * 65], s[1 * 65]); o.y = pk2(s[2 * 65], s[3 * 65]); o.z = pk2(s[4 * 65], s[5 * 65]); o.w = pk2(s[6 * 65], s[7 * 65]);
            *(uint4*)(WT + (size_t)maprow(kind, n) * Kd + k0 + 8 * c) = o; } }
    LDS_WAIT();
}
DI void tr_job(const float* W, int ldw, int ncols, int Kd, bf16_t* WT, int kind, int r, float* scr, int lane) {
    const int nblk = (ncols + 63) / 64; const int kb = r / nblk, nb = r % nblk;
    tr_item(W, ldw, ncols, Kd, WT, kb * 64, nb * 64, kind, scr, lane);
}
DI void st_convert(const Params& p, unsigned char* smem, const int WV) {
    const int TIDX = opq_tid(WV); const int BIDX = opq_bid(); (void)TIDX; (void)BIDX;
    const int tid = TIDX, lane = tid & 63, wave = tid >> 6;
    float* scr = (float*)smem + wave * (64 * 65);
    const int gw = BIDX * 8 + wave, NGW = gridDim.x * 8;
    constexpr int I_WIN = 32 * 97, I_WOUT = 32 * 32, I_C1 = 64 * 4, I_C2 = 4 * 2, I_GU = 32 * 16, I_DN = 8 * 32;
    constexpr int PER_L = I_WIN + I_WOUT + 2 * I_C1 + 2 * I_C2 + 65 * I_GU + 65 * I_DN;
    for (int it = gw; it < NL * PER_L; it += NGW) {
        const int l = it / PER_L; int r = it % PER_L;
        if (r < I_WIN) { tr_job(p.w_in + (size_t)l * DM * D_IN, D_IN, D_IN, DM, wl_ptr(p, l, WL_WIN), 1, r, scr, lane); continue; } r -= I_WIN;
        if (r < I_WOUT) { tr_job(p.w_out + (size_t)l * DM * DM, DM, DM, DM, wl_ptr(p, l, WL_WOUT), 0, r, scr, lane); continue; } r -= I_WOUT;
        if (r < 2 * I_C1) { const int kv = r / I_C1; tr_job(p.cmp_w1 + (size_t)(l * 2 + kv) * 4096 * 256, 256, 256, 4096, wl_ptr(p, l, WL_CW1) + (size_t)kv * 256 * 4096, 0, r % I_C1, scr, lane); continue; } r -= 2 * I_C1;
        if (r < 2 * I_C2) { const int kv = r / I_C2; tr_job(p.cmp_w2 + (size_t)(l * 2 + kv) * 256 * 128, 128, 128, 256, wl_ptr(p, l, WL_CW2) + (size_t)kv * 128 * 256, 0, r % I_C2, scr, lane); continue; } r -= 2 * I_C2;
        if (r < 65 * I_GU) { const int e = r / I_GU; const float* src = e < 64 ? p.exp_w_gu + (size_t)(l * 64 + e) * DM * 1024 : p.shared_w_gu + (size_t)l * DM * 1024;
            tr_job(src, 1024, 1024, DM, wl_ptr(p, l, WL_EGU) + (size_t)e * 1024 * DM, 2, r % I_GU, scr, lane); continue; } r -= 65 * I_GU;
        { const int e = r / I_DN; const float* src = e < 64 ? p.exp_w_down + (size_t)(l * 64 + e) * 512 * DM : p.shared_w_down + (size_t)l * 512 * DM;
            tr_job(src, DM, DM, 512, wl_ptr(p, l, WL_EDN) + (size_t)e * DM * 512, 0, r % I_DN, scr, lane); }
    }
    const size_t gt = (size_t)BIDX * 512 + tid, NGT = (size_t)gridDim.x * 512;
    for (int l = 0; l < NL; ++l) {
        bf16_t* wt = wl_ptr(p, l, WL_WIN);
        for (size_t i = gt; i < (size_t)(LDY - D_IN) * DM / 8; i += NGT) ((uint4*)(wt + (size_t)D_IN * DM))[i] = make_uint4(0, 0, 0, 0);
        { uint4* rz = (uint4*)wl_ptr(p, l, WL_RTZ); for (size_t i = gt; i < (size_t)128 * DM / 8; i += NGT) rz[i] = make_uint4(0, 0, 0, 0); }
        bf16_t* rh = wl_ptr(p, l, WL_RTH); bf16_t* rl = wl_ptr(p, l, WL_RTL);
        for (size_t i = gt; i < (size_t)64 * DM; i += NGT) { const int e = (int)(i / DM), k = (int)(i % DM); const float w = p.router_w[((size_t)l * DM + k) * 64 + e];
            const bf16_t h = f2bf(w); rh[i] = h; rl[i] = f2bf(w - bf2f(h)); }
    }
    { const int ub = (int)gridDim.x - 1 - BIDX;
      if (ub < 64) {
        const int l = ub >> 5, kv = (ub >> 4) & 1, jb = (ub >> 2) & 3, ic = ub & 3;
        const float* pe = p.cmp_pe + (size_t)(l * 2 + kv) * 4096; const float* w1 = p.cmp_w1 + (size_t)(l * 2 + kv) * 4096 * 256;
        float acc = 0.f; const int j = jb * 64 + lane; const int i0 = ic * 1024 + wave * 128;
#pragma unroll 16
        for (int i = i0; i < i0 + 128; ++i) acc += pe[i] * w1[(size_t)i * 256 + j];
        __syncthreads();
        float* red = (float*)smem; red[wave * 64 + lane] = acc; __syncthreads();
        if (wave == 0) { float s = 0.f; for (int w = 0; w < 8; ++w) s += red[w * 64 + lane]; ((float*)(p.ws + WS_CMPB))[ic * 1024 + (l * 2 + kv) * 256 + j] = s; }
      } }
}

DI void st_mod(const Params& p, unsigned char* smem, const int WV) {
    const int TIDX = opq_tid(WV); const int BIDX = opq_bid(); (void)TIDX; (void)BIDX;
    const int tid = TIDX, lane = tid & 63, wave = tid >> 6;
    float* ca = (float*)smem;
    float* red = ca + 4 * DM;
#pragma unroll
    for (int it = 0; it < 4 * DM / 512; ++it) { const int i = tid + it * 512; ca[i] = silu_f(p.c[i]); }
    __syncthreads();
    for (int u = BIDX; u < NL * 96; u += gridDim.x) {
        const int l = u / 96, cb = u % 96; const int col = cb * 128 + (lane & 31) * 4;
        const float* W = p.ada_w + (size_t)l * DM * 12288;
        float acc[4][4] = {};
#pragma unroll 8
        for (int i = 0; i < 128; ++i) { const int k = 2 * (wave + 8 * i) + (lane >> 5);
            typedef float f4v_t __attribute__((ext_vector_type(4))); const f4v_t w = __builtin_nontemporal_load((const f4v_t*)(W + (size_t)k * 12288 + col));
#pragma unroll
            for (int b = 0; b < 4; ++b) { const float cv = ca[b * DM + k]; acc[b][0] += cv * w.x; acc[b][1] += cv * w.y; acc[b][2] += cv * w.z; acc[b][3] += cv * w.w; } }
#pragma unroll
        for (int b = 0; b < 4; ++b)
#pragma unroll
            for (int j = 0; j < 4; ++j) acc[b][j] += __shfl_xor(acc[b][j], 32);
        __syncthreads();
        if (lane < 32) {
#pragma unroll
            for (int b = 0; b < 4; ++b)
#pragma unroll
                for (int j = 0; j < 4; ++j) red[(wave * 4 + b) * 128 + lane * 4 + j] = acc[b][j]; }
        __syncthreads();
        { const int b = tid >> 7, cc = tid & 127; float s = 0.f;
            for (int w = 0; w < 8; ++w) s += red[(w * 4 + b) * 128 + cc];
            const int gcol = cb * 128 + cc;
            ((float*)(p.ws + WS_MOD))[(size_t)(l * NB + b) * 12288 + gcol] = s + p.ada_b[(size_t)l * 12288 + gcol]; }
    }
}

typedef float f4v_t __attribute__((ext_vector_type(4)));
#define LDSF __attribute__((address_space(3)))
DI void norm_row_store(float4 (&v)[8], int lane, const LDSF float* gs, const LDSF float* sh, bf16_t* hrow, bf16_t* lorow) {
    float ss = 0.f;
#pragma unroll
    for (int j = 0; j < 8; ++j) ss += v[j].x * v[j].x + v[j].y * v[j].y + v[j].z * v[j].z + v[j].w * v[j].w;
    const float r = rsqrtf(wave_sum(ss) * (1.f / DM) + EPS);
#pragma unroll
    for (int j = 0; j < 8; ++j) { const unsigned e = ((unsigned)j * 64u + (unsigned)lane) * 4u;
        const f4v_t gg = *(const LDSF f4v_t*)(gs + e), s0 = *(const LDSF f4v_t*)(sh + e);
        const float h0 = v[j].x * r * gg.x + s0.x, h1 = v[j].y * r * gg.y + s0.y, h2 = v[j].z * r * gg.z + s0.z, h3 = v[j].w * r * gg.w + s0.w;
        const bf16_t b0 = f2bf(h0), b1 = f2bf(h1), b2 = f2bf(h2), b3 = f2bf(h3);
        uint2 o; o.x = (unsigned)b0 | ((unsigned)b1 << 16); o.y = (unsigned)b2 | ((unsigned)b3 << 16);
        *(uint2*)(hrow + e) = o;
        if (lorow) { uint2 q; q.x = pk2(h0 - bf2f(b0), h1 - bf2f(b1)); q.y = pk2(h2 - bf2f(b2), h3 - bf2f(b3)); *(uint2*)(lorow + e) = q; } }
}
DI void norm_tables(const Params& p, int l, int which, const float* g, LDSF float* gs, LDSF float* sh, int tid) {
#pragma unroll
    for (int it = 0; it < 4 * DM / 512; ++it) { const int i = tid + it * 512; const int b = i >> 11, kk = i & (DM - 1);
        gs[i] = g[kk] * (1.f + mod_ptr(p, l, b, which * 3 + 1)[kk]); sh[i] = mod_ptr(p, l, b, which * 3 + 0)[kk]; }
}
DI void st_norm(const Params& p, int l, const float* xin, int which, unsigned char* smem, const int WV) {
    const int TIDX = opq_tid(WV); const int BIDX = opq_bid(); (void)TIDX; (void)BIDX;
    const int lane = TIDX & 63, wave = __builtin_amdgcn_readfirstlane(TIDX >> 6);
    bf16_t* H = (bf16_t*)(p.ws + WS_H); bf16_t* HLO = (bf16_t*)(p.ws + WS_HLO);
    LDSF float* gs = (LDSF float*)(LDSF unsigned char*)smem; LDSF float* sh = gs + 4 * DM;
    norm_tables(p, l, which, (which == 0 ? p.norm1_g : p.norm2_g) + (size_t)l * DM, gs, sh, TIDX);
    __syncthreads();
    for (int t = BIDX * 8 + wave; t < NT; t += gridDim.x * 8) {
        const int b = t / SEQ; float4 v[8];
#pragma unroll
        for (int j = 0; j < 8; ++j) {
            if (which) { const uint2 w = *(const uint2*)((const bf16_t*)xin + (size_t)t * DM + (j * 64 + lane) * 4);
                v[j] = make_float4(__uint_as_float(w.x << 16), __uint_as_float(w.x & 0xffff0000u), __uint_as_float(w.y << 16), __uint_as_float(w.y & 0xffff0000u)); }
            else v[j] = *(const float4*)(xin + (size_t)t * DM + (j * 64 + lane) * 4); }
        norm_row_store(v, lane, gs + b * DM, sh + b * DM, H + (size_t)t * DM, nullptr);
    }
}

template <class Epi>
DI void sgemm_tile(unsigned char* smem, const bf16_t* A, size_t lda, size_t kseg, int mvalid, const bf16_t* Bt, size_t ldb, int K, const Epi& epi, const int WV) {
    const int TIDX = opq_tid(WV); const int BIDX = opq_bid(); (void)TIDX; (void)BIDX;
    float* As = (float*)smem; float* Bs = As + 16 * 132;
    const int tid = TIDX, tx = tid & 31, ty = tid >> 5;
    const int lr = tid >> 2, lk = (tid & 3) * 4;
    const int ar = lr < mvalid ? lr : mvalid - 1;
    float acc[8][4] = {};
    for (int k0 = 0; k0 < K; k0 += 16) {
        const int k = k0 + lk;
        const uint2 av = *(const uint2*)(A + (size_t)ar * lda + (size_t)(k >> 7) * kseg + (k & 127));
        const uint2 bv = *(const uint2*)(Bt + (size_t)lr * ldb + k);
        __syncthreads();
        As[(lk + 0) * 132 + lr] = __uint_as_float(av.x << 16); As[(lk + 1) * 132 + lr] = __uint_as_float(av.x & 0xffff0000u);
        As[(lk + 2) * 132 + lr] = __uint_as_float(av.y << 16); As[(lk + 3) * 132 + lr] = __uint_as_float(av.y & 0xffff0000u);
        Bs[(lk + 0) * 132 + lr] = __uint_as_float(bv.x << 16); Bs[(lk + 1) * 132 + lr] = __uint_as_float(bv.x & 0xffff0000u);
        Bs[(lk + 2) * 132 + lr] = __uint_as_float(bv.y << 16); Bs[(lk + 3) * 132 + lr] = __uint_as_float(bv.y & 0xffff0000u);
        __syncthreads();
#pragma unroll
        for (int kk = 0; kk < 16; ++kk) {
            const float4 a0 = *(const float4*)(As + kk * 132 + ty * 8), a1 = *(const float4*)(As + kk * 132 + ty * 8 + 4);
            const float4 b = *(const float4*)(Bs + kk * 132 + tx * 4);
            const float a[8] = {a0.x, a0.y, a0.z, a0.w, a1.x, a1.y, a1.z, a1.w};
#pragma unroll
            for (int i = 0; i < 8; ++i) { acc[i][0] += a[i] * b.x; acc[i][1] += a[i] * b.y; acc[i][2] += a[i] * b.z; acc[i][3] += a[i] * b.w; }
        }
    }
    __syncthreads();
#pragma unroll
    for (int i = 0; i < 8; ++i) { const int r = ty * 8 + i; if (r < mvalid) {
#pragma unroll
        for (int j = 0; j < 4; ++j) epi(r, tx * 4 + j, acc[i][j]); } }
}


DI void rot8(uint4& A, uint4& B, const float* cs, const float* sn) {
    unsigned a[4] = {A.x, A.y, A.z, A.w}, b[4] = {B.x, B.y, B.z, B.w};
#pragma unroll
    for (int j = 0; j < 4; ++j) { const float a0 = __uint_as_float(a[j] << 16), a1 = __uint_as_float(a[j] & 0xffff0000u), b0 = __uint_as_float(b[j] << 16), b1 = __uint_as_float(b[j] & 0xffff0000u);
        const float c0 = cs[2 * j], c1 = cs[2 * j + 1], s0 = sn[2 * j], s1 = sn[2 * j + 1];
        a[j] = pk2(a0 * c0 - b0 * s0, a1 * c1 - b1 * s1); b[j] = pk2(a0 * s0 + b0 * c0, a1 * s1 + b1 * c1); }
    A = make_uint4(a[0], a[1], a[2], a[3]); B = make_uint4(b[0], b[1], b[2], b[3]);
}
DI void st_post(const Params& p, int l, unsigned char* smem, const int WV, const float sgn = 1.f) {
    const int TIDX = opq_tid(WV); const int BIDX = opq_bid(); (void)TIDX; (void)BIDX;
    const int lane = TIDX & 63, wave = __builtin_amdgcn_readfirstlane(TIDX >> 6);
    bf16_t* Y = (bf16_t*)(p.ws + WS_Y); bf16_t* YM = (bf16_t*)(p.ws + WS_YMIX);
    float* tab = (float*)smem + wave * 160;
    const float inv_n = exp2f(-(float)(lane & 15) * (18.931568569324174f / 16.f));
    const float inv_r = exp2f(-(float)lane * (13.287712379549449f / 64.f));
    const int c0 = lane * 8;
    float cw[24], cg[8];
    { const float4* w4 = (const float4*)(p.conv_w + ((size_t)l * 512 + c0) * 3);
#pragma unroll
      for (int i = 0; i < 6; ++i) { const float4 v = w4[i]; cw[4 * i] = v.x; cw[4 * i + 1] = v.y; cw[4 * i + 2] = v.z; cw[4 * i + 3] = v.w; }
      const float4* g4 = (const float4*)(p.conv_g + (size_t)l * 512 + c0); const float4 g0 = g4[0], g1 = g4[1];
      cg[0] = g0.x; cg[1] = g0.y; cg[2] = g0.z; cg[3] = g0.w; cg[4] = g1.x; cg[5] = g1.y; cg[6] = g1.z; cg[7] = g1.w; }
    for (int t = BIDX * 8 + wave; t < NT; t += gridDim.x * 8) {
        bf16_t* y = Y + (size_t)t * LDY; const float pos = (float)p.pos[t]; const int s = t % SEQ;
        { float sn, cs; sincosf(pos * inv_r, &sn, &cs); tab[32 + lane] = cs; tab[96 + lane] = sn * sgn;
          if (lane < 16) { sincosf(pos * inv_n, &sn, &cs); tab[lane] = cs; tab[16 + lane] = sn * sgn; } }
        const uint4 qb_ = *(const uint4*)(y + Y_CB + c0), qc0 = *(const uint4*)(y + Y_CC + c0), qu0 = *(const uint4*)(y + Y_CU + c0);
        uint4 qc1 = make_uint4(0, 0, 0, 0), qu1 = qc1, qc2 = qc1, qu2 = qc1;
        if (s >= 1) { qc1 = *(const uint4*)(y + Y_CC + c0 - LDY); qu1 = *(const uint4*)(y + Y_CU + c0 - LDY); }
        if (s >= 2) { qc2 = *(const uint4*)(y + Y_CC + c0 - 2 * LDY); qu2 = *(const uint4*)(y + Y_CU + c0 - 2 * LDY); }
        LDS_WAIT();
        { const int v = lane >> 3, kk = lane & 7; bf16_t* base = y + (v < 4 ? Y_QR : Y_KR) + (v & 3) * 128 + 8 * kk;
          uint4 A = *(const uint4*)base, B = *(const uint4*)(base + 64); rot8(A, B, tab + 32 + 8 * kk, tab + 96 + 8 * kk); *(uint4*)base = A; *(uint4*)(base + 64) = B; }
        if (lane < 28) { const int v = lane >> 1, cp = lane & 1; bf16_t* base = y + (v < 8 ? Y_QN + v * 128 : Y_KV + ((v - 8) >> 1) * 512 + ((v - 8) & 1) * 128) + 8 * cp;
          uint4 A = *(const uint4*)base, B = *(const uint4*)(base + 16); rot8(A, B, tab + 8 * cp, tab + 16 + 8 * cp); *(uint4*)base = A; *(uint4*)(base + 16) = B; }
        const unsigned wb[4] = {qb_.x, qb_.y, qb_.z, qb_.w}, wc0[4] = {qc0.x, qc0.y, qc0.z, qc0.w}, wu0[4] = {qu0.x, qu0.y, qu0.z, qu0.w}, wc1[4] = {qc1.x, qc1.y, qc1.z, qc1.w}, wu1[4] = {qu1.x, qu1.y, qu1.z, qu1.w},
                       wc2[4] = {qc2.x, qc2.y, qc2.z, qc2.w}, wu2[4] = {qu2.x, qu2.y, qu2.z, qu2.w};
        float yc[8]; float ss = 0.f;
#pragma unroll
        for (int i = 0; i < 8; ++i) { const int w = i >> 1; const bool hi_ = i & 1;
#define BFX(arr) (hi_ ? __uint_as_float(arr[w] & 0xffff0000u) : __uint_as_float(arr[w] << 16))
            const float v0 = BFX(wc0) * BFX(wu0), v1 = BFX(wc1) * BFX(wu1), v2 = BFX(wc2) * BFX(wu2);
            yc[i] = BFX(wb) * (cw[3 * i] * v2 + cw[3 * i + 1] * v1 + cw[3 * i + 2] * v0); ss += yc[i] * yc[i]; }
#undef BFX
        ss += __shfl_xor(ss, 1); ss += __shfl_xor(ss, 2); ss += __shfl_xor(ss, 4); ss += __shfl_xor(ss, 8);
        const float rs = rsqrtf(ss * (1.f / 128.f) + EPS);
        uint4 o; o.x = pk2(yc[0] * rs * cg[0], yc[1] * rs * cg[1]); o.y = pk2(yc[2] * rs * cg[2], yc[3] * rs * cg[3]); o.z = pk2(yc[4] * rs * cg[4], yc[5] * rs * cg[5]); o.w = pk2(yc[6] * rs * cg[6], yc[7] * rs * cg[7]);
        *(uint4*)(YM + (size_t)t * DM + c0) = o;
        LDS_WAIT();
    }
}

DI void st_cmp2(const Params& p, int l, unsigned char* smem, const int WV) {
    const int TIDX = opq_tid(WV); const int BIDX = opq_bid(); (void)TIDX; (void)BIDX;
    typedef short c2_bf16x8 __attribute__((ext_vector_type(8))); typedef float c2_f32x16 __attribute__((ext_vector_type(16))); typedef unsigned c2_u4 __attribute__((ext_vector_type(4)));
    constexpr int HP = 264;
    const float* CP = (const float*)(p.ws + WS_CP); const float* bias = (const float*)(p.ws + WS_CMPB) + l * 512;
    bf16_t* hid = (bf16_t*)(smem + 32768);
    const int wid = __builtin_amdgcn_readfirstlane(TIDX >> 6), lane = TIDX & 63, li = lane & 31, hi = lane >> 5, cb = wid & 3, db0 = 2 * (wid >> 2);
    for (int u = BIDX; u < 2 * 8 * 2; u += gridDim.x) {
        const int kv = u >> 4, bg = (u >> 1) & 7, mt = u & 1;
        const bf16_t* W2 = wl_ptr(p, l, WL_CW2) + (size_t)kv * 128 * 256;
        c2_bf16x8 wf[8][2];
#pragma unroll
        for (int ks = 0; ks < 8; ++ks)
#pragma unroll
            for (int t = 0; t < 2; ++t) wf[ks][t] = *(const c2_bf16x8*)(W2 + (size_t)(32 * (db0 + t) + li) * 256 + 16 * ks + 8 * hi);
        __syncthreads();
        for (int i = TIDX; i < 128 * 64; i += 512) { const int r = i >> 6, c4 = (i & 63) * 4; const size_t o = ((size_t)((kv * 8 + bg) * 256 + mt * 128 + r)) * 256 + c4;
            const float4 a0 = *(const float4*)(CP + o), a1 = *(const float4*)(CP + (size_t)16 * 65536 + o), a2 = *(const float4*)(CP + (size_t)32 * 65536 + o), a3 = *(const float4*)(CP + (size_t)48 * 65536 + o);
            const float4 b0_ = *(const float4*)(bias + kv * 256 + c4), b1_ = *(const float4*)(bias + 1024 + kv * 256 + c4), b2_ = *(const float4*)(bias + 2048 + kv * 256 + c4), b3_ = *(const float4*)(bias + 3072 + kv * 256 + c4);
            const float4 bb = make_float4((b0_.x + b1_.x) + (b2_.x + b3_.x), (b0_.y + b1_.y) + (b2_.y + b3_.y), (b0_.z + b1_.z) + (b2_.z + b3_.z), (b0_.w + b1_.w) + (b2_.w + b3_.w));
            uint2 w; w.x = pk2(gelu_tanh_f((a0.x + a1.x) + (a2.x + a3.x) + bb.x), gelu_tanh_f((a0.y + a1.y) + (a2.y + a3.y) + bb.y)); w.y = pk2(gelu_tanh_f((a0.z + a1.z) + (a2.z + a3.z) + bb.z), gelu_tanh_f((a0.w + a1.w) + (a2.w + a3.w) + bb.w));
            *(uint2*)(hid + r * HP + c4) = w; }
        __syncthreads();
        const LDSF bf16_t* hl = (const LDSF bf16_t*)(LDSF unsigned char*)(smem + 32768);
        c2_f32x16 acc[2];
#pragma unroll
        for (int r = 0; r < 16; ++r) { acc[0][r] = 0.f; acc[1][r] = 0.f; }
#pragma unroll
        for (int kh = 0; kh < 2; ++kh) {
            if (kh == 1) {
#pragma unroll
                for (int ks = 0; ks < 8; ++ks)
#pragma unroll
                    for (int t = 0; t < 2; ++t) wf[ks][t] = *(const c2_bf16x8*)(W2 + (size_t)(32 * (db0 + t) + li) * 256 + 128 + 16 * ks + 8 * hi); }
#pragma unroll
            for (int ks = 0; ks < 8; ++ks) { const c2_bf16x8 hf = *(const LDSF c2_bf16x8*)(hl + (32 * cb + li) * HP + 128 * kh + 16 * ks + 8 * hi);
#pragma unroll
                for (int t = 0; t < 2; ++t) acc[t] = kv ? __builtin_amdgcn_mfma_f32_32x32x16_bf16(hf, wf[ks][t], acc[t], 0, 0, 0) : __builtin_amdgcn_mfma_f32_32x32x16_bf16(wf[ks][t], hf, acc[t], 0, 0, 0); } }
        bf16_t* kc = (bf16_t*)(p.ws + WS_KC) + (size_t)bg * 256 * 128; bf16_t* vct = (bf16_t*)(p.ws + WS_VC) + (size_t)bg * 128 * 256;
        if (kv == 0) { const int g = mt * 128 + 32 * cb + li;
#pragma unroll
            for (int t = 0; t < 2; ++t)
#pragma unroll
                for (int rq = 0; rq < 4; ++rq) { uint2 w; w.x = pk2(acc[t][4 * rq], acc[t][4 * rq + 1]); w.y = pk2(acc[t][4 * rq + 2], acc[t][4 * rq + 3]); if (g == 255) { w.x = 0u; w.y = 0u; }
                    *(uint2*)(kc + (size_t)g * 128 + 32 * (db0 + t) + 8 * rq + 4 * hi) = w; } }
        else {
#pragma unroll
            for (int t = 0; t < 2; ++t)
#pragma unroll
                for (int h2 = 0; h2 < 2; ++h2) { const int base = mt * 128 + 32 * cb + 16 * h2 + 8 * hi;
                    c2_u4 w; w.x = pk2(acc[t][8 * h2 + 0], acc[t][8 * h2 + 1]); w.y = pk2(acc[t][8 * h2 + 2], acc[t][8 * h2 + 3]); w.z = pk2(acc[t][8 * h2 + 4], acc[t][8 * h2 + 5]); w.w = pk2(acc[t][8 * h2 + 6], acc[t][8 * h2 + 7]);
                    if (base + 7 == 255) w.w &= 0x0000ffffu;
                    *(c2_u4*)(vct + (size_t)(32 * (db0 + t) + li) * 256 + base) = w; } }
    }
}

DI void st_scan(const Params& p, int l, const int WV) {
    const int TIDX = opq_tid(WV); const int BIDX = opq_bid(); (void)TIDX; (void)BIDX;
    const float* KVC = (const float*)(p.ws + WS_KVC); bf16_t* STB = (bf16_t*)(p.ws + WS_STATEB);
    for (size_t i = (size_t)BIDX * 512 + TIDX; i < (size_t)16 * 16384; i += (size_t)gridDim.x * 512) {
        const int bh = (int)(i >> 14), ed = (int)(i & 16383); const float cd = ret_chunkdecay(bh & 3);
        float kv[32];
#pragma unroll
        for (int c = 0; c < 32; ++c) kv[c] = KVC[(size_t)(bh * 32 + c) * 16384 + ed];
        float st = 0.f;
#pragma unroll
        for (int c = 0; c < 32; ++c) { STB[(size_t)(bh * 32 + c) * 16384 + ed] = f2bf(st); st = st * cd + kv[c]; }
    }
}


DI void pad_offsets(const unsigned* CNT, int* po, const int WV) {
    const int TIDX = opq_tid(WV); const int BIDX = opq_bid(); (void)TIDX; (void)BIDX;
    if (TIDX < 64) { const int pad = (int)((CNT[TIDX] + 255u) >> 8) << 8; int inc = pad;
#pragma unroll
        for (int o = 1; o < 64; o <<= 1) { const int v = __shfl_up(inc, o); if (TIDX >= o) inc += v; }
        po[TIDX] = inc - pad; if (TIDX == 63) po[64] = inc; }
    __syncthreads();
}
DI int blk_expert(const int* po, int blk) { int e = 0; while (e < 63 && po[e + 1] <= blk * 256) ++e; return e; }
typedef unsigned u2v_t __attribute__((ext_vector_type(2)));
typedef unsigned u4w_t __attribute__((ext_vector_type(4)));
DI void st_combine(const Params& p, int l, unsigned char* smem, const int WV) {
    const int TIDX = opq_tid(WV); const int BIDX = opq_bid(); (void)TIDX; (void)BIDX;
    bf16_t* X2 = (bf16_t*)(p.ws + WS_X2);
    LDSF float* tg2 = (LDSF float*)(LDSF unsigned char*)smem; LDSF float* tgs = tg2 + 4 * DM; LDSF float* tsh = tgs + 4 * DM;
#pragma unroll
    for (int it = 0; it < 4 * DM / 512; ++it) { const int i = TIDX + it * 512; tg2[i] = mod_ptr(p, l, i >> 11, 5)[i & (DM - 1)]; }
    if (l + 1 < NL) norm_tables(p, l + 1, 0, p.norm1_g + (size_t)(l + 1) * DM, tgs, tsh, TIDX); else for (int i = TIDX; i < DM; i += 512) tgs[i] = p.final_g[i];
    __syncthreads();
    const int* TOPE = (const int*)(p.ws + WS_TOPE); const int* RANK = (const int*)(p.ws + WS_RANK); const float* TOPW = (const float*)(p.ws + WS_TOPW);
    int* po = (int*)(smem + 100 * 1024); pad_offsets((const unsigned*)(p.ws + WS_CTL) + CW_CNT + l * 64, po, WV);
    const int lane = TIDX & 63, wave = __builtin_amdgcn_readfirstlane(TIDX >> 6);
    const __amdgpu_buffer_rsrc_t rys = __builtin_amdgcn_make_buffer_rsrc((void*)(p.ws + WS_YS), 0, (int)((size_t)NROWS_E * DM), 0x00020000);
    const __amdgpu_buffer_rsrc_t rx1 = __builtin_amdgcn_make_buffer_rsrc((void*)(p.ws + WS_X1), 0, (int)((size_t)NT * DM * 2), 0x00020000);
    const int lane0 = lane;
    for (int t = BIDX * 8 + wave; t < NT; t += gridDim.x * 8) {
        int lane = opq_tid(WV) & 63;
        const int b = t / SEQ; float4 acc[8];
        const int lo4 = lane * 4;
        { const int so = (NSLOT + t) * DM;
#pragma unroll
          for (int j = 0; j < 8; ++j) { const int w = (int)__builtin_amdgcn_raw_buffer_load_b32(rys, lo4 + j * 256, so, 2);
              acc[j] = make_float4(__builtin_amdgcn_cvt_f32_fp8(w, 0), __builtin_amdgcn_cvt_f32_fp8(w, 1), __builtin_amdgcn_cvt_f32_fp8(w, 2), __builtin_amdgcn_cvt_f32_fp8(w, 3)); } }
        { const int sv = po[TOPE[(size_t)t * 8 + (lane & 7)]] + RANK[(size_t)t * 8 + (lane & 7)]; const float wv = TOPW[(size_t)t * 8 + (lane & 7)];
#pragma unroll 1
          for (int kk = 0; kk < 8; kk += 4) { int w[4][8];
#pragma unroll
              for (int k2 = 0; k2 < 4; ++k2) { const int so = __builtin_amdgcn_readlane(sv, kk + k2) * DM;
#pragma unroll
                  for (int j = 0; j < 8; ++j) w[k2][j] = (int)__builtin_amdgcn_raw_buffer_load_b32(rys, lo4 + j * 256, so, 2); }
#pragma unroll
              for (int k2 = 0; k2 < 4; ++k2) { const float wk = __uint_as_float(__builtin_amdgcn_readlane(__float_as_uint(wv), kk + k2));
#pragma unroll
                  for (int j = 0; j < 8; ++j) { acc[j].x += wk * __builtin_amdgcn_cvt_f32_fp8(w[k2][j], 0); acc[j].y += wk * __builtin_amdgcn_cvt_f32_fp8(w[k2][j], 1); acc[j].z += wk * __builtin_amdgcn_cvt_f32_fp8(w[k2][j], 2); acc[j].w += wk * __builtin_amdgcn_cvt_f32_fp8(w[k2][j], 3); } }
              asm volatile("" ::: "memory"); } }
        asm volatile("" : "+v"(lane));
        float4 v[8];
#pragma unroll
        for (int j = 0; j < 8; ++j) { const u2v_t xw = __builtin_amdgcn_raw_buffer_load_b64(rx1, lane * 8 + j * 512, t * (DM * 2), 0); const f4v_t gg = *(const LDSF f4v_t*)(tg2 + b * DM + ((unsigned)j * 64u + (unsigned)lane) * 4u);
            v[j] = make_float4(__uint_as_float(xw.x << 16) + gg.x * acc[j].x, __uint_as_float(xw.x & 0xffff0000u) + gg.y * acc[j].y, __uint_as_float(xw.y << 16) + gg.z * acc[j].z, __uint_as_float(xw.y & 0xffff0000u) + gg.w * acc[j].w);
            if ((j & 3) == 3) asm volatile("" ::: "memory"); }
        if (l + 1 < NL) {
#pragma unroll
            for (int j = 0; j < 8; ++j) { uint2 o; o.x = pk2(v[j].x, v[j].y); o.y = pk2(v[j].z, v[j].w); *(uint2*)(X2 + (size_t)t * DM + ((unsigned)j * 64u + (unsigned)lane) * 4u) = o; }
            norm_row_store(v, lane, tgs + b * DM, tsh + b * DM, (bf16_t*)(p.ws + WS_H) + (size_t)t * DM, nullptr);
        } else {
            float ss = 0.f;
#pragma unroll
            for (int j = 0; j < 8; ++j) ss += v[j].x * v[j].x + v[j].y * v[j].y + v[j].z * v[j].z + v[j].w * v[j].w;
            const float r = rsqrtf(wave_sum(ss) * (1.f / DM) + EPS);
#pragma unroll
            for (int j = 0; j < 8; ++j) { const unsigned e = ((unsigned)j * 64u + (unsigned)lane) * 4u; const f4v_t gg = *(const LDSF f4v_t*)(tgs + e);
                *(float4*)(p.out + (size_t)t * DM + e) = make_float4(v[j].x * r * gg.x, v[j].y * r * gg.y, v[j].z * r * gg.z, v[j].w * r * gg.w); }
        }
    }
}


namespace pg8 {
#define PG8_LAS __attribute__((address_space(3)))
typedef short bf16x8 __attribute__((ext_vector_type(8)));
typedef float f32x4 __attribute__((ext_vector_type(4)));
typedef unsigned u32x4 __attribute__((ext_vector_type(4)));
constexpr int BM = 256, BK = 64, HALF = 128, HTB = HALF * BK * 2, STAGE_BYTES = 8 * HTB, NXCD = 8, WGM = 8;
__host__ __device__ __forceinline__ int lds_byte(int r, int c) { const int st = (r >> 4) * 2 + (c >> 5), rr = r & 15, cc = c & 31, ob = rr * 64 + cc * 2; return st * 1024 + (ob ^ (((ob >> 9) & 1) << 5)); }
__host__ __device__ __forceinline__ void stage_rc(int b, int& R, int& C) { const int st = b / 1024, sb = b % 1024, swz = sb ^ (((sb >> 9) & 1) << 5); R = (st >> 1) * 16 + swz / 64; C = (st & 1) * 32 + (swz % 64) / 2; }
__host__ __device__ __forceinline__ int perm32(int rho) { const int n = rho >> 4, i = rho & 15; return 8 * (i >> 2) + 4 * n + (i & 3); }
struct Unit { const char* A; const char* B; int i0, i1; };
__device__ __forceinline__ unsigned cvt_pk_bf16(float lo, float hi) { unsigned r; asm volatile("v_cvt_pk_bf16_f32 %0, %1, %2" : "=v"(r) : "v"(lo), "v"(hi)); return r; }
template <class Epi, class Sched, bool GATHER = false>
__device__ __forceinline__ void gemm_phase(PG8_LAS unsigned char* lds, const int K, const Sched& S, const Epi& E, const int tid, const size_t pitchA = 0, const size_t segA = 256, const size_t pitchB = 0) {
    const int wid = __builtin_amdgcn_readfirstlane(tid >> 6), lane = tid & 63, wr = wid >> 2, wc = wid & 3, fr = lane & 15, fq = lane >> 4;
    const int nt = K / BK;
    unsigned voffB[2], cva[2][2], nva[2][2]; int RA[2]; unsigned CA[2];
    const size_t pA = pitchA ? pitchA : (size_t)K * 2;
#pragma unroll
    for (int i = 0; i < 2; ++i) { int R, C; stage_rc(tid * 16 + i * 8192, R, C);
        const int Rb = Epi::BP16 ? (64 * (R >> 5) + 16 * ((R >> 2) & 3) + 4 * ((R >> 4) & 1) + (R & 3)) : (Epi::PERM ? ((R & ~31) + perm32(R & 31)) : R);
        RA[i] = R; CA[i] = (unsigned)C * 2u; voffB[i] = (unsigned)((size_t)Rb * (pitchB ? pitchB : (size_t)K * 2)) + (unsigned)C * 2u;
        cva[0][i] = (unsigned)((size_t)R * pA) + CA[i]; cva[1][i] = (unsigned)((size_t)(R + HALF) * pA) + CA[i]; nva[0][i] = cva[0][i]; nva[1][i] = cva[1][i]; }
    const size_t kstep = (size_t)(BK * 2);
    const size_t hstep = (size_t)(Epi::BP16 ? 8 : HALF) * (pitchB ? pitchB : (size_t)K * 2);
    const unsigned ldsw = (unsigned)wid * 1024u;
    const int aoff = lds_byte(wr * 64 + fr, fq * 8), boff = lds_byte(wc * 32 + fr, fq * 8);
#define PG8_SA(b, h) (((b) * 2 + (h)) * HTB)
#define PG8_SB(b, h) ((4 + (b) * 2 + (h)) * HTB)
#define PG8_STAGE(bufoff, gbase, voff) do { _Pragma("unroll") for (int _i = 0; _i < 2; ++_i) \
        __builtin_amdgcn_global_load_lds((const unsigned*)((const char*)(gbase) + (voff)[_i]), (PG8_LAS unsigned*)(lds + (bufoff) + ldsw + _i * 8192), 16, 0, 0); } while (0)
#define PG8_LDA(dst, b, h) do { _Pragma("unroll") for (int m = 0; m < 4; ++m) _Pragma("unroll") for (int k = 0; k < 2; ++k) dst[m][k] = *(const PG8_LAS bf16x8*)(lds + PG8_SA(b, h) + aoff + m * 2048 + k * 1024); } while (0)
#define PG8_LDB(dst, b, h) do { _Pragma("unroll") for (int n = 0; n < 2; ++n) _Pragma("unroll") for (int k = 0; k < 2; ++k) dst[n][k] = *(const PG8_LAS bf16x8*)(lds + PG8_SB(b, h) + boff + n * 2048 + k * 1024); } while (0)
#define PG8_MMA(ai, bj, At, Bt) do { __builtin_amdgcn_s_setprio(1); _Pragma("unroll") for (int m = 0; m < 4; ++m) _Pragma("unroll") for (int n = 0; n < 2; ++n) _Pragma("unroll") for (int k = 0; k < 2; ++k) \
        acc[ai][bj][m][n] = __builtin_amdgcn_mfma_f32_16x16x32_bf16(Bt[n][k], At[m][k], acc[ai][bj][m][n], 0, 0, 0); __builtin_amdgcn_s_setprio(0); } while (0)
#define PG8_WAIT_V(n) asm volatile("s_waitcnt vmcnt(" #n ")" ::: "memory")
#define PG8_WAIT_L(n) asm volatile("s_waitcnt lgkmcnt(" #n ")" ::: "memory")
#define PG8_BAR __builtin_amdgcn_s_barrier()
#define PG8_SCHED __builtin_amdgcn_sched_barrier(0)
    Unit cur, nxt; int ui = 0;
    if (!S.next(0, cur)) return;
    f32x4 acc[2][2][4][2];
#pragma unroll
    for (int a = 0; a < 2; ++a)
#pragma unroll
        for (int b = 0; b < 2; ++b)
#pragma unroll
            for (int m = 0; m < 4; ++m)
#pragma unroll
                for (int n = 0; n < 2; ++n) acc[a][b][m][n] = (f32x4){0.f, 0.f, 0.f, 0.f};
    bf16x8 At[4][2], B0[2][2], B1[2][2];
    const char* cA = cur.A; const char* cB = cur.B;
    if constexpr (GATHER) {
#pragma unroll
        for (int h = 0; h < 2; ++h)
#pragma unroll
            for (int i = 0; i < 2; ++i) cva[h][i] = S.rowoff(cur, h * HALF + RA[i]) + CA[i]; }
    S.a_ready(cur);
    PG8_STAGE(PG8_SB(0, 0), cB, voffB); PG8_STAGE(PG8_SA(0, 0), cA, cva[0]); PG8_STAGE(PG8_SB(0, 1), cB + hstep, voffB); PG8_STAGE(PG8_SA(0, 1), cA, cva[1]);
    if (wr == 1) PG8_BAR;
    PG8_WAIT_V(4); PG8_BAR;
    PG8_STAGE(PG8_SB(1, 0), cB + kstep, voffB); PG8_STAGE(PG8_SA(1, 0), cA + kstep, cva[0]); PG8_STAGE(PG8_SB(1, 1), cB + hstep + kstep, voffB);
    PG8_WAIT_V(6); PG8_BAR;
    for (;;) {
        const bool has_next = S.next(ui + 1, nxt);
        if constexpr (GATHER) { if (has_next) {
#pragma unroll
            for (int h = 0; h < 2; ++h)
#pragma unroll
                for (int i = 0; i < 2; ++i) nva[h][i] = S.rowoff(nxt, h * HALF + RA[i]) + CA[i]; } }
        const char* nA = has_next ? nxt.A : cA; const char* nB = has_next ? nxt.B : cB;
        for (int t = 0; t < nt; t += 2) {
            const bool last = (t == nt - 2);
            const char* a1 = cA + (size_t)(t >> 1) * segA + kstep;
            unsigned va2[2][2];
#pragma unroll
            for (int h = 0; h < 2; ++h)
#pragma unroll
                for (int i = 0; i < 2; ++i) va2[h][i] = (GATHER && last) ? nva[h][i] : cva[h][i];
            const char* a2 = last ? nA : cA + (size_t)((t >> 1) + 1) * segA; const char* b2 = last ? nB : cB + (size_t)(t + 2) * kstep;
            const char* a3 = a2 + kstep; const char* b3 = b2 + kstep;
            if (last && has_next) S.a_ready(nxt);
            PG8_LDB(B0, 0, 0); PG8_SCHED; PG8_LDA(At, 0, 0); PG8_STAGE(PG8_SA(1, 1), a1, cva[1]);
            PG8_WAIT_L(8); PG8_BAR; PG8_WAIT_L(0); PG8_MMA(0, 0, At, B0); PG8_BAR; PG8_SCHED;
            PG8_LDB(B1, 0, 1); PG8_STAGE(PG8_SB(0, 0), b2, voffB);
            PG8_BAR; PG8_WAIT_L(0); PG8_MMA(0, 1, At, B1); PG8_BAR;
            PG8_LDA(At, 0, 1); PG8_STAGE(PG8_SA(0, 0), a2, va2[0]);
            PG8_BAR; PG8_WAIT_L(0); PG8_MMA(1, 0, At, B0); PG8_BAR; PG8_SCHED;
            PG8_STAGE(PG8_SB(0, 1), b2 + hstep, voffB);
            PG8_WAIT_V(6); PG8_BAR; PG8_MMA(1, 1, At, B1); PG8_BAR;
            PG8_LDB(B0, 1, 0); PG8_SCHED; PG8_LDA(At, 1, 0); PG8_STAGE(PG8_SA(0, 1), a2, va2[1]);
            PG8_WAIT_L(8); PG8_BAR; PG8_WAIT_L(0); PG8_MMA(0, 0, At, B0); PG8_BAR; PG8_SCHED;
            PG8_LDB(B1, 1, 1); PG8_STAGE(PG8_SB(1, 0), b3, voffB);
            PG8_BAR; PG8_WAIT_L(0); PG8_MMA(0, 1, At, B1); PG8_BAR;
            PG8_LDA(At, 1, 1); PG8_STAGE(PG8_SA(1, 0), a3, va2[0]);
            PG8_BAR; PG8_WAIT_L(0); PG8_MMA(1, 0, At, B0); PG8_BAR; PG8_SCHED;
            PG8_STAGE(PG8_SB(1, 1), b3 + hstep, voffB);
            PG8_WAIT_V(6); PG8_BAR; PG8_MMA(1, 1, At, B1); PG8_BAR;
        }
        if (wr == 0) PG8_BAR;
        if constexpr (!Epi::AFTER_DRAIN) { E(acc, cur, wr, wc, fr, fq); S.done(cur); }
        if (!has_next) break;
#pragma unroll
        for (int a = 0; a < 2; ++a)
#pragma unroll
            for (int b = 0; b < 2; ++b)
#pragma unroll
                for (int m = 0; m < 4; ++m)
#pragma unroll
                    for (int n = 0; n < 2; ++n) acc[a][b][m][n] = (f32x4){0.f, 0.f, 0.f, 0.f};
        cur = nxt; cA = nA; cB = nB; ++ui;
        if constexpr (GATHER) {
#pragma unroll
            for (int h = 0; h < 2; ++h)
#pragma unroll
                for (int i = 0; i < 2; ++i) cva[h][i] = nva[h][i]; }
        if (wr == 1) PG8_BAR;
    }
    PG8_WAIT_V(0);
    PG8_BAR;
    if constexpr (Epi::AFTER_DRAIN) { E.fused(acc, cur, wr, wc, fr, fq, lds, wid, lane); S.done(cur); }
#undef PG8_SA
#undef PG8_SB
#undef PG8_STAGE
#undef PG8_LDA
#undef PG8_LDB
#undef PG8_MMA
#undef PG8_WAIT_V
#undef PG8_WAIT_L
#undef PG8_BAR
#undef PG8_SCHED
}

struct GridOrder {
    int nM, nN, nwg, G, c; const char* A; const char* B; size_t tstep;
    __device__ __forceinline__ void init(int M, int N, int K, int G_, int c_, const void* A_, const void* B_) { nM = M / BM; nN = N / BM; nwg = nM * nN; G = G_; c = c_; A = (const char*)A_; B = (const char*)B_; tstep = (size_t)BM * K * 2; }
    __device__ __forceinline__ bool next(int i, Unit& u) const {
        const long L = (long)i * G + c; if (L >= nwg) return false;
        int wgid = (int)L; { const int q = nwg / NXCD, r = nwg % NXCD, xcd = wgid % NXCD, off = wgid / NXCD; wgid = (xcd < r ? xcd * (q + 1) : r * (q + 1) + (xcd - r) * q) + off; }
        const int nig = WGM * nN, gid = wgid / nig, fm = gid * WGM, gsz = (nM - fm) < WGM ? (nM - fm) : WGM;
        const int pm = fm + ((wgid % nig) % gsz), pn = (wgid % nig) / gsz;
        u.A = A + (size_t)pm * tstep; u.B = B + (size_t)pn * tstep; u.i0 = pm * BM; u.i1 = pn; return true;
    }
    __device__ __forceinline__ void a_ready(const Unit&) const {}
    __device__ __forceinline__ void done(const Unit&) const {}
};
struct MoeOrder {
    int G, c, nblk, npn; const PG8_LAS int* be; const char* XS; const char* HS; const char* W; size_t a_tile, w_exp, w_tile;
    __device__ __forceinline__ bool next(int i, Unit& u) const {
        int blk, pn;
        if ((G & 7) == 0) { const int x = c & 7, r = c >> 3, W = G >> 3, nb = nblk + NT / 256, q = nb >> 3, rem = nb & 7;
            const int b0 = x * q + (x < rem ? x : rem), cntb = q + (x < rem ? 1 : 0); const long kk = (long)i * W + r; if (kk >= (long)cntb * npn) return false;
            blk = b0 + (int)(kk / npn); pn = (int)(kk % npn); }
        else { const long L = (long)i * G + c; if (L >= (long)(nblk + NT / 256) * npn) return false; blk = (int)(L / npn); pn = (int)(L % npn); }
        int e;
        if (blk < nblk) { e = be[blk]; u.A = XS + (size_t)blk * a_tile; u.i0 = blk * 256; }
        else { e = 64; u.A = HS + (size_t)(blk - nblk) * a_tile; u.i0 = NSLOT + (blk - nblk) * 256; }
        if (tokof) u.A = HS;
        u.B = W + (size_t)e * w_exp + (size_t)pn * w_tile; u.i1 = pn; return true;
    }
    __device__ __forceinline__ void a_ready(const Unit&) const {}
    __device__ __forceinline__ void done(const Unit&) const {}
    const int* tokof; unsigned rowbytes; const PG8_LAS int* po; const PG8_LAS int* lc;
    __device__ __forceinline__ unsigned rowoff(const Unit& u, int r) const {
        int t;
        if (u.i0 < NSLOT) { const int e = be[u.i0 >> 8], rk = u.i0 - po[e] + r, c = lc[e]; const int tt = tokof[(size_t)e * NT + (rk < c ? rk : 0)]; t = rk < c ? tt : 0; }
        else t = u.i0 - NSLOT + r;
        return (unsigned)t * rowbytes; }
};
template <bool NT_ST = false> struct EpiStoreBf16T {
    static constexpr bool BP16 = false; static constexpr bool PERM = true, AFTER_DRAIN = false;
    bf16_t* O; int ldc;
    __device__ __forceinline__ void operator()(const f32x4 (&acc)[2][2][4][2], const Unit& u, int wr, int wc, int fr, int fq) const {
        bf16_t* base = O + (size_t)(u.i0 + wr * 64 + fr) * ldc + u.i1 * BM + wc * 32 + 8 * fq;
#pragma unroll
        for (int ai = 0; ai < 2; ++ai)
#pragma unroll
            for (int m = 0; m < 4; ++m) { bf16_t* rowp = base + (size_t)(ai * HALF + m * 16) * ldc;
#pragma unroll
                for (int bj = 0; bj < 2; ++bj) { const f32x4 v0 = acc[ai][bj][m][0], v1 = acc[ai][bj][m][1];
                    u32x4 w; w.x = cvt_pk_bf16(v0[0], v0[1]); w.y = cvt_pk_bf16(v0[2], v0[3]); w.z = cvt_pk_bf16(v1[0], v1[1]); w.w = cvt_pk_bf16(v1[2], v1[3]);
                    if constexpr (NT_ST) __builtin_nontemporal_store(w, (u32x4*)(rowp + bj * HALF)); else *(u32x4*)(rowp + bj * HALF) = w; } }
    }
};
typedef EpiStoreBf16T<false> EpiStoreBf16;
struct EpiSwiglu {
    static constexpr bool BP16 = false; static constexpr bool PERM = true, AFTER_DRAIN = false;
    bf16_t* O;
    __device__ __forceinline__ void operator()(const f32x4 (&acc)[2][2][4][2], const Unit& u, int wr, int wc, int fr, int fq) const {
        bf16_t* base = O + (size_t)(u.i0 + wr * 64 + fr) * 512 + u.i1 * 128 + wc * 32 + 8 * fq;
#pragma unroll
        for (int ai = 0; ai < 2; ++ai)
#pragma unroll
            for (int m = 0; m < 4; ++m) { float r[8];
#pragma unroll
                for (int n = 0; n < 2; ++n)
#pragma unroll
                    for (int j = 0; j < 4; ++j) { const float g = acc[ai][0][m][n][j], up = acc[ai][1][m][n][j]; r[n * 4 + j] = g * __builtin_amdgcn_rcpf(1.f + __expf(-g)) * up; }
                u32x4 w; w.x = cvt_pk_bf16(r[0], r[1]); w.y = cvt_pk_bf16(r[2], r[3]); w.z = cvt_pk_bf16(r[4], r[5]); w.w = cvt_pk_bf16(r[6], r[7]);
                *(u32x4*)(base + (size_t)(ai * HALF + m * 16) * 512) = w; }
    }
};
struct EpiResid {
    static constexpr bool BP16 = false, PACED = false; static constexpr bool PERM = true, AFTER_DRAIN = false;
    const float* xin; const bf16_t* xinb; bf16_t* xo; const float* mod_g1;
    __device__ __forceinline__ void operator()(const f32x4 (&acc)[2][2][4][2], const Unit& u, int wr, int wc, int fr, int fq) const {
        const int col0 = u.i1 * BM + wc * 32 + 8 * fq; const float* g1 = mod_g1 + (size_t)(u.i0 / SEQ) * 12288 + col0;
        f32x4 gv[2][2];
#pragma unroll
        for (int bj = 0; bj < 2; ++bj)
#pragma unroll
            for (int n = 0; n < 2; ++n) gv[bj][n] = *(const f32x4*)(g1 + bj * HALF + n * 4);
        const bool xb = xinb != nullptr;
#pragma unroll
        for (int ai = 0; ai < 2; ++ai)
#pragma unroll
            for (int m = 0; m < 4; ++m) { const size_t off = (size_t)(u.i0 + wr * 64 + fr + ai * HALF + m * 16) * DM + col0;
#pragma unroll
                for (int bj = 0; bj < 2; ++bj) { f32x4 x0, x1;
                    if (xb) { const u32x4 w = *(const u32x4*)(xinb + off + bj * HALF);
                        x0 = (f32x4){__uint_as_float(w.x << 16), __uint_as_float(w.x & 0xffff0000u), __uint_as_float(w.y << 16), __uint_as_float(w.y & 0xffff0000u)};
                        x1 = (f32x4){__uint_as_float(w.z << 16), __uint_as_float(w.z & 0xffff0000u), __uint_as_float(w.w << 16), __uint_as_float(w.w & 0xffff0000u)}; }
                    else { x0 = *(const f32x4*)(xin + off + bj * HALF); x1 = *(const f32x4*)(xin + off + bj * HALF + 4); }
                    const f32x4 r0 = x0 + gv[bj][0] * acc[ai][bj][m][0], r1 = x1 + gv[bj][1] * acc[ai][bj][m][1];
                    u32x4 o; o.x = cvt_pk_bf16(r0[0], r0[1]); o.y = cvt_pk_bf16(r0[2], r0[3]); o.z = cvt_pk_bf16(r1[0], r1[1]); o.w = cvt_pk_bf16(r1[2], r1[3]);
                    *(u32x4*)(xo + off + bj * HALF) = o; }
                if (m & 1) asm volatile("" ::: "memory"); }
    }
};
}

namespace pg8 {
struct EpiStoreFp8 {
    static constexpr bool BP16 = true, PERM = true, AFTER_DRAIN = false;
    unsigned char* O;
    __device__ __forceinline__ static unsigned pk4(const f32x4 v) {
        int w = __builtin_amdgcn_cvt_pk_fp8_f32(__builtin_amdgcn_fmed3f(v[0], -448.f, 448.f), __builtin_amdgcn_fmed3f(v[1], -448.f, 448.f), 0, false);
        w = __builtin_amdgcn_cvt_pk_fp8_f32(__builtin_amdgcn_fmed3f(v[2], -448.f, 448.f), __builtin_amdgcn_fmed3f(v[3], -448.f, 448.f), w, true); return (unsigned)w; }
    __device__ __forceinline__ void operator()(const f32x4 (&acc)[2][2][4][2], const Unit& u, int wr, int wc, int fr, int fq) const {
        unsigned char* base = O + (size_t)(u.i0 + wr * 64 + fr) * DM + u.i1 * BM + wc * 64 + 16 * fq;
#pragma unroll
        for (int ai = 0; ai < 2; ++ai)
#pragma unroll
            for (int m = 0; m < 4; ++m) { u32x4 w; w.x = pk4(acc[ai][0][m][0]); w.y = pk4(acc[ai][0][m][1]); w.z = pk4(acc[ai][1][m][0]); w.w = pk4(acc[ai][1][m][1]);
                *(u32x4*)(base + (size_t)(ai * HALF + m * 16) * DM) = w; }
    }
};
}
constexpr int LDS_PO = 148 * 1024;
constexpr int LDS_BE = 148 * 1024 + 512;
constexpr int LDS_BST = 148 * 1024 + 3072;
constexpr int LDS_LC = 148 * 1024 + 3200;
DI void st_inproj_mm(const Params& p, int l, unsigned char* smem, const int WV) {
    const int TIDX = opq_tid(WV), BIDX = opq_bid();
    pg8::GridOrder S; S.init(NT, 6144, DM, gridDim.x, BIDX, p.ws + WS_H, wl_ptr(p, l, WL_WIN));
    pg8::EpiStoreBf16 E{(bf16_t*)(p.ws + WS_Y), LDY};
    pg8::gemm_phase(( PG8_LAS unsigned char*)smem, DM, S, E, TIDX);
}
DI void st_outproj_mm(const Params& p, int l, const float* xin, const bf16_t* xinb, unsigned char* smem, const int WV) {
    const int TIDX = opq_tid(WV), BIDX = opq_bid();
    pg8::GridOrder S; S.init(NT, DM, DM, gridDim.x, BIDX, p.ws + WS_YMIX, wl_ptr(p, l, WL_WOUT));
    pg8::EpiResid E{xin, xinb, (bf16_t*)(p.ws + WS_X1), mod_ptr(p, l, 0, 2)};
    pg8::gemm_phase((PG8_LAS unsigned char*)smem, DM, S, E, TIDX);
}
DI void moe_offsets(const Params& p, int l, unsigned char* smem, int TIDX) {
    const unsigned* CNT = (const unsigned*)(p.ws + WS_CTL) + CW_CNT + l * 64; int* po = (int*)(smem + LDS_PO);
    __syncthreads();
    if (TIDX < 64) { const int pad = (int)((CNT[TIDX] + 255u) >> 8) << 8; int inc = pad;
        ((int*)(smem + LDS_LC))[TIDX] = (int)CNT[TIDX];
#pragma unroll
        for (int o = 1; o < 64; o <<= 1) { const int v = __shfl_up(inc, o); if (TIDX >= o) inc += v; }
        po[TIDX] = inc - pad; if (TIDX == 63) po[64] = inc; }
    __syncthreads();
    int* be = (int*)(smem + LDS_BE);
    for (int blk = TIDX; blk < 576; blk += 512) { int e = 0;
#pragma unroll 1
        while (e < 63 && po[e + 1] <= blk * 256) ++e;
        be[blk] = e; }
    __syncthreads();
}
DI void st_gemm1_mm(const Params& p, int l, unsigned char* smem, const int WV) {
    const int TIDX = opq_tid(WV), BIDX = opq_bid();
    moe_offsets(p, l, smem, TIDX);
    const PG8_LAS int* po = (const PG8_LAS int*)(PG8_LAS unsigned char*)(smem + LDS_PO);
    pg8::MoeOrder S; S.tokof = (const int*)(p.ws + WS_XS); S.po = po; S.lc = (const PG8_LAS int*)(PG8_LAS unsigned char*)(smem + LDS_LC); S.rowbytes = DM * 2; S.G = gridDim.x; S.c = BIDX; S.nblk = po[64] / 256; S.npn = 4; S.be = (const PG8_LAS int*)(PG8_LAS unsigned char*)(smem + LDS_BE); S.XS = (const char*)(p.ws + WS_XS); S.HS = (const char*)(p.ws + WS_H); S.W = (const char*)wl_ptr(p, l, WL_EGU);
    S.a_tile = (size_t)256 * DM * 2; S.w_exp = (size_t)1024 * DM * 2; S.w_tile = (size_t)256 * DM * 2;
    pg8::EpiSwiglu E{(bf16_t*)(p.ws + WS_ACT)};
    pg8::gemm_phase<pg8::EpiSwiglu, pg8::MoeOrder, true>((PG8_LAS unsigned char*)smem, DM, S, E, TIDX);
}
DI void st_gemm2_mm(const Params& p, int l, unsigned char* smem, const int WV) {
    const int TIDX = opq_tid(WV), BIDX = opq_bid();
    moe_offsets(p, l, smem, TIDX);
    const PG8_LAS int* po = (const PG8_LAS int*)(PG8_LAS unsigned char*)(smem + LDS_PO);
    pg8::MoeOrder S; S.tokof = nullptr; S.po = po; S.lc = (const PG8_LAS int*)(PG8_LAS unsigned char*)(smem + LDS_LC); S.rowbytes = 0; S.G = gridDim.x; S.c = BIDX; S.nblk = po[64] / 256; S.npn = 8; S.be = (const PG8_LAS int*)(PG8_LAS unsigned char*)(smem + LDS_BE); S.XS = (const char*)(p.ws + WS_ACT); S.HS = (const char*)(p.ws + WS_ACT) + (size_t)NSLOT * 512 * 2; S.W = (const char*)wl_ptr(p, l, WL_EDN);
    S.a_tile = (size_t)256 * 512 * 2; S.w_exp = (size_t)DM * 512 * 2; S.w_tile = (size_t)256 * 512 * 2;
    pg8::EpiStoreFp8 E{(unsigned char*)(p.ws + WS_YS)};
    pg8::gemm_phase((PG8_LAS unsigned char*)smem, 512, S, E, TIDX);
}

typedef short bf16x8_t __attribute__((ext_vector_type(8)));
typedef float f32x16_t __attribute__((ext_vector_type(16)));
#define LASP __attribute__((address_space(3)))
DI void st_vt(const Params& p, int l, unsigned char* smem, const int WV) {
    const int TIDX = opq_tid(WV), BIDX = opq_bid();
    const bf16_t* Y = (const bf16_t*)(p.ws + WS_Y); bf16_t* VT = (bf16_t*)(p.ws + WS_VT);
    LDSF bf16_t* T = (LDSF bf16_t*)(LDSF unsigned char*)smem;
    constexpr int TSZ = 128 * 72;
    for (int u0 = BIDX; u0 < NB * 64 * 4; u0 += 4 * gridDim.x) {
        { const int tok = TIDX & 63, dseg = (TIDX >> 6) * 16; uint4 v[4][2];
#pragma unroll
          for (int k = 0; k < 4; ++k) { const int u = u0 + k * gridDim.x;
              if (u < NB * 64 * 4) { const int b = u >> 8, tile = (u >> 2) & 63, wh = u & 3, br = 1 + (wh >> 1), g = wh & 1;
                  const uint4* src = (const uint4*)(Y + ((size_t)b * SEQ + tile * 64 + tok) * LDY + Y_KV + br * 512 + 256 + g * 128 + dseg); v[k][0] = src[0]; v[k][1] = src[1]; }
              else { v[k][0] = make_uint4(0u, 0u, 0u, 0u); v[k][1] = v[k][0]; } }
          const int pos = (tok & ~15) | kperm16(tok & 15);
#pragma unroll
          for (int k = 0; k < 4; ++k) { const unsigned w[8] = {v[k][0].x, v[k][0].y, v[k][0].z, v[k][0].w, v[k][1].x, v[k][1].y, v[k][1].z, v[k][1].w};
#pragma unroll
              for (int i = 0; i < 8; ++i) { T[k * TSZ + (dseg + 2 * i) * 72 + pos] = (bf16_t)(w[i] & 0xffffu); T[k * TSZ + (dseg + 2 * i + 1) * 72 + pos] = (bf16_t)(w[i] >> 16); } } }
        __syncthreads();
        { const int d = TIDX >> 2, seg = (TIDX & 3) * 16;
          typedef unsigned u4v_t __attribute__((ext_vector_type(4)));
#pragma unroll
          for (int k = 0; k < 4; ++k) { const int u = u0 + k * gridDim.x;
              if (u < NB * 64 * 4) { const int b = u >> 8, tile = (u >> 2) & 63, wh = u & 3, br = 1 + (wh >> 1), g = wh & 1;
                  const LDSF u4v_t* sp = (const LDSF u4v_t*)(T + k * TSZ + d * 72 + seg);
                  u4v_t* dst = (u4v_t*)(VT + ((size_t)((b * 2 + g) * 2 + (br - 1)) * 128 + d) * SEQ + tile * 64 + seg); const u4v_t s0 = sp[0], s1 = sp[1]; dst[0] = s0; dst[1] = s1; } } }
        __syncthreads();
    }
}
DI float fast_exp2(float x) { return __builtin_amdgcn_exp2f(x); }
#define DSR(dst, addr, off) asm volatile("ds_read_b128 %0, %1 offset:%2" : "=v"(dst) : "v"(addr), "i"(off) : "memory")
#define LWAIT(n, var) asm volatile("s_waitcnt lgkmcnt(" #n ")" : "+v"(var) :: "memory")
DI void qk_tile_pipe(f32x16_t& s0, f32x16_t& s1, const unsigned kb, const int xh, const bf16x8_t (&qf)[8]) {
    bf16x8_t f0, f1, f2, f3;
#pragma unroll
    for (int r = 0; r < 16; ++r) { s0[r] = 0.f; s1[r] = 0.f; }
    DSR(f0, (kb + (unsigned)((0 ^ xh) << 5)), 0);
    DSR(f1, (kb + (unsigned)((0 ^ xh) << 5)), 8192);
    DSR(f2, (kb + (unsigned)((1 ^ xh) << 5)), 0);
    DSR(f3, (kb + (unsigned)((1 ^ xh) << 5)), 8192);
    LWAIT(3, f0); s0 = __builtin_amdgcn_mfma_f32_32x32x16_bf16(f0, qf[0], s0, 0, 0, 0); DSR(f0, (kb + (unsigned)((2 ^ xh) << 5)), 0);
    LWAIT(3, f1); s1 = __builtin_amdgcn_mfma_f32_32x32x16_bf16(f1, qf[0], s1, 0, 0, 0); DSR(f1, (kb + (unsigned)((2 ^ xh) << 5)), 8192);
    LWAIT(3, f2); s0 = __builtin_amdgcn_mfma_f32_32x32x16_bf16(f2, qf[1], s0, 0, 0, 0); DSR(f2, (kb + (unsigned)((3 ^ xh) << 5)), 0);
    LWAIT(3, f3); s1 = __builtin_amdgcn_mfma_f32_32x32x16_bf16(f3, qf[1], s1, 0, 0, 0); DSR(f3, (kb + (unsigned)((3 ^ xh) << 5)), 8192);
    LWAIT(3, f0); s0 = __builtin_amdgcn_mfma_f32_32x32x16_bf16(f0, qf[2], s0, 0, 0, 0); DSR(f0, (kb + (unsigned)((4 ^ xh) << 5)), 0);
    LWAIT(3, f1); s1 = __builtin_amdgcn_mfma_f32_32x32x16_bf16(f1, qf[2], s1, 0, 0, 0); DSR(f1, (kb + (unsigned)((4 ^ xh) << 5)), 8192);
    LWAIT(3, f2); s0 = __builtin_amdgcn_mfma_f32_32x32x16_bf16(f2, qf[3], s0, 0, 0, 0); DSR(f2, (kb + (unsigned)((5 ^ xh) << 5)), 0);
    LWAIT(3, f3); s1 = __builtin_amdgcn_mfma_f32_32x32x16_bf16(f3, qf[3], s1, 0, 0, 0); DSR(f3, (kb + (unsigned)((5 ^ xh) << 5)), 8192);
    LWAIT(3, f0); s0 = __builtin_amdgcn_mfma_f32_32x32x16_bf16(f0, qf[4], s0, 0, 0, 0); DSR(f0, (kb + (unsigned)((6 ^ xh) << 5)), 0);
    LWAIT(3, f1); s1 = __builtin_amdgcn_mfma_f32_32x32x16_bf16(f1, qf[4], s1, 0, 0, 0); DSR(f1, (kb + (unsigned)((6 ^ xh) << 5)), 8192);
    LWAIT(3, f2); s0 = __builtin_amdgcn_mfma_f32_32x32x16_bf16(f2, qf[5], s0, 0, 0, 0); DSR(f2, (kb + (unsigned)((7 ^ xh) << 5)), 0);
    LWAIT(3, f3); s1 = __builtin_amdgcn_mfma_f32_32x32x16_bf16(f3, qf[5], s1, 0, 0, 0); DSR(f3, (kb + (unsigned)((7 ^ xh) << 5)), 8192);
    LWAIT(3, f0); s0 = __builtin_amdgcn_mfma_f32_32x32x16_bf16(f0, qf[6], s0, 0, 0, 0);
    LWAIT(2, f1); s1 = __builtin_amdgcn_mfma_f32_32x32x16_bf16(f1, qf[6], s1, 0, 0, 0);
    LWAIT(1, f2); s0 = __builtin_amdgcn_mfma_f32_32x32x16_bf16(f2, qf[7], s0, 0, 0, 0);
    LWAIT(0, f3); s1 = __builtin_amdgcn_mfma_f32_32x32x16_bf16(f3, qf[7], s1, 0, 0, 0);
}
DI void pv_tile_pipe(f32x16_t (&O)[4], const unsigned vb, const int yh, const bf16x8_t (&pf)[4]) {
    bf16x8_t f0, f1, f2, f3;
    const unsigned av0 = vb + (unsigned)((0 ^ yh) << 5), av1 = vb + (unsigned)((1 ^ yh) << 5), av2 = vb + (unsigned)((2 ^ yh) << 5), av3 = vb + (unsigned)((3 ^ yh) << 5);
    DSR(f0, av0, 0);
    DSR(f1, av0, 4096);
    DSR(f2, av0, 8192);
    DSR(f3, av0, 12288);
    LWAIT(3, f0); O[0] = __builtin_amdgcn_mfma_f32_32x32x16_bf16(f0, pf[0], O[0], 0, 0, 0); DSR(f0, av1, 0);
    LWAIT(3, f1); O[1] = __builtin_amdgcn_mfma_f32_32x32x16_bf16(f1, pf[0], O[1], 0, 0, 0); DSR(f1, av1, 4096);
    LWAIT(3, f2); O[2] = __builtin_amdgcn_mfma_f32_32x32x16_bf16(f2, pf[0], O[2], 0, 0, 0); DSR(f2, av1, 8192);
    LWAIT(3, f3); O[3] = __builtin_amdgcn_mfma_f32_32x32x16_bf16(f3, pf[0], O[3], 0, 0, 0); DSR(f3, av1, 12288);
    LWAIT(3, f0); O[0] = __builtin_amdgcn_mfma_f32_32x32x16_bf16(f0, pf[1], O[0], 0, 0, 0); DSR(f0, av2, 0);
    LWAIT(3, f1); O[1] = __builtin_amdgcn_mfma_f32_32x32x16_bf16(f1, pf[1], O[1], 0, 0, 0); DSR(f1, av2, 4096);
    LWAIT(3, f2); O[2] = __builtin_amdgcn_mfma_f32_32x32x16_bf16(f2, pf[1], O[2], 0, 0, 0); DSR(f2, av2, 8192);
    LWAIT(3, f3); O[3] = __builtin_amdgcn_mfma_f32_32x32x16_bf16(f3, pf[1], O[3], 0, 0, 0); DSR(f3, av2, 12288);
    LWAIT(3, f0); O[0] = __builtin_amdgcn_mfma_f32_32x32x16_bf16(f0, pf[2], O[0], 0, 0, 0); DSR(f0, av3, 0);
    LWAIT(3, f1); O[1] = __builtin_amdgcn_mfma_f32_32x32x16_bf16(f1, pf[2], O[1], 0, 0, 0); DSR(f1, av3, 4096);
    LWAIT(3, f2); O[2] = __builtin_amdgcn_mfma_f32_32x32x16_bf16(f2, pf[2], O[2], 0, 0, 0); DSR(f2, av3, 8192);
    LWAIT(3, f3); O[3] = __builtin_amdgcn_mfma_f32_32x32x16_bf16(f3, pf[2], O[3], 0, 0, 0); DSR(f3, av3, 12288);
    LWAIT(3, f0); O[0] = __builtin_amdgcn_mfma_f32_32x32x16_bf16(f0, pf[3], O[0], 0, 0, 0);
    LWAIT(2, f1); O[1] = __builtin_amdgcn_mfma_f32_32x32x16_bf16(f1, pf[3], O[1], 0, 0, 0);
    LWAIT(1, f2); O[2] = __builtin_amdgcn_mfma_f32_32x32x16_bf16(f2, pf[3], O[2], 0, 0, 0);
    LWAIT(0, f3); O[3] = __builtin_amdgcn_mfma_f32_32x32x16_bf16(f3, pf[3], O[3], 0, 0, 0);
}
#undef DSR
#undef LWAIT
template <int BR>
DI float attn_mask_max(f32x16_t& s0, f32x16_t& s1, int j, int qb, int qoff, int hi, unsigned long long sel) {
    constexpr float C2 = 0.08838834764831845f * 1.4426950408889634f;
    const float NEGINF = -__builtin_inff();
    if (j == qb) {
#pragma unroll
        for (int r = 0; r < 16; ++r) { const int kk = (r & 3) + 8 * (r >> 2) + 4 * hi; if (kk > qoff) s0[r] = NEGINF; if (kk + 32 > qoff) s1[r] = NEGINF; }
    } else if (BR == 1) { const bool on = (sel >> j) & 1ull;
        if (!__all(on)) {
#pragma unroll
            for (int r = 0; r < 16; ++r) { s0[r] = on ? s0[r] : NEGINF; s1[r] = on ? s1[r] : NEGINF; } }
    } else if (j == qb - 8) {
#pragma unroll
        for (int r = 0; r < 16; ++r) { const int kk = (r & 3) + 8 * (r >> 2) + 4 * hi; if (kk <= qoff) s0[r] = NEGINF; if (kk + 32 <= qoff) s1[r] = NEGINF; }
    }
    float mx = s0[0];
#pragma unroll
    for (int r = 1; r < 16; ++r) mx = fmaxf(mx, s0[r]);
#pragma unroll
    for (int r = 0; r < 16; ++r) mx = fmaxf(mx, s1[r]);
    auto sw = __builtin_amdgcn_permlane32_swap(__float_as_uint(mx), __float_as_uint(mx), false, false);
    return fmaxf(__uint_as_float(sw[0]), __uint_as_float(sw[1])) * C2;
}
template <int BR>
DI void attn_branch(LASP unsigned char* ldsw, const bf16_t* yb, const bf16_t* vtb, int g, int qb, int half, int qi, int hi, int wid, int lane, const bf16x8_t (&qf)[8], unsigned long long sel, unsigned long long tiles, f32x16_t (&O)[4]) {
    constexpr float C2 = 0.08838834764831845f * 1.4426950408889634f;
    const LASP unsigned char* lds = ldsw;
    const bool grpB = wid >= 4;
    unsigned kgo[2], vgo[2];
#pragma unroll
    for (int i = 0; i < 2; ++i) { const int pp = (2 * wid + i) * 64 + lane; const int key = pp >> 4, c = (pp & 15) ^ (key & 15); kgo[i] = (unsigned)(key * (LDY * 2) + c * 16);
        const int d = pp >> 3, cv = (pp & 7) ^ ((d >> 1) & 7); vgo[i] = (unsigned)(d * (SEQ * 2) + cv * 16); }
    const char* kbase = (const char*)(yb + Y_KV + BR * 512 + g * 128);
    const char* vbase = (const char*)(vtb + (size_t)(BR - 1) * 128 * SEQ);
#define DMA_TILE(jj, buf) do { const char* kb_ = kbase + (size_t)(jj) * (64 * LDY * 2); const char* vb_ = vbase + (size_t)(jj) * 128; \
        _Pragma("unroll") for (int i_ = 0; i_ < 2; ++i_) { \
            __builtin_amdgcn_global_load_lds((const unsigned*)(kb_ + kgo[i_]), (LASP unsigned*)(ldsw + (buf) * 32768u + (unsigned)((2 * wid + i_) * 1024)), 16, 0, 0); \
            __builtin_amdgcn_global_load_lds((const unsigned*)(vb_ + vgo[i_]), (LASP unsigned*)(ldsw + (buf) * 32768u + 16384u + (unsigned)((2 * wid + i_) * 1024)), 16, 0, 0); } } while (0)
#define BAR_ONLY() do { asm volatile("" ::: "memory"); __builtin_amdgcn_s_barrier(); asm volatile("" ::: "memory"); } while (0)
#define WAIT_DMA(newest_in_flight) do { if (newest_in_flight) asm volatile("s_waitcnt vmcnt(4)" ::: "memory"); else asm volatile("s_waitcnt vmcnt(0)" ::: "memory"); } while (0)
    const int x = qi & 15, xh = x >> 1; const unsigned kra = (unsigned)(qi * 256 + (((hi ^ x) & 1) << 4));
    const int yv = (qi >> 1) & 7, yh = yv >> 1; const unsigned vra = (unsigned)(16384 + qi * 128 + (((hi ^ yv) & 1) << 4));
    const int qoff = 32 * half + qi;
    float m_run = -1.0e30f, l_run = 0.f;
#pragma unroll
    for (int dt = 0; dt < 4; ++dt)
#pragma unroll
        for (int r = 0; r < 16; ++r) O[dt][r] = 0.f;
    unsigned long long rem = tiles;
    int jc = __builtin_ctzll(rem); rem &= rem - 1;
    int j1 = rem ? __builtin_ctzll(rem) : -1; rem &= rem - 1;
    int j2 = rem ? __builtin_ctzll(rem) : -1; rem &= rem - 1;
    asm volatile("s_waitcnt vmcnt(0)" ::: "memory");
    DMA_TILE(jc, 0u);
    if (j1 >= 0) DMA_TILE(j1, 1u);
    if (j2 >= 0) DMA_TILE(j2, 2u);
    WAIT_DMA(j2 >= 0);
    BAR_ONLY();
    f32x16_t s0, s1;
    qk_tile_pipe(s0, s1, (unsigned)(uintptr_t)ldsw + kra, xh, qf);
    m_run = fmaxf(m_run, attn_mask_max<BR>(s0, s1, jc, qb, qoff, hi, sel));
    if (grpB) BAR_ONLY();
    unsigned cur = 0;
    for (;;) {
        const int j3 = rem ? __builtin_ctzll(rem) : -1; rem &= rem - 1;
        if (grpB && j3 >= 0) DMA_TILE(j3, ((cur + 3u) & 3u));
        float ps = 0.f;
#pragma unroll
        for (int r = 0; r < 16; ++r) { s0[r] = fast_exp2(s0[r] * C2 - m_run); s1[r] = fast_exp2(s1[r] * C2 - m_run); ps += s0[r] + s1[r]; }
        l_run += ps;
        bf16x8_t pf[4];
#pragma unroll
        for (int s = 0; s < 4; ++s) { const f32x16_t& sv = (s < 2) ? s0 : s1; const int o = (s & 1) * 8;
            typedef unsigned u4_t __attribute__((ext_vector_type(4))); u4_t ww = {pg8::cvt_pk_bf16(sv[o + 0], sv[o + 1]), pg8::cvt_pk_bf16(sv[o + 2], sv[o + 3]), pg8::cvt_pk_bf16(sv[o + 4], sv[o + 5]), pg8::cvt_pk_bf16(sv[o + 6], sv[o + 7])};
            pf[s] = *reinterpret_cast<bf16x8_t*>(&ww); }
        if (!grpB) WAIT_DMA(j2 >= 0);
        BAR_ONLY();
        if (!grpB && j3 >= 0) DMA_TILE(j3, ((cur + 3u) & 3u));
        __builtin_amdgcn_s_setprio(1);
        const unsigned lbase = (unsigned)(uintptr_t)ldsw;
        pv_tile_pipe(O, lbase + cur * 32768u + vra, yh, pf);
        if (j1 >= 0) qk_tile_pipe(s0, s1, lbase + ((cur + 1u) & 3u) * 32768u + kra, xh, qf);
        __builtin_amdgcn_s_setprio(0);
        if (grpB) WAIT_DMA(j3 >= 0);
        BAR_ONLY();
        if (j1 < 0) break;
        { const float mx = attn_mask_max<BR>(s0, s1, j1, qb, qoff, hi, sel);
          if (__any(mx > m_run + 8.f)) { const float m_new = fmaxf(m_run, mx), alpha = fast_exp2(m_run - m_new); m_run = m_new; l_run *= alpha;
#pragma unroll
              for (int dt = 0; dt < 4; ++dt)
#pragma unroll
                  for (int r = 0; r < 16; ++r) O[dt][r] *= alpha; } }
        cur = (cur + 1u) & 3u; jc = j1; j1 = j2; j2 = j3;
    }
    if (!grpB) BAR_ONLY();
    asm volatile("s_waitcnt vmcnt(0)" ::: "memory");
    BAR_ONLY();
#undef DMA_TILE
#undef BAR_ONLY
#undef WAIT_DMA
    float lt;
    { auto sw = __builtin_amdgcn_permlane32_swap(__float_as_uint(l_run), __float_as_uint(l_run), false, false); lt = __uint_as_float(sw[0]) + __uint_as_float(sw[1]); }
    const float inv = 1.f / lt;
#pragma unroll
    for (int dt = 0; dt < 4; ++dt)
#pragma unroll
        for (int r = 0; r < 16; ++r) O[dt][r] *= inv;
}
DI void st_attn_mm(const Params& p, int l, unsigned char* smem, const int WV) {
    const int TIDX = opq_tid(WV), BIDX = opq_bid();
    const int wid = __builtin_amdgcn_readfirstlane(TIDX >> 6), lane0 = TIDX & 63, rr = wid >> 1, half = wid & 1;
    const bf16_t* Y = (const bf16_t*)(p.ws + WS_Y); const float* OC = (const float*)(p.ws + WS_OCMP); const unsigned long long* SEL = (const unsigned long long*)(p.ws + WS_SEL);
    bf16_t* YM = (bf16_t*)(p.ws + WS_YMIX); const bf16_t* VT = (const bf16_t*)(p.ws + WS_VT);
    const LASP unsigned char* lds = (const LASP unsigned char*)smem;
    LASP unsigned long long* sor = (LASP unsigned long long*)(LASP unsigned char*)(smem + 131072);
    for (int item = BIDX; item < 256; item += gridDim.x) {
        const int bg = item & 7, pr = item >> 3, b = bg >> 1, g = bg & 1, h = g * 4 + rr;
        const bf16_t* yb = Y + (size_t)b * SEQ * LDY; const bf16_t* vtb = VT + (size_t)bg * 2 * 128 * SEQ;
#pragma unroll 1
        for (int pass = 0; pass < 2; ++pass) {
            int lane = lane0; asm volatile("" : "+v"(lane));
            const int qi = lane & 31, hi = lane >> 5;
            const int qb = pass ? pr : 63 - pr, t = qb * 64 + 32 * half + qi;
            const bf16_t* yrow = yb + (size_t)t * LDY;
            bf16x8_t qf[8];
#pragma unroll
            for (int ks = 0; ks < 8; ++ks) qf[ks] = *(const bf16x8_t*)(yrow + Y_QN + h * 128 + 16 * ks + 8 * hi);
            const unsigned long long sel = SEL[(size_t)bg * SEQ + t];
            { unsigned lo = (unsigned)sel, hi32 = (unsigned)(sel >> 32);
#pragma unroll
              for (int o = 1; o < 32; o <<= 1) { lo |= __shfl_xor(lo, o); hi32 |= __shfl_xor(hi32, o); }
              if (wid < 2 && lane == 0) sor[wid] = ((unsigned long long)hi32 << 32) | lo; }
            __syncthreads();
            const unsigned long long lowmask = (qb == 63) ? ~0ull : ((2ull << qb) - 1ull);
            const unsigned long long tiles_s = (sor[0] | sor[1] | 1ull | (1ull << qb)) & lowmask;
            const int jlo = qb >= 8 ? qb - 8 : 0; const unsigned long long tiles_w = lowmask & ~((1ull << jlo) - 1ull);
            f32x16_t O[4];
            const float* gp_ = (const float*)(p.ws + WS_GATEP) + ((size_t)b * SEQ + t) * 256 + h * 3;
            const float g0 = sigmoid_f(gp_[0] + gp_[(size_t)NT * 256]), g1 = sigmoid_f(gp_[1] + gp_[(size_t)NT * 256 + 1]), g2 = sigmoid_f(gp_[2] + gp_[(size_t)NT * 256 + 2]);
            const float* ocrow = OC + ((size_t)b * SEQ + t) * 1024 + h * 128 + 4 * hi; float* ptrow = (float*)(p.ws + WS_PART) + ((size_t)b * SEQ + t) * 1024 + h * 128 + 4 * hi;
            attn_branch<1>((LASP unsigned char*)smem, yb, vtb, g, qb, half, qi, hi, wid, lane, qf, sel, tiles_s, O);
            { float4 cc[16];
#pragma unroll
              for (int i = 0; i < 16; ++i) cc[i] = *(const float4*)(ocrow + 32 * (i >> 2) + 8 * (i & 3));
#pragma unroll
              for (int i = 0; i < 16; ++i) { const int dt = i >> 2, rq = i & 3; float4 c = cc[i];
                  c.x = g0 * c.x + g1 * O[dt][4 * rq + 0]; c.y = g0 * c.y + g1 * O[dt][4 * rq + 1]; c.z = g0 * c.z + g1 * O[dt][4 * rq + 2]; c.w = g0 * c.w + g1 * O[dt][4 * rq + 3];
                  *(float4*)(ptrow + 32 * dt + 8 * rq) = c; } }
            attn_branch<2>((LASP unsigned char*)smem, yb, vtb, g, qb, half, qi, hi, wid, lane, qf, sel, tiles_w, O);
            float ss = 0.f;
            { float4 cc[16];
#pragma unroll
              for (int i = 0; i < 16; ++i) cc[i] = *(const float4*)(ptrow + 32 * (i >> 2) + 8 * (i & 3));
#pragma unroll
              for (int i = 0; i < 16; ++i) { const int dt = i >> 2, rq = i & 3; const float4 c = cc[i];
                  O[dt][4 * rq + 0] = c.x + g2 * O[dt][4 * rq + 0]; O[dt][4 * rq + 1] = c.y + g2 * O[dt][4 * rq + 1]; O[dt][4 * rq + 2] = c.z + g2 * O[dt][4 * rq + 2]; O[dt][4 * rq + 3] = c.w + g2 * O[dt][4 * rq + 3];
                  ss += O[dt][4 * rq + 0] * O[dt][4 * rq + 0] + O[dt][4 * rq + 1] * O[dt][4 * rq + 1] + O[dt][4 * rq + 2] * O[dt][4 * rq + 2] + O[dt][4 * rq + 3] * O[dt][4 * rq + 3]; } }
            { auto sw = __builtin_amdgcn_permlane32_swap(__float_as_uint(ss), __float_as_uint(ss), false, false); ss = __uint_as_float(sw[0]) + __uint_as_float(sw[1]); }
            const float rn = rsqrtf(ss * (1.f / 128.f) + EPS);
            const float* ng = p.nsa_g + (size_t)l * 1024 + h * 128 + 4 * hi; bf16_t* orow = YM + ((size_t)b * SEQ + t) * DM + 512 + h * 128 + 4 * hi;
            { float4 gg[16];
#pragma unroll
              for (int i = 0; i < 16; ++i) gg[i] = *(const float4*)(ng + 32 * (i >> 2) + 8 * (i & 3));
#pragma unroll
              for (int i = 0; i < 16; ++i) { const int dt = i >> 2, rq = i & 3;
                  uint2 w; w.x = pg8::cvt_pk_bf16(O[dt][4 * rq + 0] * rn * gg[i].x, O[dt][4 * rq + 1] * rn * gg[i].y); w.y = pg8::cvt_pk_bf16(O[dt][4 * rq + 2] * rn * gg[i].z, O[dt][4 * rq + 3] * rn * gg[i].w);
                  *(uint2*)(orow + 32 * dt + 8 * rq) = w; } }
        }
    }
}

constexpr int RP = 136;
DI int kv_unit(int c, int i, int G) {
    if (G == 256) { if (c < 192) return i == 0 ? c : -1; return i < 5 ? 192 + (c - 192) * 5 + i : -1; }
    const int u = c + i * G; return u < 16 * 32 ? u : -1;
}
DI void st_kvchunk_mm(const Params& p, int l, unsigned char* smem, const int WV) {
    const int TIDX = opq_tid(WV), BIDX = opq_bid();
    const int wid = __builtin_amdgcn_readfirstlane(TIDX >> 6), lane = TIDX & 63, li = lane & 31, hi = lane >> 5;
    const bf16_t* Y = (const bf16_t*)(p.ws + WS_Y); float* KVC = (float*)(p.ws + WS_KVC);
    LDSF bf16_t* KT = (LDSF bf16_t*)smem; LDSF bf16_t* VTt = KT + 128 * RP;
    const int m = TIDX >> 2, seg = (TIDX & 3) * 32;
    uint4 kq[4], vq[4];
    const int G = gridDim.x; int u = kv_unit(BIDX, 0, G);
    if (u >= 0) { const int bh = u >> 5, c = u & 31, b = bh >> 2, h = bh & 3; const bf16_t* row = Y + ((size_t)b * SEQ + c * 128 + m) * LDY;
        const uint4* ks = (const uint4*)(row + Y_KR + h * 128 + seg); const uint4* vs = (const uint4*)(row + Y_VR + h * 128 + seg);
#pragma unroll
        for (int q4 = 0; q4 < 4; ++q4) { kq[q4] = ks[q4]; vq[q4] = vs[q4]; } }
    for (int it = 0; u >= 0; ++it) {
        const int bh = u >> 5, c = u & 31, h = bh & 3; const float lg = ret_loggamma(h);
        { const float z = __expf((float)(127 - m) * lg) * 0.08838834764831845f;
#pragma unroll
          for (int q4 = 0; q4 < 4; ++q4) { const uint4 kk = kq[q4], vv = vq[q4]; const unsigned kw[4] = {kk.x, kk.y, kk.z, kk.w}, vw[4] = {vv.x, vv.y, vv.z, vv.w};
#pragma unroll
              for (int i = 0; i < 4; ++i) { const int d = seg + q4 * 8 + 2 * i;
                  KT[d * RP + m] = f2bf(__uint_as_float(kw[i] << 16) * z); KT[(d + 1) * RP + m] = f2bf(__uint_as_float(kw[i] & 0xffff0000u) * z);
                  VTt[d * RP + m] = (bf16_t)(vw[i] & 0xffffu); VTt[(d + 1) * RP + m] = (bf16_t)(vw[i] >> 16); } } }
        const int un = kv_unit(BIDX, it + 1, G);
        { if (un >= 0) { const int bh2 = un >> 5, c2 = un & 31, b2 = bh2 >> 2, h2 = bh2 & 3; const bf16_t* row = Y + ((size_t)b2 * SEQ + c2 * 128 + m) * LDY;
              const uint4* ks = (const uint4*)(row + Y_KR + h2 * 128 + seg); const uint4* vs = (const uint4*)(row + Y_VR + h2 * 128 + seg);
#pragma unroll
              for (int q4 = 0; q4 < 4; ++q4) { kq[q4] = ks[q4]; vq[q4] = vs[q4]; } } }
        __syncthreads();
        const int db = wid & 3, eb0 = 2 * (wid >> 2);
        f32x16_t acc[2];
#pragma unroll
        for (int r = 0; r < 16; ++r) { acc[0][r] = 0.f; acc[1][r] = 0.f; }
#pragma unroll
        for (int ks = 0; ks < 8; ++ks) { const bf16x8_t a = *(const LDSF bf16x8_t*)(KT + (32 * db + li) * RP + 16 * ks + 8 * hi);
#pragma unroll
            for (int t = 0; t < 2; ++t) { const bf16x8_t bb = *(const LDSF bf16x8_t*)(VTt + (32 * (eb0 + t) + li) * RP + 16 * ks + 8 * hi); acc[t] = __builtin_amdgcn_mfma_f32_32x32x16_bf16(a, bb, acc[t], 0, 0, 0); } }
#pragma unroll
        for (int t = 0; t < 2; ++t) { float* orow = KVC + ((size_t)(bh * 32 + c) * 128 + 32 * (eb0 + t) + li) * 128 + 32 * db + 4 * hi;
#pragma unroll
            for (int rq = 0; rq < 4; ++rq) *(float4*)(orow + 8 * rq) = make_float4(acc[t][4 * rq], acc[t][4 * rq + 1], acc[t][4 * rq + 2], acc[t][4 * rq + 3]); }
        __syncthreads();
        u = un;
    }
}
DI void st_retout_mm(const Params& p, int l, unsigned char* smem, const int WV) {
    const int TIDX = opq_tid(WV), BIDX = opq_bid();
    const int wid = __builtin_amdgcn_readfirstlane(TIDX >> 6), lane = TIDX & 63, li = lane & 31, hi = lane >> 5, nb = wid & 3, eh = wid >> 2;
    const bf16_t* Y = (const bf16_t*)(p.ws + WS_Y); const bf16_t* STB = (const bf16_t*)(p.ws + WS_STATEB); bf16_t* YM = (bf16_t*)(p.ws + WS_YMIX);
    LDSF bf16_t* KL = (LDSF bf16_t*)smem; LDSF bf16_t* VL = KL + 128 * RP; LDSF bf16_t* SL = VL + 128 * RP; LDSF float* ssq = (LDSF float*)(SL + 128 * RP);
    typedef unsigned u4v_t __attribute__((ext_vector_type(4)));
    const int m = TIDX >> 2, seg = (TIDX & 3) * 32;
    u4v_t kq[4], sq[4]; uint4 vq[4]; bf16x8_t qn[8];
    if (BIDX < 16 * 32) { const int bh = BIDX >> 5, c = BIDX & 31, b = bh >> 2, h = bh & 3; const bf16_t* row = Y + ((size_t)b * SEQ + c * 128 + m) * LDY;
        const u4v_t* ks = (const u4v_t*)(row + Y_KR + h * 128 + seg); const uint4* vs = (const uint4*)(row + Y_VR + h * 128 + seg);
        const u4v_t* ss = (const u4v_t*)(STB + (size_t)(bh * 32 + c) * 16384 + (size_t)m * 128 + seg);
        const bf16_t* qrow = Y + ((size_t)b * SEQ + c * 128 + 32 * nb + li) * LDY;
#pragma unroll
        for (int q4 = 0; q4 < 4; ++q4) { kq[q4] = ks[q4]; sq[q4] = ss[q4]; vq[q4] = vs[q4]; }
#pragma unroll
        for (int ks2 = 0; ks2 < 8; ++ks2) qn[ks2] = *(const bf16x8_t*)(qrow + Y_QR + h * 128 + 16 * ks2 + 8 * hi); }
    for (int u = BIDX; u < 16 * 32; u += gridDim.x) {
        const int bh = u >> 5, c = u & 31, b = bh >> 2, h = bh & 3; const float lg2 = ret_loggamma(h) * 1.4426950408889634f;
        { const int pos = (m & ~15) | kperm16(m & 15);
#pragma unroll
          for (int q4 = 0; q4 < 4; ++q4) { *(LDSF u4v_t*)(KL + m * RP + seg + q4 * 8) = kq[q4]; *(LDSF u4v_t*)(SL + m * RP + seg + q4 * 8) = sq[q4];
              const uint4 vv = vq[q4]; const unsigned vw[4] = {vv.x, vv.y, vv.z, vv.w};
#pragma unroll
              for (int i = 0; i < 4; ++i) { const int e = seg + q4 * 8 + 2 * i; VL[e * RP + pos] = (bf16_t)(vw[i] & 0xffffu); VL[(e + 1) * RP + pos] = (bf16_t)(vw[i] >> 16); } } }
        const int n = 32 * nb + li; const bf16_t* qrow = Y + ((size_t)b * SEQ + c * 128 + n) * LDY;
        bf16x8_t qf[8];
#pragma unroll
        for (int ks = 0; ks < 8; ++ks) qf[ks] = qn[ks];
        { const int un = u + gridDim.x;
          if (un < 16 * 32) { const int bh2 = un >> 5, c2 = un & 31, b2 = bh2 >> 2, h2 = bh2 & 3; const bf16_t* row = Y + ((size_t)b2 * SEQ + c2 * 128 + m) * LDY;
              const u4v_t* ks = (const u4v_t*)(row + Y_KR + h2 * 128 + seg); const uint4* vs = (const uint4*)(row + Y_VR + h2 * 128 + seg);
              const u4v_t* ss = (const u4v_t*)(STB + (size_t)(bh2 * 32 + c2) * 16384 + (size_t)m * 128 + seg);
              const bf16_t* qrow2 = Y + ((size_t)b2 * SEQ + c2 * 128 + n) * LDY;
#pragma unroll
              for (int q4 = 0; q4 < 4; ++q4) { kq[q4] = ks[q4]; sq[q4] = ss[q4]; vq[q4] = vs[q4]; }
#pragma unroll
              for (int ks2 = 0; ks2 < 8; ++ks2) qn[ks2] = *(const bf16x8_t*)(qrow2 + Y_QR + h2 * 128 + 16 * ks2 + 8 * hi); } }
        __syncthreads();
        f32x16_t O[2];
#pragma unroll
        for (int r = 0; r < 16; ++r) { O[0][r] = 0.f; O[1][r] = 0.f; }
#pragma unroll
        for (int ks = 0; ks < 8; ++ks)
#pragma unroll
            for (int dt = 0; dt < 2; ++dt) { const bf16x8_t a = *(const LDSF bf16x8_t*)(SL + (64 * eh + 32 * dt + li) * RP + 16 * ks + 8 * hi); O[dt] = __builtin_amdgcn_mfma_f32_32x32x16_bf16(a, qf[ks], O[dt], 0, 0, 0); }
        { const float xi = fast_exp2((float)(n + 1) * lg2);
#pragma unroll
          for (int r = 0; r < 16; ++r) { O[0][r] *= xi; O[1][r] *= xi; } }
        for (int ms = 0; ms <= nb; ++ms) {
            f32x16_t s;
#pragma unroll
            for (int r = 0; r < 16; ++r) s[r] = 0.f;
#pragma unroll
            for (int ks = 0; ks < 8; ++ks) { const bf16x8_t a = *(const LDSF bf16x8_t*)(KL + (32 * ms + li) * RP + 16 * ks + 8 * hi); s = __builtin_amdgcn_mfma_f32_32x32x16_bf16(a, qf[ks], s, 0, 0, 0); }
#pragma unroll
            for (int r = 0; r < 16; ++r) { const int m = 32 * ms + (r & 3) + 8 * (r >> 2) + 4 * hi; const int df = n - m;
                s[r] = df >= 0 ? s[r] * 0.08838834764831845f * fast_exp2((float)df * lg2) : 0.f; }
#pragma unroll
            for (int sp = 0; sp < 2; ++sp) { const int o = sp * 8;
                typedef unsigned u4_t __attribute__((ext_vector_type(4))); u4_t ww = {pg8::cvt_pk_bf16(s[o + 0], s[o + 1]), pg8::cvt_pk_bf16(s[o + 2], s[o + 3]), pg8::cvt_pk_bf16(s[o + 4], s[o + 5]), pg8::cvt_pk_bf16(s[o + 6], s[o + 7])};
                const bf16x8_t pf = *reinterpret_cast<bf16x8_t*>(&ww);
#pragma unroll
                for (int dt = 0; dt < 2; ++dt) { const bf16x8_t a = *(const LDSF bf16x8_t*)(VL + (64 * eh + 32 * dt + li) * RP + 32 * ms + 16 * sp + 8 * hi); O[dt] = __builtin_amdgcn_mfma_f32_32x32x16_bf16(a, pf, O[dt], 0, 0, 0); } }
        }
        float ss = 0.f;
#pragma unroll
        for (int r = 0; r < 16; ++r) ss += O[0][r] * O[0][r] + O[1][r] * O[1][r];
        ss += __shfl_xor(ss, 32);
        if (hi == 0) ssq[wid * 32 + li] = ss;
        __syncthreads();
        const float rn = rsqrtf((ss + ssq[(wid ^ 4) * 32 + li]) * (1.f / 128.f) + EPS);
        const int e0 = 64 * eh + 4 * hi; const float* rg = p.ret_g + (size_t)l * 512 + h * 128 + e0; bf16_t* orow = YM + ((size_t)b * SEQ + c * 128 + n) * DM + 1536 + h * 128 + e0;
#pragma unroll
        for (int dt = 0; dt < 2; ++dt)
#pragma unroll
            for (int rq = 0; rq < 4; ++rq) { const int eo = 32 * dt + 8 * rq; const float4 gg = *(const float4*)(rg + eo); const uint2 gw = *(const uint2*)(qrow + Y_GR + h * 128 + e0 + eo);
                const float g0 = __uint_as_float(gw.x << 16), g1 = __uint_as_float(gw.x & 0xffff0000u), g2 = __uint_as_float(gw.y << 16), g3 = __uint_as_float(gw.y & 0xffff0000u);
                uint2 w; w.x = pg8::cvt_pk_bf16(silu_f(g0) * O[dt][4 * rq] * rn * gg.x, silu_f(g1) * O[dt][4 * rq + 1] * rn * gg.y);
                w.y = pg8::cvt_pk_bf16(silu_f(g2) * O[dt][4 * rq + 2] * rn * gg.z, silu_f(g3) * O[dt][4 * rq + 3] * rn * gg.w);
                *(uint2*)(orow + eo) = w; }
        __syncthreads();
    }
}

DI void st_cmpattn_mm(const Params& p, int l, unsigned char* smem, const int WV) {
    const int TIDX = opq_tid(WV), BIDX = opq_bid();
    const int wid = __builtin_amdgcn_readfirstlane(TIDX >> 6), lane = TIDX & 63, qi = lane & 31, hi = lane >> 5, rr = wid >> 1, half = wid & 1;
    constexpr float C2 = 0.08838834764831845f * 1.4426950408889634f;
    const float NEGINF = -__builtin_inff();
    const bf16_t* Y = (const bf16_t*)(p.ws + WS_Y); const bf16_t* KC = (const bf16_t*)(p.ws + WS_KC); const bf16_t* VCT = (const bf16_t*)(p.ws + WS_VC);
    float* OC = (float*)(p.ws + WS_OCMP); unsigned long long* SEL = (unsigned long long*)(p.ws + WS_SEL);
    const LASP unsigned char* lds = (const LASP unsigned char*)smem; LASP unsigned char* ldsw = (LASP unsigned char*)smem;
    int* impL = (int*)(smem + 131072);
    typedef unsigned u4v_t __attribute__((ext_vector_type(4)));
    const int skey = TIDX >> 3, scp = TIDX & 7; const unsigned kwa = (unsigned)(skey * 256 + (((2 * scp) ^ (skey & 15)) << 4));
    const int sd = TIDX >> 2, vcp = TIDX & 3; const unsigned vwa = (unsigned)(65536 + sd * 128 + (((2 * vcp) ^ ((sd >> 1) & 7)) << 4));
    const int x = qi & 15, xh = x >> 1; const unsigned kra = (unsigned)(qi * 256 + (((hi ^ x) & 1) << 4));
    const int yv = (qi >> 1) & 7, yh = yv >> 1; const unsigned vra = (unsigned)(65536 + qi * 128 + (((hi ^ yv) & 1) << 4));
    for (int item = BIDX; item < 256; item += gridDim.x) {
        const int bg = item & 7, pr = item >> 3, b = bg >> 1, g = bg & 1, h = g * 4 + rr;
#pragma unroll 1
        for (int pass = 0; pass < 2; ++pass) {
            const int qb = pass ? pr : 63 - pr, t = qb * 64 + 32 * half + qi;
            const int ntile = (4 * qb + 3 + 63) >> 6;
            const bf16_t* yrow = Y + ((size_t)b * SEQ + t) * LDY;
            bf16x8_t qf[8];
#pragma unroll
            for (int ks = 0; ks < 8; ++ks) qf[ks] = *(const bf16x8_t*)(yrow + Y_QN + h * 128 + 16 * ks + 8 * hi);
#pragma unroll 1
            for (int tl = 0; tl < ntile; tl += 2) {
                const int t2 = tl + 1 < ntile ? tl + 1 : tl;
                const u4v_t* ks = (const u4v_t*)(KC + ((size_t)bg * 256 + tl * 64 + skey) * 128 + scp * 16); const u4v_t* vs = (const u4v_t*)(VCT + ((size_t)bg * 128 + sd) * 256 + tl * 64 + vcp * 16);
                const u4v_t* ks2 = (const u4v_t*)(KC + ((size_t)bg * 256 + t2 * 64 + skey) * 128 + scp * 16); const u4v_t* vs2 = (const u4v_t*)(VCT + ((size_t)bg * 128 + sd) * 256 + t2 * 64 + vcp * 16);
                const u4v_t k0 = ks[0], k1 = ks[1], v0 = vs[0], v1 = vs[1], k2 = ks2[0], k3 = ks2[1], v2 = vs2[0], v3 = vs2[1];
                *(LASP u4v_t*)(ldsw + tl * 16384 + kwa) = k0; *(LASP u4v_t*)(ldsw + tl * 16384 + (kwa ^ 16u)) = k1; *(LASP u4v_t*)(ldsw + tl * 16384 + vwa) = v0; *(LASP u4v_t*)(ldsw + tl * 16384 + (vwa ^ 16u)) = v1;
                *(LASP u4v_t*)(ldsw + t2 * 16384 + kwa) = k2; *(LASP u4v_t*)(ldsw + t2 * 16384 + (kwa ^ 16u)) = k3; *(LASP u4v_t*)(ldsw + t2 * 16384 + vwa) = v2; *(LASP u4v_t*)(ldsw + t2 * 16384 + (vwa ^ 16u)) = v3; }
            for (int i = TIDX; i < 64 * 64; i += 512) impL[i] = 0;
            __syncthreads();
            const int cmax = t >= 31 ? (t - 31) >> 4 : -1;
            float m_run = -1.0e30f, l_run = 0.f;
            for (int tl = 0; tl < ntile; ++tl) {
                f32x16_t s0, s1;
                qk_tile_pipe(s0, s1, (unsigned)(uintptr_t)lds + (unsigned)(tl * 16384) + kra, xh, qf);
                float mx = NEGINF;
#pragma unroll
                for (int r = 0; r < 16; ++r) { const int c = tl * 64 + (r & 3) + 8 * (r >> 2) + 4 * hi; s0[r] = c <= cmax ? s0[r] * C2 : NEGINF; s1[r] = c + 32 <= cmax ? s1[r] * C2 : NEGINF; mx = fmaxf(mx, fmaxf(s0[r], s1[r])); }
                mx = fmaxf(mx, __shfl_xor(mx, 32));
                const float m_new = fmaxf(m_run, mx); float ps = 0.f;
#pragma unroll
                for (int r = 0; r < 16; ++r) ps += fast_exp2(s0[r] - m_new) + fast_exp2(s1[r] - m_new);
                l_run = l_run * fast_exp2(m_run - m_new) + ps; m_run = m_new;
            }
            l_run += __shfl_xor(l_run, 32);
            const float inv = l_run > 0.f ? 1.f / l_run : 0.f;
            f32x16_t O[4];
#pragma unroll
            for (int dt = 0; dt < 4; ++dt)
#pragma unroll
                for (int r = 0; r < 16; ++r) O[dt][r] = 0.f;
            LASP int* imrow = (LASP int*)(LASP unsigned char*)(smem + 131072) + (32 * half + qi) * 64;
            for (int tl = 0; tl < ntile; ++tl) {
                f32x16_t s0, s1;
                qk_tile_pipe(s0, s1, (unsigned)(uintptr_t)lds + (unsigned)(tl * 16384) + kra, xh, qf);
#pragma unroll
                for (int r = 0; r < 16; ++r) { const int c = tl * 64 + (r & 3) + 8 * (r >> 2) + 4 * hi;
                    s0[r] = c <= cmax ? fast_exp2(s0[r] * C2 - m_run) * inv : 0.f; s1[r] = c + 32 <= cmax ? fast_exp2(s1[r] * C2 - m_run) * inv : 0.f; }
#pragma unroll
                for (int sub = 0; sub < 2; ++sub)
#pragma unroll
                    for (int rq = 0; rq < 4; ++rq) { const f32x16_t& sv = sub ? s1 : s0; const int j = 16 * tl + 8 * sub + 2 * rq + hi;
                        const float hp = 0.5f * sv[4 * rq + 3]; const int ia = (int)((sv[4 * rq] + sv[4 * rq + 1] + sv[4 * rq + 2] + hp) * 67108864.f + 0.5f), ib = (int)(hp * 67108864.f + 0.5f);
                        (void)__hip_atomic_fetch_add(imrow + j, ia, __ATOMIC_RELAXED, __HIP_MEMORY_SCOPE_WORKGROUP); if (j < 63) (void)__hip_atomic_fetch_add(imrow + j + 1, ib, __ATOMIC_RELAXED, __HIP_MEMORY_SCOPE_WORKGROUP); }
                bf16x8_t pf[4];
#pragma unroll
                for (int s = 0; s < 4; ++s) { const f32x16_t& sv = (s < 2) ? s0 : s1; const int o = (s & 1) * 8;
                    u4v_t ww = {pg8::cvt_pk_bf16(sv[o + 0], sv[o + 1]), pg8::cvt_pk_bf16(sv[o + 2], sv[o + 3]), pg8::cvt_pk_bf16(sv[o + 4], sv[o + 5]), pg8::cvt_pk_bf16(sv[o + 6], sv[o + 7])}; pf[s] = *reinterpret_cast<bf16x8_t*>(&ww); }
                pv_tile_pipe(O, (unsigned)(uintptr_t)lds + (unsigned)(tl * 16384) + vra, yh, pf);
            }
            { float* ocrow = OC + ((size_t)b * SEQ + t) * 1024 + h * 128 + 4 * hi;
#pragma unroll
              for (int dt = 0; dt < 4; ++dt)
#pragma unroll
                  for (int rq = 0; rq < 4; ++rq) *(float4*)(ocrow + 32 * dt + 8 * rq) = make_float4(O[dt][4 * rq], O[dt][4 * rq + 1], O[dt][4 * rq + 2], O[dt][4 * rq + 3]); }
            __syncthreads();
            for (int qq = 0; qq < 8; ++qq) { const int q = wid * 8 + qq, tq = qb * 64 + q, jq = qb, j = lane; const int* row = impL + q * 64;
                const int im = row[j]; const bool forced = (j == 0) || (j == jq) || (j == jq - 1); const int v = forced ? 0x7fffffff : (j <= jq ? im : -1);
                int rank = 0;
#pragma unroll 16
                for (int jj = 0; jj < 64; ++jj) { const int o = __builtin_amdgcn_readlane(v, jj); rank += (o > v || (o == v && jj < j)) ? 1 : 0; }
                const unsigned long long msk = __ballot(rank < 16);
                if (lane == 0) SEL[(size_t)bg * SEQ + tq] = msk; }
            __syncthreads();
        }
    }
}

namespace pg8 {
struct EpiF32Plain {
    static constexpr bool BP16 = false; static constexpr bool PERM = false, AFTER_DRAIN = false;
    float* C;
    __device__ __forceinline__ void operator()(const f32x4 (&acc)[2][2][4][2], const Unit& u, int wr, int wc, int fr, int fq) const {
        float* base = C + (size_t)(u.i0 + wr * 64 + fr) * 256 + wc * 32 + 4 * fq;
#pragma unroll
        for (int ai = 0; ai < 2; ++ai)
#pragma unroll
            for (int m = 0; m < 4; ++m) { float* rowp = base + (size_t)(ai * HALF + m * 16) * 256;
#pragma unroll
                for (int bj = 0; bj < 2; ++bj)
#pragma unroll
                    for (int n = 0; n < 2; ++n) *(f32x4*)(rowp + bj * HALF + n * 16) = acc[ai][bj][m][n]; }
    }
};
struct Cmp1Order {
    int G, c; const char* Y; const char* W;
    __device__ __forceinline__ bool next(int i, Unit& u) const {
        const int L = i * G + c; if (L >= 64) return false;
        const int kv = L >> 5, bg = (L >> 2) & 7, ks = L & 3, b = bg >> 1, g = bg & 1;
        u.A = Y + ((size_t)b * SEQ * LDY + (size_t)ks * 8 * LDY + Y_KV + kv * 256 + g * 128) * 2;
        u.B = W + ((size_t)kv * 256 * 4096 + (size_t)ks * 1024) * 2; u.i0 = (ks * 16 + kv * 8 + bg) * 256; u.i1 = 0; return true;
    }
    __device__ __forceinline__ void a_ready(const Unit&) const {}
    __device__ __forceinline__ void done(const Unit&) const {}
};
}
DI void st_cmp1_mm(const Params& p, int l, unsigned char* smem, const int WV) {
    const int TIDX = opq_tid(WV), BIDX = opq_bid();
    pg8::Cmp1Order S; S.G = gridDim.x; S.c = BIDX; S.Y = (const char*)(p.ws + WS_Y); S.W = (const char*)wl_ptr(p, l, WL_CW1);
    pg8::EpiF32Plain E{(float*)(p.ws + WS_CP)};
    pg8::gemm_phase((PG8_LAS unsigned char*)smem, 1024, S, E, TIDX, (size_t)16 * LDY * 2, (size_t)LDY * 2, (size_t)4096 * 2);
}
DI void st_slots(const Params& p, int l, unsigned char* smem, const int WV) {
    const int TIDX = opq_tid(WV), BIDX = opq_bid();
    const int* TOPE = (const int*)(p.ws + WS_TOPE); const int* RANK = (const int*)(p.ws + WS_RANK); int* SLOT = (int*)(p.ws + WS_SLOT); int* TOKOF = (int*)(p.ws + WS_TOKOF);
    const unsigned* CNT = (const unsigned*)(p.ws + WS_CTL) + CW_CNT + l * 64;
    int* po = (int*)smem; pad_offsets(CNT, po, WV);
    for (int i = BIDX * 512 + TIDX; i < NT * 8; i += gridDim.x * 512) { const int slot = po[TOPE[i]] + RANK[i]; SLOT[i] = slot; TOKOF[slot] = i >> 3; }
    for (int e = BIDX; e < 64; e += gridDim.x) { const int a = po[e] + (int)CNT[e], b = po[e + 1]; for (int s = a + TIDX; s < b; s += 512) TOKOF[s] = 0; }
}

namespace pg8 {
struct RouterOrder {
    int G, c; const char* H; const char* HLO; const char* W;
    __device__ __forceinline__ bool next(int i, Unit& u) const {
        const int L = i * G + c; if (L >= 256) return false;
        const int kq = L & 3, pm = L >> 2;
        u.A = H + ((size_t)pm * 256 * DM + (size_t)kq * 512) * 2; u.B = W + (size_t)kq * 512 * 2; u.i0 = kq * NT + pm * 256; u.i1 = 0; return true;
    }
    __device__ __forceinline__ void a_ready(const Unit&) const {}
    __device__ __forceinline__ void done(const Unit&) const {}
};
}
DI void st_rlogit_mm(const Params& p, int l, unsigned char* smem, const int WV) {
    const int TIDX = opq_tid(WV), BIDX = opq_bid();
    pg8::RouterOrder S; S.G = gridDim.x; S.c = BIDX; S.H = (const char*)(p.ws + WS_H); S.HLO = (const char*)(p.ws + WS_HLO); S.W = (const char*)wl_ptr(p, l, WL_RTH);
    pg8::EpiF32Plain E{(float*)(p.ws + WS_LOGP)};
    pg8::gemm_phase((PG8_LAS unsigned char*)smem, 512, S, E, TIDX, (size_t)DM * 2, 256, (size_t)DM * 2);
}
DI void st_route(const Params& p, int l, unsigned char* smem, const int WV, const int cnt_l_off = 0) {
    const int TIDX = opq_tid(WV), BIDX = opq_bid();
    const int wave = __builtin_amdgcn_readfirstlane(TIDX >> 6), lane = TIDX & 63;
    const float* LP = (const float*)(p.ws + WS_LOGP);
    int* TOPE = (int*)(p.ws + WS_TOPE); float* TOPW = (float*)(p.ws + WS_TOPW); int* RANK = (int*)(p.ws + WS_RANK); unsigned* CNT = (unsigned*)(p.ws + WS_CTL) + CW_CNT + (l + cnt_l_off) * 64;
    unsigned* lcnt = (unsigned*)smem; unsigned* lbase = lcnt + 64;
    if (TIDX < 64) lcnt[TIDX] = 0u;
    __syncthreads();
    const float rbias = p.router_bias[l * 64 + lane];
    float lpc[8];
    { const int t0 = BIDX * 8 + wave;
#pragma unroll
      for (int q = 0; q < 4; ++q) { lpc[2 * q] = t0 < NT ? LP[(size_t)(q * NT + t0) * 256 + lane] : 0.f; lpc[2 * q + 1] = t0 < NT ? LP[(size_t)(q * NT + t0) * 256 + 64 + lane] : 0.f; } }
    for (int t = BIDX * 8 + wave; t < NT; t += gridDim.x * 8) {
        float lpn[8]; { const int tn = t + gridDim.x * 8; const int tc = tn < NT ? tn : t;
#pragma unroll
          for (int q = 0; q < 4; ++q) { lpn[2 * q] = LP[(size_t)(q * NT + tc) * 256 + lane]; lpn[2 * q + 1] = LP[(size_t)(q * NT + tc) * 256 + 64 + lane]; } }
        float logit = 0.f;
#pragma unroll
        for (int q = 0; q < 4; ++q) logit += lpc[2 * q] + lpc[2 * q + 1];
#pragma unroll
        for (int q = 0; q < 8; ++q) lpc[q] = lpn[q];
        const float score = sigmoid_f(logit); const float biased = score + rbias;
        int rk = 0; const int gb = lane & ~7;
#pragma unroll
        for (int j = 0; j < 8; ++j) { const float o = __shfl(biased, gb + j); rk += (o > biased || (o == biased && (gb + j) < lane)) ? 1 : 0; }
        float gsum = rk < 2 ? biased : 0.f; gsum += __shfl_xor(gsum, 1); gsum += __shfl_xor(gsum, 2); gsum += __shfl_xor(gsum, 4);
        int grk = 0; const int myg = lane >> 3;
#pragma unroll
        for (int gg = 0; gg < 8; ++gg) { const float o = __shfl(gsum, gg * 8); grk += (o > gsum || (o == gsum && gg < myg)) ? 1 : 0; }
        const float masked = grk < 4 ? biased : -__builtin_inff();
        int erk = 0;
#pragma unroll 16
        for (int j = 0; j < 64; ++j) { const float o = __uint_as_float(__builtin_amdgcn_readlane(__float_as_uint(masked), j)); erk += (o > masked || (o == masked && j < lane)) ? 1 : 0; }
        const bool selx = erk < 8; const float wsum = wave_sum(selx ? score : 0.f);
        if (selx) { const unsigned rr = atomicAdd(lcnt + lane, 1u);
            TOPE[(size_t)t * 8 + erk] = lane; TOPW[(size_t)t * 8 + erk] = 2.5f * score / wsum; RANK[(size_t)t * 8 + erk] = (int)rr; }
    }
    __syncthreads();
    if (TIDX < 64) lbase[TIDX] = lcnt[TIDX] ? atomicAdd(CNT + TIDX, lcnt[TIDX]) : 0u;
    asm volatile("s_waitcnt vmcnt(0)" ::: "memory");
    __syncthreads();
    for (int t = BIDX * 8 + wave; t < NT; t += gridDim.x * 8)
        if (lane < 8) { const int e = TOPE[(size_t)t * 8 + lane]; const int rk = RANK[(size_t)t * 8 + lane] + (int)lbase[e]; RANK[(size_t)t * 8 + lane] = rk;
            ((int*)(p.ws + WS_XS))[(size_t)e * NT + rk] = t; }
}

namespace pg8 {
struct GateOrder {
    int G, c; const char* H; const char* W;
    __device__ __forceinline__ bool next(int i, Unit& u) const {
        const int cc = G >= 192 ? (c >= 64 ? c - 64 : c + G - 64) : c;
        const int L = i * G + cc; if (L >= 128) return false;
        const int kh = L & 1, pm = L >> 1;
        u.A = H + ((size_t)pm * 256 * DM + (size_t)kh * 1024) * 2; u.B = W + ((size_t)6144 * DM + (size_t)kh * 1024) * 2; u.i0 = kh * NT + pm * 256; u.i1 = 0; return true;
    }
    __device__ __forceinline__ void a_ready(const Unit&) const {}
    __device__ __forceinline__ void done(const Unit&) const {}
};
}
DI void st_gate_mm(const Params& p, int l, unsigned char* smem, const int WV) {
    const int TIDX = opq_tid(WV), BIDX = opq_bid();
    pg8::GateOrder S; S.G = gridDim.x; S.c = BIDX; S.H = (const char*)(p.ws + WS_H); S.W = (const char*)wl_ptr(p, l, WL_WIN);
    pg8::EpiF32Plain E{(float*)(p.ws + WS_GATEP)};
    pg8::gemm_phase((PG8_LAS unsigned char*)smem, 1024, S, E, TIDX, (size_t)DM * 2, 256, (size_t)DM * 2);
}


#define XB_TMO      128
#define XB_XCNT(j)  (256  + 64 * (j))
#define XB_XSUB(j)  (1280 + 64 * (j))
#define XB_XGEN(j)  (2304 + 64 * (j))
#define XB_TOP      3328
#define XB_TOPGEN   3392
#define XCD_BAR_WORDS 3456
#define XB_SPIN_CAP (1u << 18)
#define LAS __attribute__((address_space(3)))

__device__ __forceinline__ unsigned xb_ld(unsigned* p)              { return __hip_atomic_load(p, __ATOMIC_RELAXED, __HIP_MEMORY_SCOPE_AGENT); }
__device__ __forceinline__ unsigned xb_add(unsigned* p, unsigned v) { return __hip_atomic_fetch_add(p, v, __ATOMIC_RELAXED, __HIP_MEMORY_SCOPE_AGENT); }
__device__ __forceinline__ unsigned xb_xcc_id() { return (unsigned)__builtin_amdgcn_s_getreg((3 << 11) | 20) & 0xFu; }
#define XB_SPIN(cond, bar) do { unsigned _sp = 0; while (cond) { __builtin_amdgcn_s_sleep(1); \
    if ((++_sp & 255u) == 0u) { if (xb_ld(&(bar)[XB_TMO])) break; if (_sp > XB_SPIN_CAP) { atomicAdd(&(bar)[XB_TMO], 1u); break; } } } } while (0)

struct XcdBarrier {
    bool t0;
    unsigned* bar; unsigned x;
    volatile LAS unsigned* st;
};

__device__ __forceinline__ XcdBarrier xcd_barrier_post(unsigned* bar, volatile LAS unsigned* st) {
    XcdBarrier b; b.bar = bar; b.x = xb_xcc_id(); b.st = st;
    if (threadIdx.x == 0) (void)xb_add(&bar[XB_XCNT(b.x)], 1u);
    return b;
}
__device__ __forceinline__ void xcd_barrier_complete(unsigned* bar, unsigned x, unsigned& nloc, unsigned& nx) {
    const unsigned G = gridDim.x * gridDim.y * gridDim.z;
    unsigned sum, cnt, mine, sp = 0u;
    for (;;) {
        sum = 0u; cnt = 0u; mine = 0u;
#pragma unroll
        for (unsigned j = 0; j < 16; ++j) { const unsigned c = xb_ld(&bar[XB_XCNT(j)]); sum += c; cnt += (c > 0u) ? 1u : 0u; mine = (j == x) ? c : mine; }
        if (sum == G) break;
        __builtin_amdgcn_s_sleep(1);
        if ((++sp & 255u) == 0u) { if (xb_ld(&bar[XB_TMO])) break; if (sp > XB_SPIN_CAP) { atomicAdd(&bar[XB_TMO], 1u); break; } }
    }
    nloc = mine > 0u ? mine : 1u; nx = cnt > 0u ? cnt : 1u;
}

__device__ __forceinline__ void xcd_barrier(const XcdBarrier& b) {
    asm volatile("s_waitcnt vmcnt(0)" ::: "memory");
    __syncthreads();
    if (b.t0) {
        unsigned* bar = b.bar;
        __builtin_amdgcn_s_waitcnt(0);
        unsigned nloc = b.st[0], nx = b.st[1];
        if (nloc == 0u) { xcd_barrier_complete(bar, b.x, nloc, nx); b.st[0] = nloc; b.st[1] = nx; }
        const unsigned old = xb_add(&bar[XB_XSUB(b.x)], 1u);
        const unsigned gen = old / nloc;
        if (old + 1u == (gen + 1u) * nloc) {
            __builtin_amdgcn_fence(__ATOMIC_RELEASE, "agent");
            asm volatile("s_waitcnt vmcnt(0)" ::: "memory");
            const unsigned og = xb_add(&bar[XB_TOP], 1u);
            const unsigned tg = og / nx;
            if (og + 1u == (tg + 1u) * nx) xb_add(&bar[XB_TOPGEN], 1u);
            else XB_SPIN(xb_ld(&bar[XB_TOPGEN]) == tg, bar);
            __builtin_amdgcn_fence(__ATOMIC_ACQUIRE, "agent");
            xb_add(&bar[XB_XGEN(b.x)], 1u);
            asm volatile("s_waitcnt vmcnt(0)" ::: "memory");
        } else {
            XB_SPIN(xb_ld(&bar[XB_XGEN(b.x)]) == gen, bar);
            __builtin_amdgcn_fence(__ATOMIC_ACQUIRE, "agent");
            asm volatile("s_waitcnt vmcnt(0)" ::: "memory");
        }
    }
    __syncthreads();
}


DI void launder(Params& q, int& l) {
    long z = 0; asm volatile("" : "+s"(z));
#define L_(f) q.f = (decltype(q.f))((const char*)q.f + z)
    L_(x); L_(c); L_(pos); L_(ada_w); L_(ada_b); L_(norm1_g); L_(norm2_g); L_(w_in); L_(conv_w); L_(conv_g); L_(cmp_pe); L_(cmp_w1); L_(cmp_w2); L_(nsa_g); L_(ret_g); L_(w_out);
    L_(router_w); L_(router_bias); L_(exp_w_gu); L_(exp_w_down); L_(shared_w_gu); L_(shared_w_down); L_(final_g);
#undef L_
    q.out = (float*)((char*)q.out + z); q.ws = q.ws + z;
    asm volatile("" : "+s"(l));
}
constexpr int CW_BAR = 16384;
constexpr int SMEM_MEGA = 152 * 1024;
__global__ void __launch_bounds__(512, 2) k_mega(Params p) {
    extern __shared__ __attribute__((aligned(16))) unsigned char smem[];
    volatile LAS unsigned* bst = (volatile LAS unsigned*)(smem + LDS_BST);
    const int WV = __builtin_amdgcn_readfirstlane(threadIdx.x >> 6);
    if (threadIdx.x < 4) bst[threadIdx.x] = 0u;
    __syncthreads();
    (void)xcd_barrier_post((unsigned*)(p.ws + WS_CTL) + CW_BAR, bst);
#define GRID_BAR() do { Params q = p; int l_ = 0; launder(q, l_); XcdBarrier b_; b_.t0 = (opq_tid(WV) == 0); b_.bar = (unsigned*)(q.ws + WS_CTL) + CW_BAR; b_.x = xb_xcc_id(); b_.st = bst; xcd_barrier(b_); if (MK_PROBE == 18) xcd_barrier(b_); } while (0)
#define STG(call) do { Params q = p; launder(q, l); call; } while (0)
#define REP(n, call) do { if (MK_PROBE == (n)) { STG(call); __syncthreads(); } } while (0)
    { int l = 0; REP(1, st_convert(q, smem, WV)); STG(st_convert(q, smem, WV)); __syncthreads(); REP(17, st_mod(q, smem, WV)); STG(st_mod(q, smem, WV)); GRID_BAR(); REP(17, st_norm(q, 0, q.x, 0, smem, WV)); STG(st_norm(q, 0, q.x, 0, smem, WV)); GRID_BAR(); }
#pragma clang loop unroll(disable)
    for (int l0 = 0; l0 < NL; ++l0) {
        int l = l0;
        REP(8, st_inproj_mm(q, l, smem, WV)); STG(st_inproj_mm(q, l, smem, WV)); GRID_BAR();
        REP(20, st_post(q, l, smem, WV)); REP(20, st_post(q, l, smem, WV, -1.f)); STG(st_post(q, l, smem, WV)); __syncthreads(); REP(15, st_vt(q, l, smem, WV)); STG(st_vt(q, l, smem, WV)); GRID_BAR();
        REP(2, st_cmp1_mm(q, l, smem, WV)); STG(st_cmp1_mm(q, l, smem, WV)); STG(st_gate_mm(q, l, smem, WV)); __syncthreads(); REP(16, st_kvchunk_mm(q, l, smem, WV)); STG(st_kvchunk_mm(q, l, smem, WV)); GRID_BAR();
        REP(16, st_cmp2(q, l, smem, WV)); REP(16, st_scan(q, l, WV)); STG(st_cmp2(q, l, smem, WV)); STG(st_scan(q, l, WV)); GRID_BAR();
        REP(12, st_cmpattn_mm(q, l, smem, WV)); REP(24, st_retout_mm(q, l, smem, WV)); STG(st_cmpattn_mm(q, l, smem, WV)); __syncthreads(); STG(st_retout_mm(q, l, smem, WV)); GRID_BAR();
        REP(14, st_attn_mm(q, l, smem, WV)); STG(st_attn_mm(q, l, smem, WV)); GRID_BAR();
        REP(13, st_outproj_mm(q, l, q.x, l == 0 ? (const bf16_t*)nullptr : (const bf16_t*)(q.ws + WS_X2), smem, WV)); STG(st_outproj_mm(q, l, q.x, l == 0 ? (const bf16_t*)nullptr : (const bf16_t*)(q.ws + WS_X2), smem, WV)); GRID_BAR();
        REP(17, st_norm(q, l, (const float*)(q.ws + WS_X1), 1, smem, WV)); STG(st_norm(q, l, (const float*)(q.ws + WS_X1), 1, smem, WV)); GRID_BAR();
        REP(23, st_rlogit_mm(q, l, smem, WV)); STG(st_rlogit_mm(q, l, smem, WV)); GRID_BAR();
        REP(25, st_route(q, l, smem, WV, 2)); STG(st_route(q, l, smem, WV)); GRID_BAR();
        REP(9, st_gemm1_mm(q, l, smem, WV)); STG(st_gemm1_mm(q, l, smem, WV)); GRID_BAR();
        REP(10, st_gemm2_mm(q, l, smem, WV)); STG(st_gemm2_mm(q, l, smem, WV)); GRID_BAR();
        REP(7, st_combine(q, l, smem, WV)); REP(11, st_combine(q, l, smem, WV)); STG(st_combine(q, l, smem, WV)); if (l0 + 1 < NL) GRID_BAR();
    }
#undef STG
#undef GRID_BAR
}
extern "C" void kernel_launch(void* const* d_in, const int* in_sizes, int n_in, void* d_out, int out_size, void* d_ws, size_t ws_size, hipStream_t stream) {
    if (n_in != 23 || ws_size < WS_END) { fprintf(stderr, "kernel_launch: unexpected n_in %d or ws_size %zu < %zu\n", n_in, ws_size, (size_t)WS_END); return; }
    Params p; memset(&p, 0, sizeof(p));
    p.x = (const float*)d_in[0]; p.c = (const float*)d_in[1]; p.pos = (const int*)d_in[2];
    p.ada_w = (const float*)d_in[3]; p.ada_b = (const float*)d_in[4]; p.norm1_g = (const float*)d_in[5]; p.norm2_g = (const float*)d_in[6]; p.w_in = (const float*)d_in[7];
    p.conv_w = (const float*)d_in[8]; p.conv_g = (const float*)d_in[9]; p.cmp_pe = (const float*)d_in[10]; p.cmp_w1 = (const float*)d_in[11]; p.cmp_w2 = (const float*)d_in[12];
    p.nsa_g = (const float*)d_in[13]; p.ret_g = (const float*)d_in[14]; p.w_out = (const float*)d_in[15]; p.router_w = (const float*)d_in[16]; p.router_bias = (const float*)d_in[17];
    p.exp_w_gu = (const float*)d_in[18]; p.exp_w_down = (const float*)d_in[19]; p.shared_w_gu = (const float*)d_in[20]; p.shared_w_down = (const float*)d_in[21]; p.final_g = (const float*)d_in[22];
    p.out = (float*)d_out; p.ws = (unsigned char*)d_ws;
    (void)hipMemsetAsync((char*)d_ws + WS_CTL, 0, 1 * MiB, stream);
    static int grid = 0;
    if (!grid) {
        int dev = 0, cus = 0, per_cu = 0;
        (void)hipGetDevice(&dev); (void)hipDeviceGetAttribute(&cus, hipDeviceAttributeMultiprocessorCount, dev);
        (void)hipFuncSetAttribute((const void*)k_mega, hipFuncAttributeMaxDynamicSharedMemorySize, SMEM_MEGA);
        if (hipOccupancyMaxActiveBlocksPerMultiprocessor(&per_cu, (const void*)k_mega, 512, SMEM_MEGA) != hipSuccess || per_cu < 1) { fprintf(stderr, "kernel_launch: occupancy query says %d\n", per_cu); (void)hipGetLastError(); }
        grid = cus > 0 ? cus : 256;
    }
    hipLaunchKernelGGL(k_mega, dim3(grid), dim3(512), SMEM_MEGA, stream, p);
}
```

```cpp
#include <hip/hip_runtime.h>
#include <stdint.h>
#include <stdio.h>
#include <string.h>
#ifndef MK_PROBE
#define MK_PROBE 0
#endif

typedef unsigned short bf16_t;
#define DI __device__ __forceinline__
#define LDS_WAIT() asm volatile("s_waitcnt lgkmcnt(0)" ::: "memory")

constexpr int NB = 4, SEQ = 4096, DM = 2048, NT = NB * SEQ, NL = 2;
constexpr int HD = 128;
constexpr int D_IN = 6168, LDY = 6400;
constexpr int Y_CB = 0, Y_CC = 512, Y_CU = 1024, Y_QN = 1536, Y_KV = 2560, Y_QR = 4096, Y_KR = 4608, Y_VR = 5120, Y_GR = 5632, Y_GATE = 6144;
constexpr int NEXP = 64, TOPK = 8, DEXP = 512;
constexpr int NSLOT = 576 * 256;
constexpr int NROWS_E = NSLOT + NT;
constexpr float EPS = 1e-6f;
constexpr int NCMP = 255;

constexpr size_t MiB = 1ull << 20;
constexpr size_t WS_CTL = 0;
constexpr size_t WS_MOD = 1 * MiB;
constexpr size_t WS_CMPB = WS_MOD + 512 * 1024;
constexpr size_t WS_W = 2 * MiB;
constexpr size_t WL_WIN = 0;
constexpr size_t WL_WOUT = WL_WIN + (size_t)LDY * DM * 2;
constexpr size_t WL_CW1 = WL_WOUT + (size_t)DM * DM * 2;
constexpr size_t WL_CW2 = WL_CW1 + (size_t)2 * 256 * 4096 * 2;
constexpr size_t WL_RTH = WL_CW2 + (size_t)2 * 128 * 256 * 2;
constexpr size_t WL_RTL = WL_RTH + (size_t)64 * DM * 2;
constexpr size_t WL_RTZ = WL_RTL + (size_t)64 * DM * 2;
constexpr size_t WL_EGU = WL_RTZ + (size_t)128 * DM * 2;
constexpr size_t WL_EDN = WL_EGU + (size_t)65 * 1024 * DM * 2;
constexpr size_t WL_END = WL_EDN + (size_t)65 * DM * 512 * 2;
constexpr size_t WL_STRIDE = 429 * MiB;
static_assert(WL_END <= WL_STRIDE, "layer weights");
constexpr size_t WS_H = WS_W + NL * WL_STRIDE;
constexpr size_t WS_HLO = WS_H + (size_t)NT * DM * 2;
constexpr size_t WS_Y = WS_HLO + (size_t)NT * DM * 2;
constexpr size_t WS_YMIX = WS_Y + (size_t)NT * LDY * 2;
constexpr size_t WS_X1 = WS_YMIX + (size_t)NT * DM * 2;
constexpr size_t WS_X2 = WS_X1 + (size_t)NT * DM * 4;
constexpr size_t WS_OCMP = WS_X2 + (size_t)NT * DM * 4;
constexpr size_t WS_SEL = WS_OCMP + (size_t)NT * 1024 * 4;
constexpr size_t WS_HID = WS_SEL + (size_t)NB * 2 * SEQ * 8;
constexpr size_t WS_KC = WS_HID + (size_t)2 * 8 * 256 * 256 * 2;
constexpr size_t WS_VC = WS_KC + (size_t)8 * 256 * 128 * 2;
constexpr size_t WS_KVC = WS_VC + (size_t)8 * 256 * 128 * 2;
constexpr size_t WS_STATE = WS_KVC + (size_t)16 * 32 * 16384 * 4;
constexpr size_t WS_TOPE = WS_STATE + (size_t)16 * 32 * 16384 * 4;
constexpr size_t WS_TOPW = WS_TOPE + (size_t)NT * 8 * 4;
constexpr size_t WS_RANK = WS_TOPW + (size_t)NT * 8 * 4;
constexpr size_t WS_SLOT = WS_RANK + (size_t)NT * 8 * 4;
constexpr size_t WS_XS = WS_SLOT + (size_t)NT * 8 * 4;
constexpr size_t WS_GU = WS_XS + (size_t)NSLOT * DM * 2;
constexpr size_t WS_ACT = WS_GU + (size_t)NROWS_E * 1024 * 2;
constexpr size_t WS_YS = WS_ACT + (size_t)NROWS_E * 512 * 2;
constexpr size_t WS_VT = WS_YS + (size_t)NROWS_E * DM * 2;
constexpr size_t WS_STATEB = WS_VT + (size_t)NB * 2 * 2 * 128 * SEQ * 2;
constexpr size_t WS_PART = WS_STATEB + (size_t)16 * 32 * 16384 * 2;
constexpr size_t WS_TOKOF = WS_PART + (size_t)NT * 1024 * 4;
constexpr size_t WS_LOGP = WS_TOKOF + (size_t)NSLOT * 4;
constexpr size_t WS_CP = WS_LOGP + (size_t)4 * NT * 256 * 4;
constexpr size_t WS_GATEP = WS_CP + (size_t)4 * 16 * 256 * 256 * 4;
constexpr size_t WS_END = WS_GATEP + (size_t)2 * NT * 256 * 4;
constexpr int CW_CNT = 8192;

struct Params {
    const float *x, *c; const int* pos;
    const float *ada_w, *ada_b, *norm1_g, *norm2_g, *w_in, *conv_w, *conv_g, *cmp_pe, *cmp_w1, *cmp_w2, *nsa_g, *ret_g, *w_out,
                *router_w, *router_bias, *exp_w_gu, *exp_w_down, *shared_w_gu, *shared_w_down, *final_g;
    float* out; unsigned char* ws;
};

DI float bf2f(bf16_t b) { return __uint_as_float(((unsigned)b) << 16); }
DI bf16_t f2bf(float f) { unsigned u = __float_as_uint(f); u += 0x7fffu + ((u >> 16) & 1u); return (bf16_t)(u >> 16); }
DI unsigned pk2(float lo, float hi) { return (unsigned)f2bf(lo) | ((unsigned)f2bf(hi) << 16); }
DI float wave_sum(float v) {
#pragma unroll
    for (int o = 1; o < 64; o <<= 1) v += __shfl_xor(v, o);
    return v;
}
DI float wave_max(float v) {
#pragma unroll
    for (int o = 1; o < 64; o <<= 1) v = fmaxf(v, __shfl_xor(v, o));
    return v;
}
DI int kperm16(int k) { return (k & ~12) | ((k & 4) << 1) | ((k & 8) >> 1); }
DI float silu_f(float v) { return v / (1.f + __expf(-v)); }
DI float sigmoid_f(float v) { return 1.f / (1.f + __expf(-v)); }
DI float gelu_tanh_f(float v) { const float u = 0.7978845608028654f * (v + 0.044715f * v * v * v); return 0.5f * v * (1.f + tanhf(u)); }
DI bf16_t* wl_ptr(const Params& p, int l, size_t off) { return (bf16_t*)(p.ws + WS_W + (size_t)l * WL_STRIDE + off); }
DI float* mod_ptr(const Params& p, int l, int b, int chunk) { return (float*)(p.ws + WS_MOD) + ((size_t)(l * NB + b) * 6 + chunk) * DM; }
DI float ret_loggamma(int h) { return h == 0 ? -0.0317486983145803f : (h == 1 ? -0.015748356968139168f : (h == 2 ? -0.007843177461025893f : -0.003913899321136329f)); }
DI float ret_chunkdecay(int h) { return h == 0 ? 0.01718302357081791f : (h == 1 ? 0.13321516287964844f : (h == 2 ? 0.3664377159220373f : 0.6059370882290803f)); }

DI int opq_tid(const int WV) { unsigned z = 0u; asm volatile("" : "+v"(z)); int t = (WV << 6) | (int)__builtin_amdgcn_mbcnt_hi(~0u, __builtin_amdgcn_mbcnt_lo(~0u, z)); asm volatile("" : "+v"(t)); return t; }
DI int opq_bid() { int b = blockIdx.x; asm volatile("" : "+s"(b)); return b; }
DI int maprow(int kind, int n) {
    if (kind == 1) return n < 4096 ? n : (n < 4120 ? n + 2048 : n - 24);
    if (kind == 2) { if (n < 512) return (n >> 7) * 256 + (n & 127); const int j = n - 512; return (j >> 7) * 256 + 128 + (j & 127); }
    return n;
}
DI void tr_item(const float* __restrict__ W, int ldw, int ncols, int Kd, bf16_t* WT, int k0, int n0, int kind, float* scr, int lane) {
    const int n4 = (lane & 15) * 4, kr = lane >> 4; const bool inb = (n0 + n4) < ncols;
    float4 v[16];
#pragma unroll
    for (int i = 0; i < 16; ++i) { typedef float f4v_t __attribute__((ext_vector_type(4))); if (inb) { const f4v_t t_ = __builtin_nontemporal_load((const f4v_t*)(W + (size_t)(k0 + 4 * i + kr) * ldw + n0 + n4)); v[i] = make_float4(t_.x, t_.y, t_.z, t_.w); } else v[i] = make_float4(0.f, 0.f, 0.f, 0.f); }
#pragma unroll
    for (int i = 0; i < 16; ++i) { float* s = scr + (4 * i + kr) * 65 + n4; s[0] = v[i].x; s[1] = v[i].y; s[2] = v[i].z; s[3] = v[i].w; }
    LDS_WAIT();
    const int c = lane & 7;
#pragma unroll
    for (int j = 0; j < 8; ++j) { const int nn = (lane >> 3) + 8 * j, n = n0 + nn;
        if (n < ncols) { const float* s = scr + (8 * c) * 65 + nn;
            uint4 o; o.x = pk2(s[0 * 65], s[1 * 65]); o.y = pk2(s[2 * 65], s[3 * 65]); o.z = pk2(s[4 * 65], s[5 * 65]); o.w = pk2(s[6 * 65], s[7 * 65]);
            *(uint4*)(WT + (size_t)maprow(kind, n) * Kd + k0 + 8 * c) = o; } }
    LDS_WAIT();
}
DI void tr_job(const float* W, int ldw, int ncols, int Kd, bf16_t* WT, int kind, int r, float* scr, int lane) {
    const int nblk = (ncols + 63) / 64; const int kb = r / nblk, nb = r % nblk;
    tr_item(W, ldw, ncols, Kd, WT, kb * 64, nb * 64, kind, scr, lane);
}
DI void st_convert(const Params& p, unsigned char* smem, const int WV) {
    const int TIDX = opq_tid(WV); const int BIDX = opq_bid(); (void)TIDX; (void)BIDX;
    const int tid = TIDX, lane = tid & 63, wave = tid >> 6;
    float* scr = (float*)smem + wave * (64 * 65);
    const int gw = BIDX * 8 + wave, NGW = gridDim.x * 8;
    constexpr int I_WIN = 32 * 97, I_WOUT = 32 * 32, I_C1 = 64 * 4, I_C2 = 4 * 2, I_GU = 32 * 16, I_DN = 8 * 32;
    constexpr int PER_L = I_WIN + I_WOUT + 2 * I_C1 + 2 * I_C2 + 65 * I_GU + 65 * I_DN;
    for (int it = gw; it < NL * PER_L; it += NGW) {
        const int l = it / PER_L; int r = it % PER_L;
        if (r < I_WIN) { tr_job(p.w_in + (size_t)l * DM * D_IN, D_IN, D_IN, DM, wl_ptr(p, l, WL_WIN), 1, r, scr, lane); continue; } r -= I_WIN;
        if (r < I_WOUT) { tr_job(p.w_out + (size_t)l * DM * DM, DM, DM, DM, wl_ptr(p, l, WL_WOUT), 0, r, scr, lane); continue; } r -= I_WOUT;
        if (r < 2 * I_C1) { const int kv = r / I_C1; tr_job(p.cmp_w1 + (size_t)(l * 2 + kv) * 4096 * 256, 256, 256, 4096, wl_ptr(p, l, WL_CW1) + (size_t)kv * 256 * 4096, 0, r % I_C1, scr, lane); continue; } r -= 2 * I_C1;
        if (r < 2 * I_C2) { const int kv = r / I_C2; tr_job(p.cmp_w2 + (size_t)(l * 2 + kv) * 256 * 128, 128, 128, 256, wl_ptr(p, l, WL_CW2) + (size_t)kv * 128 * 256, 0, r % I_C2, scr, lane); continue; } r -= 2 * I_C2;
        if (r < 65 * I_GU) { const int e = r / I_GU; const float* src = e < 64 ? p.exp_w_gu + (size_t)(l * 64 + e) * DM * 1024 : p.shared_w_gu + (size_t)l * DM * 1024;
            tr_job(src, 1024, 1024, DM, wl_ptr(p, l, WL_EGU) + (size_t)e * 1024 * DM, 2, r % I_GU, scr, lane); continue; } r -= 65 * I_GU;
        { const int e = r / I_DN; const float* src = e < 64 ? p.exp_w_down + (size_t)(l * 64 + e) * 512 * DM : p.shared_w_down + (size_t)l * 512 * DM;
            tr_job(src, DM, DM, 512, wl_ptr(p, l, WL_EDN) + (size_t)e * DM * 512, 0, r % I_DN, scr, lane); }
    }
    const size_t gt = (size_t)BIDX * 512 + tid, NGT = (size_t)gridDim.x * 512;
    for (int l = 0; l < NL; ++l) {
        bf16_t* wt = wl_ptr(p, l, WL_WIN);
        for (size_t i = gt; i < (size_t)(LDY - D_IN) * DM / 8; i += NGT) ((uint4*)(wt + (size_t)D_IN * DM))[i] = make_uint4(0, 0, 0, 0);
        { uint4* rz = (uint4*)wl_ptr(p, l, WL_RTZ); for (size_t i = gt; i < (size_t)128 * DM / 8; i += NGT) rz[i] = make_uint4(0, 0, 0, 0); }
        bf16_t* rh = wl_ptr(p, l, WL_RTH); bf16_t* rl = wl_ptr(p, l, WL_RTL);
        for (size_t i = gt; i < (size_t)64 * DM; i += NGT) { const int e = (int)(i / DM), k = (int)(i % DM); const float w = p.router_w[((size_t)l * DM + k) * 64 + e];
            const bf16_t h = f2bf(w); rh[i] = h; rl[i] = f2bf(w - bf2f(h)); }
    }
    { const int ub = (int)gridDim.x - 1 - BIDX;
      if (ub < 64) {
        const int l = ub >> 5, kv = (ub >> 4) & 1, jb = (ub >> 2) & 3, ic = ub & 3;
        const float* pe = p.cmp_pe + (size_t)(l * 2 + kv) * 4096; const float* w1 = p.cmp_w1 + (size_t)(l * 2 + kv) * 4096 * 256;
        float acc = 0.f; const int j = jb * 64 + lane; const int i0 = ic * 1024 + wave * 128;
#pragma unroll 16
        for (int i = i0; i < i0 + 128; ++i) acc += pe[i] * w1[(size_t)i * 256 + j];
        __syncthreads();
        float* red = (float*)smem; red[wave * 64 + lane] = acc; __syncthreads();
        if (wave == 0) { float s = 0.f; for (int w = 0; w < 8; ++w) s += red[w * 64 + lane]; ((float*)(p.ws + WS_CMPB))[ic * 1024 + (l * 2 + kv) * 256 + j] = s; }
      } }
}

DI void st_mod(const Params& p, unsigned char* smem, const int WV) {
    const int TIDX = opq_tid(WV); const int BIDX = opq_bid(); (void)TIDX; (void)BIDX;
    const int tid = TIDX, lane = tid & 63, wave = tid >> 6;
    float* ca = (float*)smem;
    float* red = ca + 4 * DM;
#pragma unroll
    for (int it = 0; it < 4 * DM / 512; ++it) { const int i = tid + it * 512; ca[i] = silu_f(p.c[i]); }
    __syncthreads();
    for (int u = BIDX; u < NL * 96; u += gridDim.x) {
        const int l = u / 96, cb = u % 96; const int col = cb * 128 + (lane & 31) * 4;
        const float* W = p.ada_w + (size_t)l * DM * 12288;
        float acc[4][4] = {};
#pragma unroll 8
        for (int i = 0; i < 128; ++i) { const int k = 2 * (wave + 8 * i) + (lane >> 5);
            typedef float f4v_t __attribute__((ext_vector_type(4))); const f4v_t w = __builtin_nontemporal_load((const f4v_t*)(W + (size_t)k * 12288 + col));
#pragma unroll
            for (int b = 0; b < 4; ++b) { const float cv = ca[b * DM + k]; acc[b][0] += cv * w.x; acc[b][1] += cv * w.y; acc[b][2] += cv * w.z; acc[b][3] += cv * w.w; } }
#pragma unroll
        for (int b = 0; b < 4; ++b)
#pragma unroll
            for (int j = 0; j < 4; ++j) acc[b][j] += __shfl_xor(acc[b][j], 32);
        __syncthreads();
        if (lane < 32) {
#pragma unroll
            for (int b = 0; b < 4; ++b)
#pragma unroll
                for (int j = 0; j < 4; ++j) red[(wave * 4 + b) * 128 + lane * 4 + j] = acc[b][j]; }
        __syncthreads();
        { const int b = tid >> 7, cc = tid & 127; float s = 0.f;
            for (int w = 0; w < 8; ++w) s += red[(w * 4 + b) * 128 + cc];
            const int gcol = cb * 128 + cc;
            ((float*)(p.ws + WS_MOD))[(size_t)(l * NB + b) * 12288 + gcol] = s + p.ada_b[(size_t)l * 12288 + gcol]; }
    }
}

typedef float f4v_t __attribute__((ext_vector_type(4)));
#define LDSF __attribute__((address_space(3)))
DI void norm_row_store(float4 (&v)[8], int lane, const LDSF float* gs, const LDSF float* sh, bf16_t* hrow, bf16_t* lorow) {
    float ss = 0.f;
#pragma unroll
    for (int j = 0; j < 8; ++j) ss += v[j].x * v[j].x + v[j].y * v[j].y + v[j].z * v[j].z + v[j].w * v[j].w;
    const float r = rsqrtf(wave_sum(ss) * (1.f / DM) + EPS);
#pragma unroll
    for (int j = 0; j < 8; ++j) { const unsigned e = ((unsigned)j * 64u + (unsigned)lane) * 4u;
        const f4v_t gg = *(const LDSF f4v_t*)(gs + e), s0 = *(const LDSF f4v_t*)(sh + e);
        const float h0 = v[j].x * r * gg.x + s0.x, h1 = v[j].y * r * gg.y + s0.y, h2 = v[j].z * r * gg.z + s0.z, h3 = v[j].w * r * gg.w + s0.w;
        const bf16_t b0 = f2bf(h0), b1 = f2bf(h1), b2 = f2bf(h2), b3 = f2bf(h3);
        uint2 o; o.x = (unsigned)b0 | ((unsigned)b1 << 16); o.y = (unsigned)b2 | ((unsigned)b3 << 16);
        *(uint2*)(hrow + e) = o;
        if (lorow) { uint2 q; q.x = pk2(h0 - bf2f(b0), h1 - bf2f(b1)); q.y = pk2(h2 - bf2f(b2), h3 - bf2f(b3)); *(uint2*)(lorow + e) = q; } }
}
DI void norm_tables(const Params& p, int l, int which, const float* g, LDSF float* gs, LDSF float* sh, int tid) {
#pragma unroll
    for (int it = 0; it < 4 * DM / 512; ++it) { const int i = tid + it * 512; const int b = i >> 11, kk = i & (DM - 1);
        gs[i] = g[kk] * (1.f + mod_ptr(p, l, b, which * 3 + 1)[kk]); sh[i] = mod_ptr(p, l, b, which * 3 + 0)[kk]; }
}
DI void st_norm(const Params& p, int l, const float* xin, int which, unsigned char* smem, const int WV) {
    const int TIDX = opq_tid(WV); const int BIDX = opq_bid(); (void)TIDX; (void)BIDX;
    const int lane = TIDX & 63, wave = __builtin_amdgcn_readfirstlane(TIDX >> 6);
    bf16_t* H = (bf16_t*)(p.ws + WS_H); bf16_t* HLO = (bf16_t*)(p.ws + WS_HLO);
    LDSF float* gs = (LDSF float*)(LDSF unsigned char*)smem; LDSF float* sh = gs + 4 * DM;
    norm_tables(p, l, which, (which == 0 ? p.norm1_g : p.norm2_g) + (size_t)l * DM, gs, sh, TIDX);
    __syncthreads();
    if (which) {
        const bf16_t* xb = (const bf16_t*)xin; const int step = gridDim.x * 8; int t = BIDX * 8 + wave; uint2 raw[8];
        if (t < NT) {
#pragma unroll
            for (int j = 0; j < 8; ++j) raw[j] = *(const uint2*)(xb + (size_t)t * DM + (j * 64 + lane) * 4); }
        for (; t < NT; t += step) {
            const int b = t / SEQ; float4 v[8];
#pragma unroll
            for (int j = 0; j < 8; ++j) v[j] = make_float4(__uint_as_float(raw[j].x << 16), __uint_as_float(raw[j].x & 0xffff0000u), __uint_as_float(raw[j].y << 16), __uint_as_float(raw[j].y & 0xffff0000u));
            const int tn = t + step;
            if (tn < NT) {
#pragma unroll
                for (int j = 0; j < 8; ++j) raw[j] = *(const uint2*)(xb + (size_t)tn * DM + (j * 64 + lane) * 4); }
            norm_row_store(v, lane, gs + b * DM, sh + b * DM, H + (size_t)t * DM, nullptr);
        }
        return;
    }
    for (int t = BIDX * 8 + wave; t < NT; t += gridDim.x * 8) {
        const int b = t / SEQ; float4 v[8];
#pragma unroll
        for (int j = 0; j < 8; ++j) {
            if (which) { const uint2 w = *(const uint2*)((const bf16_t*)xin + (size_t)t * DM + (j * 64 + lane) * 4);
                v[j] = make_float4(__uint_as_float(w.x << 16), __uint_as_float(w.x & 0xffff0000u), __uint_as_float(w.y << 16), __uint_as_float(w.y & 0xffff0000u)); }
            else v[j] = *(const float4*)(xin + (size_t)t * DM + (j * 64 + lane) * 4); }
        norm_row_store(v, lane, gs + b * DM, sh + b * DM, H + (size_t)t * DM, nullptr);
    }
}

template <class Epi>
DI void sgemm_tile(unsigned char* smem, const bf16_t* A, size_t lda, size_t kseg, int mvalid, const bf16_t* Bt, size_t ldb, int K, const Epi& epi, const int WV) {
    const int TIDX = opq_tid(WV); const int BIDX = opq_bid(); (void)TIDX; (void)BIDX;
    float* As = (float*)smem; float* Bs = As + 16 * 132;
    const int tid = TIDX, tx = tid & 31, ty = tid >> 5;
    const int lr = tid >> 2, lk = (tid & 3) * 4;
    const int ar = lr < mvalid ? lr : mvalid - 1;
    float acc[8][4] = {};
    for (int k0 = 0; k0 < K; k0 += 16) {
        const int k = k0 + lk;
        const uint2 av = *(const uint2*)(A + (size_t)ar * lda + (size_t)(k >> 7) * kseg + (k & 127));
        const uint2 bv = *(const uint2*)(Bt + (size_t)lr * ldb + k);
        __syncthreads();
        As[(lk + 0) * 132 + lr] = __uint_as_float(av.x << 16); As[(lk + 1) * 132 + lr] = __uint_as_float(av.x & 0xffff0000u);
        As[(lk + 2) * 132 + lr] = __uint_as_float(av.y << 16); As[(lk + 3) * 132 + lr] = __uint_as_float(av.y & 0xffff0000u);
        Bs[(lk + 0) * 132 + lr] = __uint_as_float(bv.x << 16); Bs[(lk + 1) * 132 + lr] = __uint_as_float(bv.x & 0xffff0000u);
        Bs[(lk + 2) * 132 + lr] = __uint_as_float(bv.y << 16); Bs[(lk + 3) * 132 + lr] = __uint_as_float(bv.y & 0xffff0000u);
        __syncthreads();
#pragma unroll
        for (int kk = 0; kk < 16; ++kk) {
            const float4 a0 = *(const float4*)(As + kk * 132 + ty * 8), a1 = *(const float4*)(As + kk * 132 + ty * 8 + 4);
            const float4 b = *(const float4*)(Bs + kk * 132 + tx * 4);
            const float a[8] = {a0.x, a0.y, a0.z, a0.w, a1.x, a1.y, a1.z, a1.w};
#pragma unroll
            for (int i = 0; i < 8; ++i) { acc[i][0] += a[i] * b.x; acc[i][1] += a[i] * b.y; acc[i][2] += a[i] * b.z; acc[i][3] += a[i] * b.w; }
        }
    }
    __syncthreads();
#pragma unroll
    for (int i = 0; i < 8; ++i) { const int r = ty * 8 + i; if (r < mvalid) {
#pragma unroll
        for (int j = 0; j < 4; ++j) epi(r, tx * 4 + j, acc[i][j]); } }
}


DI void rot8(uint4& A, uint4& B, const float* cs, const float* sn) {
    unsigned a[4] = {A.x, A.y, A.z, A.w}, b[4] = {B.x, B.y, B.z, B.w};
#pragma unroll
    for (int j = 0; j < 4; ++j) { const float a0 = __uint_as_float(a[j] << 16), a1 = __uint_as_float(a[j] & 0xffff0000u), b0 = __uint_as_float(b[j] << 16), b1 = __uint_as_float(b[j] & 0xffff0000u);
        const float c0 = cs[2 * j], c1 = cs[2 * j + 1], s0 = sn[2 * j], s1 = sn[2 * j + 1];
        a[j] = pk2(a0 * c0 - b0 * s0, a1 * c1 - b1 * s1); b[j] = pk2(a0 * s0 + b0 * c0, a1 * s1 + b1 * c1); }
    A = make_uint4(a[0], a[1], a[2], a[3]); B = make_uint4(b[0], b[1], b[2], b[3]);
}
DI void st_post(const Params& p, int l, unsigned char* smem, const int WV, const float sgn = 1.f) {
    const int TIDX = opq_tid(WV); const int BIDX = opq_bid(); (void)TIDX; (void)BIDX;
    const int lane = TIDX & 63, wave = __builtin_amdgcn_readfirstlane(TIDX >> 6);
    bf16_t* Y = (bf16_t*)(p.ws + WS_Y); bf16_t* YM = (bf16_t*)(p.ws + WS_YMIX);
    float* tab = (float*)smem + wave * 160;
    const float inv_n = exp2f(-(float)(lane & 15) * (18.931568569324174f / 16.f));
    const float inv_r = exp2f(-(float)lane * (13.287712379549449f / 64.f));
    const int c0 = lane * 8;
    float cw[24], cg[8];
    { const float4* w4 = (const float4*)(p.conv_w + ((size_t)l * 512 + c0) * 3);
#pragma unroll
      for (int i = 0; i < 6; ++i) { const float4 v = w4[i]; cw[4 * i] = v.x; cw[4 * i + 1] = v.y; cw[4 * i + 2] = v.z; cw[4 * i + 3] = v.w; }
      const float4* g4 = (const float4*)(p.conv_g + (size_t)l * 512 + c0); const float4 g0 = g4[0], g1 = g4[1];
      cg[0] = g0.x; cg[1] = g0.y; cg[2] = g0.z; cg[3] = g0.w; cg[4] = g1.x; cg[5] = g1.y; cg[6] = g1.z; cg[7] = g1.w; }
    for (int t = BIDX * 8 + wave; t < NT; t += gridDim.x * 8) {
        bf16_t* y = Y + (size_t)t * LDY; const float pos = (float)p.pos[t]; const int s = t % SEQ;
        { float sn, cs; sincosf(pos * inv_r, &sn, &cs); tab[32 + lane] = cs; tab[96 + lane] = sn * sgn;
          if (lane < 16) { sincosf(pos * inv_n, &sn, &cs); tab[lane] = cs; tab[16 + lane] = sn * sgn; } }
        const uint4 qb_ = *(const uint4*)(y + Y_CB + c0), qc0 = *(const uint4*)(y + Y_CC + c0), qu0 = *(const uint4*)(y + Y_CU + c0);
        uint4 qc1 = make_uint4(0, 0, 0, 0), qu1 = qc1, qc2 = qc1, qu2 = qc1;
        if (s >= 1) { qc1 = *(const uint4*)(y + Y_CC + c0 - LDY); qu1 = *(const uint4*)(y + Y_CU + c0 - LDY); }
        if (s >= 2) { qc2 = *(const uint4*)(y + Y_CC + c0 - 2 * LDY); qu2 = *(const uint4*)(y + Y_CU + c0 - 2 * LDY); }
        LDS_WAIT();
        { const int v = lane >> 3, kk = lane & 7; bf16_t* base = y + (v < 4 ? Y_QR : Y_KR) + (v & 3) * 128 + 8 * kk;
          uint4 A = *(const uint4*)base, B = *(const uint4*)(base + 64); rot8(A, B, tab + 32 + 8 * kk, tab + 96 + 8 * kk); *(uint4*)base = A; *(uint4*)(base + 64) = B; }
        if (lane < 28) { const int v = lane >> 1, cp = lane & 1; bf16_t* base = y + (v < 8 ? Y_QN + v * 128 : Y_KV + ((v - 8) >> 1) * 512 + ((v - 8) & 1) * 128) + 8 * cp;
          uint4 A = *(const uint4*)base, B = *(const uint4*)(base + 16); rot8(A, B, tab + 8 * cp, tab + 16 + 8 * cp); *(uint4*)base = A; *(uint4*)(base + 16) = B; }
        const unsigned wb[4] = {qb_.x, qb_.y, qb_.z, qb_.w}, wc0[4] = {qc0.x, qc0.y, qc0.z, qc0.w}, wu0[4] = {qu0.x, qu0.y, qu0.z, qu0.w}, wc1[4] = {qc1.x, qc1.y, qc1.z, qc1.w}, wu1[4] = {qu1.x, qu1.y, qu1.z, qu1.w},
                       wc2[4] = {qc2.x, qc2.y, qc2.z, qc2.w}, wu2[4] = {qu2.x, qu2.y, qu2.z, qu2.w};
        float yc[8]; float ss = 0.f;
#pragma unroll
        for (int i = 0; i < 8; ++i) { const int w = i >> 1; const bool hi_ = i & 1;
#define BFX(arr) (hi_ ? __uint_as_float(arr[w] & 0xffff0000u) : __uint_as_float(arr[w] << 16))
            const float v0 = BFX(wc0) * BFX(wu0), v1 = BFX(wc1) * BFX(wu1), v2 = BFX(wc2) * BFX(wu2);
            yc[i] = BFX(wb) * (cw[3 * i] * v2 + cw[3 * i + 1] * v1 + cw[3 * i + 2] * v0); ss += yc[i] * yc[i]; }
#undef BFX
        ss += __shfl_xor(ss, 1); ss += __shfl_xor(ss, 2); ss += __shfl_xor(ss, 4); ss += __shfl_xor(ss, 8);
        const float rs = rsqrtf(ss * (1.f / 128.f) + EPS);
        uint4 o; o.x = pk2(yc[0] * rs * cg[0], yc[1] * rs * cg[1]); o.y = pk2(yc[2] * rs * cg[2], yc[3] * rs * cg[3]); o.z = pk2(yc[4] * rs * cg[4], yc[5] * rs * cg[5]); o.w = pk2(yc[6] * rs * cg[6], yc[7] * rs * cg[7]);
        *(uint4*)(YM + (size_t)t * DM + c0) = o;
        LDS_WAIT();
    }
}

DI void st_cmp2(const Params& p, int l, unsigned char* smem, const int WV) {
    const int TIDX = opq_tid(WV); const int BIDX = opq_bid(); (void)TIDX; (void)BIDX;
    typedef short c2_bf16x8 __attribute__((ext_vector_type(8))); typedef float c2_f32x16 __attribute__((ext_vector_type(16))); typedef unsigned c2_u4 __attribute__((ext_vector_type(4)));
    constexpr int HP = 264;
    const float* CP = (const float*)(p.ws + WS_CP); const float* bias = (const float*)(p.ws + WS_CMPB) + l * 512;
    bf16_t* hid = (bf16_t*)(smem + 32768);
    const int wid = __builtin_amdgcn_readfirstlane(TIDX >> 6), lane = TIDX & 63, li = lane & 31, hi = lane >> 5, cb = wid & 3, db0 = 2 * (wid >> 2);
    for (int u = BIDX; u < 2 * 8 * 2; u += gridDim.x) {
        const int kv = u >> 4, bg = (u >> 1) & 7, mt = u & 1;
        const bf16_t* W2 = wl_ptr(p, l, WL_CW2) + (size_t)kv * 128 * 256;
        c2_bf16x8 wf[8][2];
#pragma unroll
        for (int ks = 0; ks < 8; ++ks)
#pragma unroll
            for (int t = 0; t < 2; ++t) wf[ks][t] = *(const c2_bf16x8*)(W2 + (size_t)(32 * (db0 + t) + li) * 256 + 16 * ks + 8 * hi);
        __syncthreads();
        for (int i = TIDX; i < 128 * 64; i += 512) { const int r = i >> 6, c4 = (i & 63) * 4; const size_t o = ((size_t)((kv * 8 + bg) * 256 + mt * 128 + r)) * 256 + c4;
            const float4 a0 = *(const float4*)(CP + o), a1 = *(const float4*)(CP + (size_t)16 * 65536 + o), a2 = *(const float4*)(CP + (size_t)32 * 65536 + o), a3 = *(const float4*)(CP + (size_t)48 * 65536 + o);
            const float4 b0_ = *(const float4*)(bias + kv * 256 + c4), b1_ = *(const float4*)(bias + 1024 + kv * 256 + c4), b2_ = *(const float4*)(bias + 2048 + kv * 256 + c4), b3_ = *(const float4*)(bias + 3072 + kv * 256 + c4);
            const float4 bb = make_float4((b0_.x + b1_.x) + (b2_.x + b3_.x), (b0_.y + b1_.y) + (b2_.y + b3_.y), (b0_.z + b1_.z) + (b2_.z + b3_.z), (b0_.w + b1_.w) + (b2_.w + b3_.w));
            uint2 w; w.x = pk2(gelu_tanh_f((a0.x + a1.x) + (a2.x + a3.x) + bb.x), gelu_tanh_f((a0.y + a1.y) + (a2.y + a3.y) + bb.y)); w.y = pk2(gelu_tanh_f((a0.z + a1.z) + (a2.z + a3.z) + bb.z), gelu_tanh_f((a0.w + a1.w) + (a2.w + a3.w) + bb.w));
            *(uint2*)(hid + r * HP + c4) = w; }
        __syncthreads();
        const LDSF bf16_t* hl = (const LDSF bf16_t*)(LDSF unsigned char*)(smem + 32768);
        c2_f32x16 acc[2];
#pragma unroll
        for (int r = 0; r < 16; ++r) { acc[0][r] = 0.f; acc[1][r] = 0.f; }
#pragma unroll
        for (int kh = 0; kh < 2; ++kh) {
            if (kh == 1) {
#pragma unroll
                for (int ks = 0; ks < 8; ++ks)
#pragma unroll
                    for (int t = 0; t < 2; ++t) wf[ks][t] = *(const c2_bf16x8*)(W2 + (size_t)(32 * (db0 + t) + li) * 256 + 128 + 16 * ks + 8 * hi); }
#pragma unroll
            for (int ks = 0; ks < 8; ++ks) { const c2_bf16x8 hf = *(const LDSF c2_bf16x8*)(hl + (32 * cb + li) * HP + 128 * kh + 16 * ks + 8 * hi);
#pragma unroll
                for (int t = 0; t < 2; ++t) acc[t] = kv ? __builtin_amdgcn_mfma_f32_32x32x16_bf16(hf, wf[ks][t], acc[t], 0, 0, 0) : __builtin_amdgcn_mfma_f32_32x32x16_bf16(wf[ks][t], hf, acc[t], 0, 0, 0); } }
        bf16_t* kc = (bf16_t*)(p.ws + WS_KC) + (size_t)bg * 256 * 128; bf16_t* vct = (bf16_t*)(p.ws + WS_VC) + (size_t)bg * 128 * 256;
        if (kv == 0) { const int g = mt * 128 + 32 * cb + li;
#pragma unroll
            for (int t = 0; t < 2; ++t)
#pragma unroll
                for (int rq = 0; rq < 4; ++rq) { uint2 w; w.x = pk2(acc[t][4 * rq], acc[t][4 * rq + 1]); w.y = pk2(acc[t][4 * rq + 2], acc[t][4 * rq + 3]); if (g == 255) { w.x = 0u; w.y = 0u; }
                    *(uint2*)(kc + (size_t)g * 128 + 32 * (db0 + t) + 8 * rq + 4 * hi) = w; } }
        else {
#pragma unroll
            for (int t = 0; t < 2; ++t)
#pragma unroll
                for (int h2 = 0; h2 < 2; ++h2) { const int base = mt * 128 + 32 * cb + 16 * h2 + 8 * hi;
                    c2_u4 w; w.x = pk2(acc[t][8 * h2 + 0], acc[t][8 * h2 + 1]); w.y = pk2(acc[t][8 * h2 + 2], acc[t][8 * h2 + 3]); w.z = pk2(acc[t][8 * h2 + 4], acc[t][8 * h2 + 5]); w.w = pk2(acc[t][8 * h2 + 6], acc[t][8 * h2 + 7]);
                    if (base + 7 == 255) w.w &= 0x0000ffffu;
                    *(c2_u4*)(vct + (size_t)(32 * (db0 + t) + li) * 256 + base) = w; } }
    }
}

DI void st_scan(const Params& p, int l, const int WV) {
    const int TIDX = opq_tid(WV); const int BIDX = opq_bid(); (void)TIDX; (void)BIDX;
    const float* KVC = (const float*)(p.ws + WS_KVC); bf16_t* STB = (bf16_t*)(p.ws + WS_STATEB);
    const bool split = gridDim.x == 256;
    if (split && BIDX < 32) return;
    const int vb = split ? BIDX - 32 : BIDX, vg = split ? 224 : (int)gridDim.x;
    for (size_t i = (size_t)vb * 512 + TIDX; i < (size_t)16 * 16384; i += (size_t)vg * 512) {
        const int bh = (int)(i >> 14), ed = (int)(i & 16383); const float cd = ret_chunkdecay(bh & 3);
        float kv[32];
#pragma unroll
        for (int c = 0; c < 32; ++c) kv[c] = KVC[(size_t)(bh * 32 + c) * 16384 + ed];
        float st = 0.f;
#pragma unroll
        for (int c = 0; c < 32; ++c) { STB[(size_t)(bh * 32 + c) * 16384 + ed] = f2bf(st); st = st * cd + kv[c]; }
    }
}


DI void pad_offsets(const unsigned* CNT, int* po, const int WV) {
    const int TIDX = opq_tid(WV); const int BIDX = opq_bid(); (void)TIDX; (void)BIDX;
    if (TIDX < 64) { const int pad = (int)((CNT[TIDX] + 255u) >> 8) << 8; int inc = pad;
#pragma unroll
        for (int o = 1; o < 64; o <<= 1) { const int v = __shfl_up(inc, o); if (TIDX >= o) inc += v; }
        po[TIDX] = inc - pad; if (TIDX == 63) po[64] = inc; }
    __syncthreads();
}
DI int blk_expert(const int* po, int blk) { int e = 0; while (e < 63 && po[e + 1] <= blk * 256) ++e; return e; }
typedef unsigned u2v_t __attribute__((ext_vector_type(2)));
typedef unsigned u4w_t __attribute__((ext_vector_type(4)));
DI void st_combine(const Params& p, int l, unsigned char* smem, const int WV) {
    const int TIDX = opq_tid(WV); const int BIDX = opq_bid(); (void)TIDX; (void)BIDX;
    bf16_t* X2 = (bf16_t*)(p.ws + WS_X2);
    LDSF float* tg2 = (LDSF float*)(LDSF unsigned char*)smem; LDSF float* tgs = tg2 + 4 * DM; LDSF float* tsh = tgs + 4 * DM;
#pragma unroll
    for (int it = 0; it < 4 * DM / 512; ++it) { const int i = TIDX + it * 512; tg2[i] = mod_ptr(p, l, i >> 11, 5)[i & (DM - 1)]; }
    if (l + 1 < NL) norm_tables(p, l + 1, 0, p.norm1_g + (size_t)(l + 1) * DM, tgs, tsh, TIDX); else for (int i = TIDX; i < DM; i += 512) tgs[i] = p.final_g[i];
    __syncthreads();
    const int* TOPE = (const int*)(p.ws + WS_TOPE); const int* RANK = (const int*)(p.ws + WS_RANK); const float* TOPW = (const float*)(p.ws + WS_TOPW);
    int* po = (int*)(smem + 100 * 1024); pad_offsets((const unsigned*)(p.ws + WS_CTL) + CW_CNT + l * 64, po, WV);
    const int lane = TIDX & 63, wave = __builtin_amdgcn_readfirstlane(TIDX >> 6);
    const __amdgpu_buffer_rsrc_t rys = __builtin_amdgcn_make_buffer_rsrc((void*)(p.ws + WS_YS), 0, (int)((size_t)NROWS_E * DM), 0x00020000);
    const __amdgpu_buffer_rsrc_t rx1 = __builtin_amdgcn_make_buffer_rsrc((void*)(p.ws + WS_X1), 0, (int)((size_t)NT * DM * 2), 0x00020000);
    const int lane0 = lane;
    for (int t = BIDX * 8 + wave; t < NT; t += gridDim.x * 8) {
        int lane = opq_tid(WV) & 63;
        const int b = t / SEQ; float4 acc[8];
        const int lo4 = lane * 4;
        { const int so = (NSLOT + t) * DM;
#pragma unroll
          for (int j = 0; j < 8; ++j) { const int w = (int)__builtin_amdgcn_raw_buffer_load_b32(rys, lo4 + j * 256, so, 2);
              acc[j] = make_float4(__builtin_amdgcn_cvt_f32_fp8(w, 0), __builtin_amdgcn_cvt_f32_fp8(w, 1), __builtin_amdgcn_cvt_f32_fp8(w, 2), __builtin_amdgcn_cvt_f32_fp8(w, 3)); } }
        { const int sv = po[TOPE[(size_t)t * 8 + (lane & 7)]] + RANK[(size_t)t * 8 + (lane & 7)]; const float wv = TOPW[(size_t)t * 8 + (lane & 7)];
#pragma unroll 1
          for (int kk = 0; kk < 8; kk += 4) { int w[4][8];
#pragma unroll
              for (int k2 = 0; k2 < 4; ++k2) { const int so = __builtin_amdgcn_readlane(sv, kk + k2) * DM;
#pragma unroll
                  for (int j = 0; j < 8; ++j) w[k2][j] = (int)__builtin_amdgcn_raw_buffer_load_b32(rys, lo4 + j * 256, so, 2); }
#pragma unroll
              for (int k2 = 0; k2 < 4; ++k2) { const float wk = __uint_as_float(__builtin_amdgcn_readlane(__float_as_uint(wv), kk + k2));
#pragma unroll
                  for (int j = 0; j < 8; ++j) { acc[j].x += wk * __builtin_amdgcn_cvt_f32_fp8(w[k2][j], 0); acc[j].y += wk * __builtin_amdgcn_cvt_f32_fp8(w[k2][j], 1); acc[j].z += wk * __builtin_amdgcn_cvt_f32_fp8(w[k2][j], 2); acc[j].w += wk * __builtin_amdgcn_cvt_f32_fp8(w[k2][j], 3); } }
              asm volatile("" ::: "memory"); } }
        asm volatile("" : "+v"(lane));
        float4 v[8];
#pragma unroll
        for (int j = 0; j < 8; ++j) { const u2v_t xw = __builtin_amdgcn_raw_buffer_load_b64(rx1, lane * 8 + j * 512, t * (DM * 2), 0); const f4v_t gg = *(const LDSF f4v_t*)(tg2 + b * DM + ((unsigned)j * 64u + (unsigned)lane) * 4u);
            v[j] = make_float4(__uint_as_float(xw.x << 16) + gg.x * acc[j].x, __uint_as_float(xw.x & 0xffff0000u) + gg.y * acc[j].y, __uint_as_float(xw.y << 16) + gg.z * acc[j].z, __uint_as_float(xw.y & 0xffff0000u) + gg.w * acc[j].w);
            if ((j & 3) == 3) asm volatile("" ::: "memory"); }
        if (l + 1 < NL) {
#pragma unroll
            for (int j = 0; j < 8; ++j) { uint2 o; o.x = pk2(v[j].x, v[j].y); o.y = pk2(v[j].z, v[j].w); *(uint2*)(X2 + (size_t)t * DM + ((unsigned)j * 64u + (unsigned)lane) * 4u) = o; }
            norm_row_store(v, lane, tgs + b * DM, tsh + b * DM, (bf16_t*)(p.ws + WS_H) + (size_t)t * DM, nullptr);
        } else {
            float ss = 0.f;
#pragma unroll
            for (int j = 0; j < 8; ++j) ss += v[j].x * v[j].x + v[j].y * v[j].y + v[j].z * v[j].z + v[j].w * v[j].w;
            const float r = rsqrtf(wave_sum(ss) * (1.f / DM) + EPS);
#pragma unroll
            for (int j = 0; j < 8; ++j) { const unsigned e = ((unsigned)j * 64u + (unsigned)lane) * 4u; const f4v_t gg = *(const LDSF f4v_t*)(tgs + e);
                *(float4*)(p.out + (size_t)t * DM + e) = make_float4(v[j].x * r * gg.x, v[j].y * r * gg.y, v[j].z * r * gg.z, v[j].w * r * gg.w); }
        }
    }
}


namespace pg8 {
#define PG8_LAS __attribute__((address_space(3)))
typedef short bf16x8 __attribute__((ext_vector_type(8)));
typedef float f32x4 __attribute__((ext_vector_type(4)));
typedef unsigned u32x4 __attribute__((ext_vector_type(4)));
constexpr int BM = 256, BK = 64, HALF = 128, HTB = HALF * BK * 2, STAGE_BYTES = 8 * HTB, NXCD = 8, WGM = 8;
__host__ __device__ __forceinline__ int lds_byte(int r, int c) { const int st = (r >> 4) * 2 + (c >> 5), rr = r & 15, cc = c & 31, ob = rr * 64 + cc * 2; return st * 1024 + (ob ^ (((ob >> 9) & 1) << 5)); }
__host__ __device__ __forceinline__ void stage_rc(int b, int& R, int& C) { const int st = b / 1024, sb = b % 1024, swz = sb ^ (((sb >> 9) & 1) << 5); R = (st >> 1) * 16 + swz / 64; C = (st & 1) * 32 + (swz % 64) / 2; }
__host__ __device__ __forceinline__ int perm32(int rho) { const int n = rho >> 4, i = rho & 15; return 8 * (i >> 2) + 4 * n + (i & 3); }
struct Unit { const char* A; const char* B; int i0, i1; };
__device__ __forceinline__ unsigned cvt_pk_bf16(float lo, float hi) { unsigned r; asm volatile("v_cvt_pk_bf16_f32 %0, %1, %2" : "=v"(r) : "v"(lo), "v"(hi)); return r; }
template <class Epi, class Sched, bool GATHER = false>
__device__ __forceinline__ void gemm_phase(PG8_LAS unsigned char* lds, const int K, const Sched& S, const Epi& E, const int tid, const size_t pitchA = 0, const size_t segA = 256, const size_t pitchB = 0) {
    const int wid = __builtin_amdgcn_readfirstlane(tid >> 6), lane = tid & 63, wr = wid >> 2, wc = wid & 3, fr = lane & 15, fq = lane >> 4;
    const int nt = K / BK;
    unsigned voffB[2], cva[2][2], nva[2][2]; int RA[2]; unsigned CA[2];
    const size_t pA = pitchA ? pitchA : (size_t)K * 2;
#pragma unroll
    for (int i = 0; i < 2; ++i) { int R, C; stage_rc(tid * 16 + i * 8192, R, C);
        const int Rb = Epi::BP16 ? (64 * (R >> 5) + 16 * ((R >> 2) & 3) + 4 * ((R >> 4) & 1) + (R & 3)) : (Epi::PERM ? ((R & ~31) + perm32(R & 31)) : R);
        RA[i] = R; CA[i] = (unsigned)C * 2u; voffB[i] = (unsigned)((size_t)Rb * (pitchB ? pitchB : (size_t)K * 2)) + (unsigned)C * 2u;
        cva[0][i] = (unsigned)((size_t)R * pA) + CA[i]; cva[1][i] = (unsigned)((size_t)(R + HALF) * pA) + CA[i]; nva[0][i] = cva[0][i]; nva[1][i] = cva[1][i]; }
    const size_t kstep = (size_t)(BK * 2);
    const size_t hstep = (size_t)(Epi::BP16 ? 8 : HALF) * (pitchB ? pitchB : (size_t)K * 2);
    const unsigned ldsw = (unsigned)wid * 1024u;
    const int aoff = lds_byte(wr * 64 + fr, fq * 8), boff = lds_byte(wc * 32 + fr, fq * 8);
#define PG8_SA(b, h) (((b) * 2 + (h)) * HTB)
#define PG8_SB(b, h) ((4 + (b) * 2 + (h)) * HTB)
#define PG8_STAGE(bufoff, gbase, voff) do { _Pragma("unroll") for (int _i = 0; _i < 2; ++_i) \
        __builtin_amdgcn_global_load_lds((const unsigned*)((const char*)(gbase) + (voff)[_i]), (PG8_LAS unsigned*)(lds + (bufoff) + ldsw + _i * 8192), 16, 0, 0); } while (0)
#define PG8_LDA(dst, b, h) do { _Pragma("unroll") for (int m = 0; m < 4; ++m) _Pragma("unroll") for (int k = 0; k < 2; ++k) dst[m][k] = *(const PG8_LAS bf16x8*)(lds + PG8_SA(b, h) + aoff + m * 2048 + k * 1024); } while (0)
#define PG8_LDB(dst, b, h) do { _Pragma("unroll") for (int n = 0; n < 2; ++n) _Pragma("unroll") for (int k = 0; k < 2; ++k) dst[n][k] = *(const PG8_LAS bf16x8*)(lds + PG8_SB(b, h) + boff + n * 2048 + k * 1024); } while (0)
#define PG8_MMA(ai, bj, At, Bt) do { __builtin_amdgcn_s_setprio(1); _Pragma("unroll") for (int m = 0; m < 4; ++m) _Pragma("unroll") for (int n = 0; n < 2; ++n) _Pragma("unroll") for (int k = 0; k < 2; ++k) \
        acc[ai][bj][m][n] = __builtin_amdgcn_mfma_f32_16x16x32_bf16(Bt[n][k], At[m][k], acc[ai][bj][m][n], 0, 0, 0); __builtin_amdgcn_s_setprio(0); } while (0)
#define PG8_WAIT_V(n) asm volatile("s_waitcnt vmcnt(" #n ")" ::: "memory")
#define PG8_WAIT_L(n) asm volatile("s_waitcnt lgkmcnt(" #n ")" ::: "memory")
#define PG8_BAR __builtin_amdgcn_s_barrier()
#define PG8_SCHED __builtin_amdgcn_sched_barrier(0)
    Unit cur, nxt; int ui = 0;
    if (!S.next(0, cur)) return;
    f32x4 acc[2][2][4][2];
#pragma unroll
    for (int a = 0; a < 2; ++a)
#pragma unroll
        for (int b = 0; b < 2; ++b)
#pragma unroll
            for (int m = 0; m < 4; ++m)
#pragma unroll
                for (int n = 0; n < 2; ++n) acc[a][b][m][n] = (f32x4){0.f, 0.f, 0.f, 0.f};
    bf16x8 At[4][2], B0[2][2], B1[2][2];
    const char* cA = cur.A; const char* cB = cur.B;
    if constexpr (GATHER) {
#pragma unroll
        for (int h = 0; h < 2; ++h)
#pragma unroll
            for (int i = 0; i < 2; ++i) cva[h][i] = S.rowoff(cur, h * HALF + RA[i]) + CA[i]; }
    S.a_ready(cur);
    PG8_STAGE(PG8_SB(0, 0), cB, voffB); PG8_STAGE(PG8_SA(0, 0), cA, cva[0]); PG8_STAGE(PG8_SB(0, 1), cB + hstep, voffB); PG8_STAGE(PG8_SA(0, 1), cA, cva[1]);
    if (wr == 1) PG8_BAR;
    PG8_WAIT_V(4); PG8_BAR;
    PG8_STAGE(PG8_SB(1, 0), cB + kstep, voffB); PG8_STAGE(PG8_SA(1, 0), cA + kstep, cva[0]); PG8_STAGE(PG8_SB(1, 1), cB + hstep + kstep, voffB);
    PG8_WAIT_V(6); PG8_BAR;
    for (;;) {
        const bool has_next = S.next(ui + 1, nxt);
        if constexpr (GATHER) { if (has_next) {
#pragma unroll
            for (int h = 0; h < 2; ++h)
#pragma unroll
                for (int i = 0; i < 2; ++i) nva[h][i] = S.rowoff(nxt, h * HALF + RA[i]) + CA[i]; } }
        const char* nA = has_next ? nxt.A : cA; const char* nB = has_next ? nxt.B : cB;
        for (int t = 0; t < nt; t += 2) {
            const bool last = (t == nt - 2);
            const char* a1 = cA + (size_t)(t >> 1) * segA + kstep;
            unsigned va2[2][2];
#pragma unroll
            for (int h = 0; h < 2; ++h)
#pragma unroll
                for (int i = 0; i < 2; ++i) va2[h][i] = (GATHER && last) ? nva[h][i] : cva[h][i];
            const char* a2 = last ? nA : cA + (size_t)((t >> 1) + 1) * segA; const char* b2 = last ? nB : cB + (size_t)(t + 2) * kstep;
            const char* a3 = a2 + kstep; const char* b3 = b2 + kstep;
            if (last && has_next) S.a_ready(nxt);
            PG8_LDB(B0, 0, 0); PG8_SCHED; PG8_LDA(At, 0, 0); PG8_STAGE(PG8_SA(1, 1), a1, cva[1]);
            PG8_WAIT_L(8); PG8_BAR; PG8_WAIT_L(0); PG8_MMA(0, 0, At, B0); PG8_BAR; PG8_SCHED;
            PG8_LDB(B1, 0, 1); PG8_STAGE(PG8_SB(0, 0), b2, voffB);
            PG8_BAR; PG8_WAIT_L(0); PG8_MMA(0, 1, At, B1); PG8_BAR;
            PG8_LDA(At, 0, 1); PG8_STAGE(PG8_SA(0, 0), a2, va2[0]);
            PG8_BAR; PG8_WAIT_L(0); PG8_MMA(1, 0, At, B0); PG8_BAR; PG8_SCHED;
            PG8_STAGE(PG8_SB(0, 1), b2 + hstep, voffB);
            PG8_WAIT_V(6); PG8_BAR; PG8_MMA(1, 1, At, B1); PG8_BAR;
            PG8_LDB(B0, 1, 0); PG8_SCHED; PG8_LDA(At, 1, 0); PG8_STAGE(PG8_SA(0, 1), a2, va2[1]);
            PG8_WAIT_L(8); PG8_BAR; PG8_WAIT_L(0); PG8_MMA(0, 0, At, B0); PG8_BAR; PG8_SCHED;
            PG8_LDB(B1, 1, 1); PG8_STAGE(PG8_SB(1, 0), b3, voffB);
            PG8_BAR; PG8_WAIT_L(0); PG8_MMA(0, 1, At, B1); PG8_BAR;
            PG8_LDA(At, 1, 1); PG8_STAGE(PG8_SA(1, 0), a3, va2[0]);
            PG8_BAR; PG8_WAIT_L(0); PG8_MMA(1, 0, At, B0); PG8_BAR; PG8_SCHED;
            PG8_STAGE(PG8_SB(1, 1), b3 + hstep, voffB);
            PG8_WAIT_V(6); PG8_BAR; PG8_MMA(1, 1, At, B1); PG8_BAR;
        }
        if (wr == 0) PG8_BAR;
        if constexpr (!Epi::AFTER_DRAIN) { E(acc, cur, wr, wc, fr, fq); S.done(cur); }
        if (!has_next) break;
#pragma unroll
        for (int a = 0; a < 2; ++a)
#pragma unroll
            for (int b = 0; b < 2; ++b)
#pragma unroll
                for (int m = 0; m < 4; ++m)
#pragma unroll
                    for (int n = 0; n < 2; ++n) acc[a][b][m][n] = (f32x4){0.f, 0.f, 0.f, 0.f};
        cur = nxt; cA = nA; cB = nB; ++ui;
        if constexpr (GATHER) {
#pragma unroll
            for (int h = 0; h < 2; ++h)
#pragma unroll
                for (int i = 0; i < 2; ++i) cva[h][i] = nva[h][i]; }
        if (wr == 1) PG8_BAR;
    }
    PG8_WAIT_V(0);
    PG8_BAR;
    if constexpr (Epi::AFTER_DRAIN) { E.fused(acc, cur, wr, wc, fr, fq, lds, wid, lane); S.done(cur); }
#undef PG8_SA
#undef PG8_SB
#undef PG8_STAGE
#undef PG8_LDA
#undef PG8_LDB
#undef PG8_MMA
#undef PG8_WAIT_V
#undef PG8_WAIT_L
#undef PG8_BAR
#undef PG8_SCHED
}

struct GridOrder {
    int nM, nN, nwg, G, c; const char* A; const char* B; size_t tstep;
    __device__ __forceinline__ void init(int M, int N, int K, int G_, int c_, const void* A_, const void* B_) { nM = M / BM; nN = N / BM; nwg = nM * nN; G = G_; c = c_; A = (const char*)A_; B = (const char*)B_; tstep = (size_t)BM * K * 2; }
    __device__ __forceinline__ bool next(int i, Unit& u) const {
        const long L = (long)i * G + c; if (L >= nwg) return false;
        int wgid = (int)L; { const int q = nwg / NXCD, r = nwg % NXCD, xcd = wgid % NXCD, off = wgid / NXCD; wgid = (xcd < r ? xcd * (q + 1) : r * (q + 1) + (xcd - r) * q) + off; }
        const int nig = WGM * nN, gid = wgid / nig, fm = gid * WGM, gsz = (nM - fm) < WGM ? (nM - fm) : WGM;
        const int pm = fm + ((wgid % nig) % gsz), pn = (wgid % nig) / gsz;
        u.A = A + (size_t)pm * tstep; u.B = B + (size_t)pn * tstep; u.i0 = pm * BM; u.i1 = pn; return true;
    }
    __device__ __forceinline__ void a_ready(const Unit&) const {}
    __device__ __forceinline__ void done(const Unit&) const {}
};
struct MoeOrder {
    int G, c, nblk, npn; const PG8_LAS int* be; const char* XS; const char* HS; const char* W; size_t a_tile, w_exp, w_tile;
    __device__ __forceinline__ bool next(int i, Unit& u) const {
        int blk, pn;
        if ((G & 7) == 0) { const int x = c & 7, r = c >> 3, W = G >> 3, nb = nblk + NT / 256, q = nb >> 3, rem = nb & 7;
            const int b0 = x * q + (x < rem ? x : rem), cntb = q + (x < rem ? 1 : 0); const long kk = (long)i * W + r; if (kk >= (long)cntb * npn) return false;
            blk = b0 + (int)(kk / npn); pn = (int)(kk % npn); }
        else { const long L = (long)i * G + c; if (L >= (long)(nblk + NT / 256) * npn) return false; blk = (int)(L / npn); pn = (int)(L % npn); }
        int e;
        if (blk < nblk) { e = be[blk]; u.A = XS + (size_t)blk * a_tile; u.i0 = blk * 256; }
        else { e = 64; u.A = HS + (size_t)(blk - nblk) * a_tile; u.i0 = NSLOT + (blk - nblk) * 256; }
        if (tokof) u.A = HS;
        u.B = W + (size_t)e * w_exp + (size_t)pn * w_tile; u.i1 = pn; return true;
    }
    __device__ __forceinline__ void a_ready(const Unit&) const {}
    __device__ __forceinline__ void done(const Unit&) const {}
    const int* tokof; unsigned rowbytes; const PG8_LAS int* po; const PG8_LAS int* lc;
    __device__ __forceinline__ unsigned rowoff(const Unit& u, int r) const {
        int t;
        if (u.i0 < NSLOT) { const int e = be[u.i0 >> 8], rk = u.i0 - po[e] + r, c = lc[e]; const int tt = tokof[(size_t)e * NT + (rk < c ? rk : 0)]; t = rk < c ? tt : 0; }
        else t = u.i0 - NSLOT + r;
        return (unsigned)t * rowbytes; }
};
template <bool NT_ST = false> struct EpiStoreBf16T {
    static constexpr bool BP16 = false; static constexpr bool PERM = true, AFTER_DRAIN = false;
    bf16_t* O; int ldc;
    __device__ __forceinline__ void operator()(const f32x4 (&acc)[2][2][4][2], const Unit& u, int wr, int wc, int fr, int fq) const {
        bf16_t* base = O + (size_t)(u.i0 + wr * 64 + fr) * ldc + u.i1 * BM + wc * 32 + 8 * fq;
#pragma unroll
        for (int ai = 0; ai < 2; ++ai)
#pragma unroll
            for (int m = 0; m < 4; ++m) { bf16_t* rowp = base + (size_t)(ai * HALF + m * 16) * ldc;
#pragma unroll
                for (int bj = 0; bj < 2; ++bj) { const f32x4 v0 = acc[ai][bj][m][0], v1 = acc[ai][bj][m][1];
                    u32x4 w; w.x = cvt_pk_bf16(v0[0], v0[1]); w.y = cvt_pk_bf16(v0[2], v0[3]); w.z = cvt_pk_bf16(v1[0], v1[1]); w.w = cvt_pk_bf16(v1[2], v1[3]);
                    if constexpr (NT_ST) __builtin_nontemporal_store(w, (u32x4*)(rowp + bj * HALF)); else *(u32x4*)(rowp + bj * HALF) = w; } }
    }
};
typedef EpiStoreBf16T<false> EpiStoreBf16;
struct EpiSwiglu {
    static constexpr bool BP16 = false; static constexpr bool PERM = true, AFTER_DRAIN = false;
    bf16_t* O;
    __device__ __forceinline__ void operator()(const f32x4 (&acc)[2][2][4][2], const Unit& u, int wr, int wc, int fr, int fq) const {
        bf16_t* base = O + (size_t)(u.i0 + wr * 64 + fr) * 512 + u.i1 * 128 + wc * 32 + 8 * fq;
#pragma unroll
        for (int ai = 0; ai < 2; ++ai)
#pragma unroll
            for (int m = 0; m < 4; ++m) { float r[8];
#pragma unroll
                for (int n = 0; n < 2; ++n)
#pragma unroll
                    for (int j = 0; j < 4; ++j) { const float g = acc[ai][0][m][n][j], up = acc[ai][1][m][n][j]; r[n * 4 + j] = g * __builtin_amdgcn_rcpf(1.f + __expf(-g)) * up; }
                u32x4 w; w.x = cvt_pk_bf16(r[0], r[1]); w.y = cvt_pk_bf16(r[2], r[3]); w.z = cvt_pk_bf16(r[4], r[5]); w.w = cvt_pk_bf16(r[6], r[7]);
                *(u32x4*)(base + (size_t)(ai * HALF + m * 16) * 512) = w; }
    }
};
struct EpiResid {
    static constexpr bool BP16 = false, PACED = false; static constexpr bool PERM = true, AFTER_DRAIN = false;
    const float* xin; const bf16_t* xinb; bf16_t* xo; const float* mod_g1;
    __device__ __forceinline__ void operator()(const f32x4 (&acc)[2][2][4][2], const Unit& u, int wr, int wc, int fr, int fq) const {
        const int col0 = u.i1 * BM + wc * 32 + 8 * fq; const float* g1 = mod_g1 + (size_t)(u.i0 / SEQ) * 12288 + col0;
        f32x4 gv[2][2];
#pragma unroll
        for (int bj = 0; bj < 2; ++bj)
#pragma unroll
            for (int n = 0; n < 2; ++n) gv[bj][n] = *(const f32x4*)(g1 + bj * HALF + n * 4);
        const bool xb = xinb != nullptr;
#pragma unroll
        for (int ai = 0; ai < 2; ++ai)
#pragma unroll
            for (int m = 0; m < 4; ++m) { const size_t off = (size_t)(u.i0 + wr * 64 + fr + ai * HALF + m * 16) * DM + col0;
#pragma unroll
                for (int bj = 0; bj < 2; ++bj) { f32x4 x0, x1;
                    if (xb) { const u32x4 w = *(const u32x4*)(xinb + off + bj * HALF);
                        x0 = (f32x4){__uint_as_float(w.x << 16), __uint_as_float(w.x & 0xffff0000u), __uint_as_float(w.y << 16), __uint_as_float(w.y & 0xffff0000u)};
                        x1 = (f32x4){__uint_as_float(w.z << 16), __uint_as_float(w.z & 0xffff0000u), __uint_as_float(w.w << 16), __uint_as_float(w.w & 0xffff0000u)}; }
                    else { x0 = *(const f32x4*)(xin + off + bj * HALF); x1 = *(const f32x4*)(xin + off + bj * HALF + 4); }
                    const f32x4 r0 = x0 + gv[bj][0] * acc[ai][bj][m][0], r1 = x1 + gv[bj][1] * acc[ai][bj][m][1];
                    u32x4 o; o.x = cvt_pk_bf16(r0[0], r0[1]); o.y = cvt_pk_bf16(r0[2], r0[3]); o.z = cvt_pk_bf16(r1[0], r1[1]); o.w = cvt_pk_bf16(r1[2], r1[3]);
                    *(u32x4*)(xo + off + bj * HALF) = o; }
                if (m & 1) asm volatile("" ::: "memory"); }
    }
};
}

namespace pg8 {
struct EpiStoreFp8 {
    static constexpr bool BP16 = true, PERM = true, AFTER_DRAIN = false;
    unsigned char* O;
    __device__ __forceinline__ static unsigned pk4(const f32x4 v) {
        int w = __builtin_amdgcn_cvt_pk_fp8_f32(__builtin_amdgcn_fmed3f(v[0], -448.f, 448.f), __builtin_amdgcn_fmed3f(v[1], -448.f, 448.f), 0, false);
        w = __builtin_amdgcn_cvt_pk_fp8_f32(__builtin_amdgcn_fmed3f(v[2], -448.f, 448.f), __builtin_amdgcn_fmed3f(v[3], -448.f, 448.f), w, true); return (unsigned)w; }
    __device__ __forceinline__ void operator()(const f32x4 (&acc)[2][2][4][2], const Unit& u, int wr, int wc, int fr, int fq) const {
        unsigned char* base = O + (size_t)(u.i0 + wr * 64 + fr) * DM + u.i1 * BM + wc * 64 + 16 * fq;
#pragma unroll
        for (int ai = 0; ai < 2; ++ai)
#pragma unroll
            for (int m = 0; m < 4; ++m) { u32x4 w; w.x = pk4(acc[ai][0][m][0]); w.y = pk4(acc[ai][0][m][1]); w.z = pk4(acc[ai][1][m][0]); w.w = pk4(acc[ai][1][m][1]);
                *(u32x4*)(base + (size_t)(ai * HALF + m * 16) * DM) = w; }
    }
};
}
constexpr int LDS_PO = 148 * 1024;
constexpr int LDS_BE = 148 * 1024 + 512;
constexpr int LDS_BST = 148 * 1024 + 3072;
constexpr int LDS_LC = 148 * 1024 + 3200;
DI void st_inproj_mm(const Params& p, int l, unsigned char* smem, const int WV) {
    const int TIDX = opq_tid(WV), BIDX = opq_bid();
    pg8::GridOrder S; S.init(NT, 6144, DM, gridDim.x, BIDX, p.ws + WS_H, wl_ptr(p, l, WL_WIN));
    pg8::EpiStoreBf16 E{(bf16_t*)(p.ws + WS_Y), LDY};
    pg8::gemm_phase(( PG8_LAS unsigned char*)smem, DM, S, E, TIDX);
}
DI void st_outproj_mm(const Params& p, int l, const float* xin, const bf16_t* xinb, unsigned char* smem, const int WV) {
    const int TIDX = opq_tid(WV), BIDX = opq_bid();
    pg8::GridOrder S; S.init(NT, DM, DM, gridDim.x, BIDX, p.ws + WS_YMIX, wl_ptr(p, l, WL_WOUT));
    pg8::EpiResid E{xin, xinb, (bf16_t*)(p.ws + WS_X1), mod_ptr(p, l, 0, 2)};
    pg8::gemm_phase((PG8_LAS unsigned char*)smem, DM, S, E, TIDX);
}
DI void moe_offsets(const Params& p, int l, unsigned char* smem, int TIDX) {
    const unsigned* CNT = (const unsigned*)(p.ws + WS_CTL) + CW_CNT + l * 64; int* po = (int*)(smem + LDS_PO);
    __syncthreads();
    if (TIDX < 64) { const int pad = (int)((CNT[TIDX] + 255u) >> 8) << 8; int inc = pad;
        ((int*)(smem + LDS_LC))[TIDX] = (int)CNT[TIDX];
#pragma unroll
        for (int o = 1; o < 64; o <<= 1) { const int v = __shfl_up(inc, o); if (TIDX >= o) inc += v; }
        po[TIDX] = inc - pad; if (TIDX == 63) po[64] = inc; }
    __syncthreads();
    int* be = (int*)(smem + LDS_BE);
    for (int blk = TIDX; blk < 576; blk += 512) { int lo = 0, hi = 63;
#pragma unroll
        for (int it = 0; it < 6; ++it) { const int mid = (lo + hi) >> 1; const bool gt = po[mid + 1] > blk * 256; hi = gt ? mid : hi; lo = gt ? lo : (lo < hi ? mid + 1 : lo); }
        be[blk] = lo; }
    __syncthreads();
}
DI void st_gemm1_mm(const Params& p, int l, unsigned char* smem, const int WV) {
    const int TIDX = opq_tid(WV), BIDX = opq_bid();
    moe_offsets(p, l, smem, TIDX);
    const PG8_LAS int* po = (const PG8_LAS int*)(PG8_LAS unsigned char*)(smem + LDS_PO);
    pg8::MoeOrder S; S.tokof = (const int*)(p.ws + WS_XS); S.po = po; S.lc = (const PG8_LAS int*)(PG8_LAS unsigned char*)(smem + LDS_LC); S.rowbytes = DM * 2; S.G = gridDim.x; S.c = BIDX; S.nblk = po[64] / 256; S.npn = 4; S.be = (const PG8_LAS int*)(PG8_LAS unsigned char*)(smem + LDS_BE); S.XS = (const char*)(p.ws + WS_XS); S.HS = (const char*)(p.ws + WS_H); S.W = (const char*)wl_ptr(p, l, WL_EGU);
    S.a_tile = (size_t)256 * DM * 2; S.w_exp = (size_t)1024 * DM * 2; S.w_tile = (size_t)256 * DM * 2;
    pg8::EpiSwiglu E{(bf16_t*)(p.ws + WS_ACT)};
    pg8::gemm_phase<pg8::EpiSwiglu, pg8::MoeOrder, true>((PG8_LAS unsigned char*)smem, DM, S, E, TIDX);
}
DI void st_gemm2_mm(const Params& p, int l, unsigned char* smem, const int WV) {
    const int TIDX = opq_tid(WV), BIDX = opq_bid();
    moe_offsets(p, l, smem, TIDX);
    const PG8_LAS int* po = (const PG8_LAS int*)(PG8_LAS unsigned char*)(smem + LDS_PO);
    pg8::MoeOrder S; S.tokof = nullptr; S.po = po; S.lc = (const PG8_LAS int*)(PG8_LAS unsigned char*)(smem + LDS_LC); S.rowbytes = 0; S.G = gridDim.x; S.c = BIDX; S.nblk = po[64] / 256; S.npn = 8; S.be = (const PG8_LAS int*)(PG8_LAS unsigned char*)(smem + LDS_BE); S.XS = (const char*)(p.ws + WS_ACT); S.HS = (const char*)(p.ws + WS_ACT) + (size_t)NSLOT * 512 * 2; S.W = (const char*)wl_ptr(p, l, WL_EDN);
    S.a_tile = (size_t)256 * 512 * 2; S.w_exp = (size_t)DM * 512 * 2; S.w_tile = (size_t)256 * 512 * 2;
    pg8::EpiStoreFp8 E{(unsigned char*)(p.ws + WS_YS)};
    pg8::gemm_phase((PG8_LAS unsigned char*)smem, 512, S, E, TIDX);
}

typedef short bf16x8_t __attribute__((ext_vector_type(8)));
typedef float f32x16_t __attribute__((ext_vector_type(16)));
#define LASP __attribute__((address_space(3)))
DI void st_vt(const Params& p, int l, unsigned char* smem, const int WV) {
    const int TIDX = opq_tid(WV), BIDX = opq_bid();
    const bf16_t* Y = (const bf16_t*)(p.ws + WS_Y); bf16_t* VT = (bf16_t*)(p.ws + WS_VT);
    LDSF bf16_t* T = (LDSF bf16_t*)(LDSF unsigned char*)smem;
    constexpr int TSZ = 128 * 72;
    for (int u0 = BIDX; u0 < NB * 64 * 4; u0 += 4 * gridDim.x) {
        { const int tok = TIDX & 63, dseg = (TIDX >> 6) * 16; uint4 v[4][2];
#pragma unroll
          for (int k = 0; k < 4; ++k) { const int u = u0 + k * gridDim.x;
              if (u < NB * 64 * 4) { const int b = u >> 8, tile = (u >> 2) & 63, wh = u & 3, br = 1 + (wh >> 1), g = wh & 1;
                  const uint4* src = (const uint4*)(Y + ((size_t)b * SEQ + tile * 64 + tok) * LDY + Y_KV + br * 512 + 256 + g * 128 + dseg); v[k][0] = src[0]; v[k][1] = src[1]; }
              else { v[k][0] = make_uint4(0u, 0u, 0u, 0u); v[k][1] = v[k][0]; } }
          const int pos = (tok & ~15) | kperm16(tok & 15);
#pragma unroll
          for (int k = 0; k < 4; ++k) { const unsigned w[8] = {v[k][0].x, v[k][0].y, v[k][0].z, v[k][0].w, v[k][1].x, v[k][1].y, v[k][1].z, v[k][1].w};
#pragma unroll
              for (int i = 0; i < 8; ++i) { T[k * TSZ + (dseg + 2 * i) * 72 + pos] = (bf16_t)(w[i] & 0xffffu); T[k * TSZ + (dseg + 2 * i + 1) * 72 + pos] = (bf16_t)(w[i] >> 16); } } }
        __syncthreads();
        { const int d = TIDX >> 2, seg = (TIDX & 3) * 16;
          typedef unsigned u4v_t __attribute__((ext_vector_type(4)));
#pragma unroll
          for (int k = 0; k < 4; ++k) { const int u = u0 + k * gridDim.x;
              if (u < NB * 64 * 4) { const int b = u >> 8, tile = (u >> 2) & 63, wh = u & 3, br = 1 + (wh >> 1), g = wh & 1;
                  const LDSF u4v_t* sp = (const LDSF u4v_t*)(T + k * TSZ + d * 72 + seg);
                  u4v_t* dst = (u4v_t*)(VT + ((size_t)((b * 2 + g) * 2 + (br - 1)) * 128 + d) * SEQ + tile * 64 + seg); const u4v_t s0 = sp[0], s1 = sp[1]; dst[0] = s0; dst[1] = s1; } } }
        __syncthreads();
    }
}
DI float fast_exp2(float x) { return __builtin_amdgcn_exp2f(x); }
#define DSR(dst, addr, off) asm volatile("ds_read_b128 %0, %1 offset:%2" : "=v"(dst) : "v"(addr), "i"(off) : "memory")
#define LWAIT(n, var) asm volatile("s_waitcnt lgkmcnt(" #n ")" : "+v"(var) :: "memory")
DI void qk_tile_pipe(f32x16_t& s0, f32x16_t& s1, const unsigned kb, const int xh, const bf16x8_t (&qf)[8]) {
    bf16x8_t f0, f1, f2, f3;
#pragma unroll
    for (int r = 0; r < 16; ++r) { s0[r] = 0.f; s1[r] = 0.f; }
    DSR(f0, (kb + (unsigned)((0 ^ xh) << 5)), 0);
    DSR(f1, (kb + (unsigned)((0 ^ xh) << 5)), 8192);
    DSR(f2, (kb + (unsigned)((1 ^ xh) << 5)), 0);
    DSR(f3, (kb + (unsigned)((1 ^ xh) << 5)), 8192);
    LWAIT(3, f0); s0 = __builtin_amdgcn_mfma_f32_32x32x16_bf16(f0, qf[0], s0, 0, 0, 0); DSR(f0, (kb + (unsigned)((2 ^ xh) << 5)), 0);
    LWAIT(3, f1); s1 = __builtin_amdgcn_mfma_f32_32x32x16_bf16(f1, qf[0], s1, 0, 0, 0); DSR(f1, (kb + (unsigned)((2 ^ xh) << 5)), 8192);
    LWAIT(3, f2); s0 = __builtin_amdgcn_mfma_f32_32x32x16_bf16(f2, qf[1], s0, 0, 0, 0); DSR(f2, (kb + (unsigned)((3 ^ xh) << 5)), 0);
    LWAIT(3, f3); s1 = __builtin_amdgcn_mfma_f32_32x32x16_bf16(f3, qf[1], s1, 0, 0, 0); DSR(f3, (kb + (unsigned)((3 ^ xh) << 5)), 8192);
    LWAIT(3, f0); s0 = __builtin_amdgcn_mfma_f32_32x32x16_bf16(f0, qf[2], s0, 0, 0, 0); DSR(f0, (kb + (unsigned)((4 ^ xh) << 5)), 0);
    LWAIT(3, f1); s1 = __builtin_amdgcn_mfma_f32_32x32x16_bf16(f1, qf[2], s1, 0, 0, 0); DSR(f1, (kb + (unsigned)((4 ^ xh) << 5)), 8192);
    LWAIT(3, f2); s0 = __builtin_amdgcn_mfma_f32_32x32x16_bf16(f2, qf[3], s0, 0, 0, 0); DSR(f2, (kb + (unsigned)((5 ^ xh) << 5)), 0);
    LWAIT(3, f3); s1 = __builtin_amdgcn_mfma_f32_32x32x16_bf16(f3, qf[3], s1, 0, 0, 0); DSR(f3, (kb + (unsigned)((5 ^ xh) << 5)), 8192);
    LWAIT(3, f0); s0 = __builtin_amdgcn_mfma_f32_32x32x16_bf16(f0, qf[4], s0, 0, 0, 0); DSR(f0, (kb + (unsigned)((6 ^ xh) << 5)), 0);
    LWAIT(3, f1); s1 = __builtin_amdgcn_mfma_f32_32x32x16_bf16(f1, qf[4], s1, 0, 0, 0); DSR(f1, (kb + (unsigned)((6 ^ xh) << 5)), 8192);
    LWAIT(3, f2); s0 = __builtin_amdgcn_mfma_f32_32x32x16_bf16(f2, qf[5], s0, 0, 0, 0); DSR(f2, (kb + (unsigned)((7 ^ xh) << 5)), 0);
    LWAIT(3, f3); s1 = __builtin_amdgcn_mfma_f32_32x32x16_bf16(f3, qf[5], s1, 0, 0, 0); DSR(f3, (kb + (unsigned)((7 ^ xh) << 5)), 8192);
    LWAIT(3, f0); s0 = __builtin_amdgcn_mfma_f32_32x32x16_bf16(f0, qf[6], s0, 0, 0, 0);
    LWAIT(2, f1); s1 = __builtin_amdgcn_mfma_f32_32x32x16_bf16(f1, qf[6], s1, 0, 0, 0);
    LWAIT(1, f2); s0 = __builtin_amdgcn_mfma_f32_32x32x16_bf16(f2, qf[7], s0, 0, 0, 0);
    LWAIT(0, f3); s1 = __builtin_amdgcn_mfma_f32_32x32x16_bf16(f3, qf[7], s1, 0, 0, 0);
}
DI void pv_tile_pipe(f32x16_t (&O)[4], const unsigned vb, const int yh, const bf16x8_t (&pf)[4]) {
    bf16x8_t f0, f1, f2, f3;
    const unsigned av0 = vb + (unsigned)((0 ^ yh) << 5), av1 = vb + (unsigned)((1 ^ yh) << 5), av2 = vb + (unsigned)((2 ^ yh) << 5), av3 = vb + (unsigned)((3 ^ yh) << 5);
    DSR(f0, av0, 0);
    DSR(f1, av0, 4096);
    DSR(f2, av0, 8192);
    DSR(f3, av0, 12288);
    LWAIT(3, f0); O[0] = __builtin_amdgcn_mfma_f32_32x32x16_bf16(f0, pf[0], O[0], 0, 0, 0); DSR(f0, av1, 0);
    LWAIT(3, f1); O[1] = __builtin_amdgcn_mfma_f32_32x32x16_bf16(f1, pf[0], O[1], 0, 0, 0); DSR(f1, av1, 4096);
    LWAIT(3, f2); O[2] = __builtin_amdgcn_mfma_f32_32x32x16_bf16(f2, pf[0], O[2], 0, 0, 0); DSR(f2, av1, 8192);
    LWAIT(3, f3); O[3] = __builtin_amdgcn_mfma_f32_32x32x16_bf16(f3, pf[0], O[3], 0, 0, 0); DSR(f3, av1, 12288);
    LWAIT(3, f0); O[0] = __builtin_amdgcn_mfma_f32_32x32x16_bf16(f0, pf[1], O[0], 0, 0, 0); DSR(f0, av2, 0);
    LWAIT(3, f1); O[1] = __builtin_amdgcn_mfma_f32_32x32x16_bf16(f1, pf[1], O[1], 0, 0, 0); DSR(f1, av2, 4096);
    LWAIT(3, f2); O[2] = __builtin_amdgcn_mfma_f32_32x32x16_bf16(f2, pf[1], O[2], 0, 0, 0); DSR(f2, av2, 8192);
    LWAIT(3, f3); O[3] = __builtin_amdgcn_mfma_f32_32x32x16_bf16(f3, pf[1], O[3], 0, 0, 0); DSR(f3, av2, 12288);
    LWAIT(3, f0); O[0] = __builtin_amdgcn_mfma_f32_32x32x16_bf16(f0, pf[2], O[0], 0, 0, 0); DSR(f0, av3, 0);
    LWAIT(3, f1); O[1] = __builtin_amdgcn_mfma_f32_32x32x16_bf16(f1, pf[2], O[1], 0, 0, 0); DSR(f1, av3, 4096);
    LWAIT(3, f2); O[2] = __builtin_amdgcn_mfma_f32_32x32x16_bf16(f2, pf[2], O[2], 0, 0, 0); DSR(f2, av3, 8192);
    LWAIT(3, f3); O[3] = __builtin_amdgcn_mfma_f32_32x32x16_bf16(f3, pf[2], O[3], 0, 0, 0); DSR(f3, av3, 12288);
    LWAIT(3, f0); O[0] = __builtin_amdgcn_mfma_f32_32x32x16_bf16(f0, pf[3], O[0], 0, 0, 0);
    LWAIT(2, f1); O[1] = __builtin_amdgcn_mfma_f32_32x32x16_bf16(f1, pf[3], O[1], 0, 0, 0);
    LWAIT(1, f2); O[2] = __builtin_amdgcn_mfma_f32_32x32x16_bf16(f2, pf[3], O[2], 0, 0, 0);
    LWAIT(0, f3); O[3] = __builtin_amdgcn_mfma_f32_32x32x16_bf16(f3, pf[3], O[3], 0, 0, 0);
}
#undef DSR
#undef LWAIT
template <int BR>
DI float attn_mask_max(f32x16_t& s0, f32x16_t& s1, int j, int qb, int qoff, int hi, unsigned long long sel) {
    constexpr float C2 = 0.08838834764831845f * 1.4426950408889634f;
    const float NEGINF = -__builtin_inff();
    if (j == qb) {
#pragma unroll
        for (int r = 0; r < 16; ++r) { const int kk = (r & 3) + 8 * (r >> 2) + 4 * hi; if (kk > qoff) s0[r] = NEGINF; if (kk + 32 > qoff) s1[r] = NEGINF; }
    } else if (BR == 1) { const bool on = (sel >> j) & 1ull;
        if (!__all(on)) {
#pragma unroll
            for (int r = 0; r < 16; ++r) { s0[r] = on ? s0[r] : NEGINF; s1[r] = on ? s1[r] : NEGINF; } }
    } else if (j == qb - 8) {
#pragma unroll
        for (int r = 0; r < 16; ++r) { const int kk = (r & 3) + 8 * (r >> 2) + 4 * hi; if (kk <= qoff) s0[r] = NEGINF; if (kk + 32 <= qoff) s1[r] = NEGINF; }
    }
    float mx = s0[0];
#pragma unroll
    for (int r = 1; r < 16; ++r) mx = fmaxf(mx, s0[r]);
#pragma unroll
    for (int r = 0; r < 16; ++r) mx = fmaxf(mx, s1[r]);
    auto sw = __builtin_amdgcn_permlane32_swap(__float_as_uint(mx), __float_as_uint(mx), false, false);
    return fmaxf(__uint_as_float(sw[0]), __uint_as_float(sw[1])) * C2;
}
template <int BR>
DI void attn_branch(LASP unsigned char* ldsw, const bf16_t* yb, const bf16_t* vtb, int g, int qb, int half, int qi, int hi, int wid, int lane, const bf16x8_t (&qf)[8], unsigned long long sel, unsigned long long tiles, f32x16_t (&O)[4]) {
    constexpr float C2 = 0.08838834764831845f * 1.4426950408889634f;
    const LASP unsigned char* lds = ldsw;
    const bool grpB = wid >= 4;
    unsigned kgo[2], vgo[2];
#pragma unroll
    for (int i = 0; i < 2; ++i) { const int pp = (2 * wid + i) * 64 + lane; const int key = pp >> 4, c = (pp & 15) ^ (key & 15); kgo[i] = (unsigned)(key * (LDY * 2) + c * 16);
        const int d = pp >> 3, cv = (pp & 7) ^ ((d >> 1) & 7); vgo[i] = (unsigned)(d * (SEQ * 2) + cv * 16); }
    const char* kbase = (const char*)(yb + Y_KV + BR * 512 + g * 128);
    const char* vbase = (const char*)(vtb + (size_t)(BR - 1) * 128 * SEQ);
#define DMA_TILE(jj, buf) do { const char* kb_ = kbase + (size_t)(jj) * (64 * LDY * 2); const char* vb_ = vbase + (size_t)(jj) * 128; \
        _Pragma("unroll") for (int i_ = 0; i_ < 2; ++i_) { \
            __builtin_amdgcn_global_load_lds((const unsigned*)(kb_ + kgo[i_]), (LASP unsigned*)(ldsw + (buf) * 32768u + (unsigned)((2 * wid + i_) * 1024)), 16, 0, 0); \
            __builtin_amdgcn_global_load_lds((const unsigned*)(vb_ + vgo[i_]), (LASP unsigned*)(ldsw + (buf) * 32768u + 16384u + (unsigned)((2 * wid + i_) * 1024)), 16, 0, 0); } } while (0)
#define BAR_ONLY() do { asm volatile("" ::: "memory"); __builtin_amdgcn_s_barrier(); asm volatile("" ::: "memory"); } while (0)
#define WAIT_DMA(newest_in_flight) do { if (newest_in_flight) asm volatile("s_waitcnt vmcnt(4)" ::: "memory"); else asm volatile("s_waitcnt vmcnt(0)" ::: "memory"); } while (0)
    const int x = qi & 15, xh = x >> 1; const unsigned kra = (unsigned)(qi * 256 + (((hi ^ x) & 1) << 4));
    const int yv = (qi >> 1) & 7, yh = yv >> 1; const unsigned vra = (unsigned)(16384 + qi * 128 + (((hi ^ yv) & 1) << 4));
    const int qoff = 32 * half + qi;
    float m_run = -1.0e30f, l_run = 0.f;
#pragma unroll
    for (int dt = 0; dt < 4; ++dt)
#pragma unroll
        for (int r = 0; r < 16; ++r) O[dt][r] = 0.f;
    unsigned long long rem = tiles;
    int jc = __builtin_ctzll(rem); rem &= rem - 1;
    int j1 = rem ? __builtin_ctzll(rem) : -1; rem &= rem - 1;
    int j2 = rem ? __builtin_ctzll(rem) : -1; rem &= rem - 1;
    asm volatile("s_waitcnt vmcnt(0)" ::: "memory");
    DMA_TILE(jc, 0u);
    if (j1 >= 0) DMA_TILE(j1, 1u);
    if (j2 >= 0) DMA_TILE(j2, 2u);
    WAIT_DMA(j2 >= 0);
    BAR_ONLY();
    f32x16_t s0, s1;
    qk_tile_pipe(s0, s1, (unsigned)(uintptr_t)ldsw + kra, xh, qf);
    m_run = fmaxf(m_run, attn_mask_max<BR>(s0, s1, jc, qb, qoff, hi, sel));
    if (grpB) BAR_ONLY();
    unsigned cur = 0;
    for (;;) {
        const int j3 = rem ? __builtin_ctzll(rem) : -1; rem &= rem - 1;
        if (grpB && j3 >= 0) DMA_TILE(j3, ((cur + 3u) & 3u));
        float ps = 0.f;
#pragma unroll
        for (int r = 0; r < 16; ++r) { s0[r] = fast_exp2(s0[r] * C2 - m_run); s1[r] = fast_exp2(s1[r] * C2 - m_run); ps += s0[r] + s1[r]; }
        l_run += ps;
        bf16x8_t pf[4];
#pragma unroll
        for (int s = 0; s < 4; ++s) { const f32x16_t& sv = (s < 2) ? s0 : s1; const int o = (s & 1) * 8;
            typedef unsigned u4_t __attribute__((ext_vector_type(4))); u4_t ww = {pg8::cvt_pk_bf16(sv[o + 0], sv[o + 1]), pg8::cvt_pk_bf16(sv[o + 2], sv[o + 3]), pg8::cvt_pk_bf16(sv[o + 4], sv[o + 5]), pg8::cvt_pk_bf16(sv[o + 6], sv[o + 7])};
            pf[s] = *reinterpret_cast<bf16x8_t*>(&ww); }
        if (!grpB) WAIT_DMA(j2 >= 0);
        BAR_ONLY();
        if (!grpB && j3 >= 0) DMA_TILE(j3, ((cur + 3u) & 3u));
        __builtin_amdgcn_s_setprio(1);
        const unsigned lbase = (unsigned)(uintptr_t)ldsw;
        pv_tile_pipe(O, lbase + cur * 32768u + vra, yh, pf);
        if (j1 >= 0) qk_tile_pipe(s0, s1, lbase + ((cur + 1u) & 3u) * 32768u + kra, xh, qf);
        __builtin_amdgcn_s_setprio(0);
        if (grpB) WAIT_DMA(j3 >= 0);
        BAR_ONLY();
        if (j1 < 0) break;
        { const float mx = attn_mask_max<BR>(s0, s1, j1, qb, qoff, hi, sel);
          if (__any(mx > m_run + 8.f)) { const float m_new = fmaxf(m_run, mx), alpha = fast_exp2(m_run - m_new); m_run = m_new; l_run *= alpha;
#pragma unroll
              for (int dt = 0; dt < 4; ++dt)
#pragma unroll
                  for (int r = 0; r < 16; ++r) O[dt][r] *= alpha; } }
        cur = (cur + 1u) & 3u; jc = j1; j1 = j2; j2 = j3;
    }
    if (!grpB) BAR_ONLY();
    asm volatile("s_waitcnt vmcnt(0)" ::: "memory");
    BAR_ONLY();
#undef DMA_TILE
#undef BAR_ONLY
#undef WAIT_DMA
    float lt;
    { auto sw = __builtin_amdgcn_permlane32_swap(__float_as_uint(l_run), __float_as_uint(l_run), false, false); lt = __uint_as_float(sw[0]) + __uint_as_float(sw[1]); }
    const float inv = 1.f / lt;
#pragma unroll
    for (int dt = 0; dt < 4; ++dt)
#pragma unroll
        for (int r = 0; r < 16; ++r) O[dt][r] *= inv;
}
DI void st_attn_mm(const Params& p, int l, unsigned char* smem, const int WV) {
    const int TIDX = opq_tid(WV), BIDX = opq_bid();
    const int wid = __builtin_amdgcn_readfirstlane(TIDX >> 6), lane0 = TIDX & 63, rr = wid >> 1, half = wid & 1;
    const bf16_t* Y = (const bf16_t*)(p.ws + WS_Y); const float* OC = (const float*)(p.ws + WS_OCMP); const unsigned long long* SEL = (const unsigned long long*)(p.ws + WS_SEL);
    bf16_t* YM = (bf16_t*)(p.ws + WS_YMIX); const bf16_t* VT = (const bf16_t*)(p.ws + WS_VT);
    const LASP unsigned char* lds = (const LASP unsigned char*)smem;
    LASP unsigned long long* sor = (LASP unsigned long long*)(LASP unsigned char*)(smem + 131072);
    for (int item = BIDX; item < 256; item += gridDim.x) {
        const int bg = item & 7, pr = item >> 3, b = bg >> 1, g = bg & 1, h = g * 4 + rr;
        const bf16_t* yb = Y + (size_t)b * SEQ * LDY; const bf16_t* vtb = VT + (size_t)bg * 2 * 128 * SEQ;
#pragma unroll 1
        for (int pass = 0; pass < 2; ++pass) {
            int lane = lane0; asm volatile("" : "+v"(lane));
            const int qi = lane & 31, hi = lane >> 5;
            const int qb = pass ? pr : 63 - pr, t = qb * 64 + 32 * half + qi;
            const bf16_t* yrow = yb + (size_t)t * LDY;
            bf16x8_t qf[8];
#pragma unroll
            for (int ks = 0; ks < 8; ++ks) qf[ks] = *(const bf16x8_t*)(yrow + Y_QN + h * 128 + 16 * ks + 8 * hi);
            const unsigned long long sel = SEL[(size_t)bg * SEQ + t];
            { unsigned lo = (unsigned)sel, hi32 = (unsigned)(sel >> 32);
#pragma unroll
              for (int o = 1; o < 32; o <<= 1) { lo |= __shfl_xor(lo, o); hi32 |= __shfl_xor(hi32, o); }
              if (wid < 2 && lane == 0) sor[wid] = ((unsigned long long)hi32 << 32) | lo; }
            __syncthreads();
            const unsigned long long lowmask = (qb == 63) ? ~0ull : ((2ull << qb) - 1ull);
            const unsigned long long tiles_s = (sor[0] | sor[1] | 1ull | (1ull << qb)) & lowmask;
            const int jlo = qb >= 8 ? qb - 8 : 0; const unsigned long long tiles_w = lowmask & ~((1ull << jlo) - 1ull);
            f32x16_t O[4];
            const float* gp_ = (const float*)(p.ws + WS_GATEP) + ((size_t)b * SEQ + t) * 256 + h * 3;
            const float g0 = sigmoid_f(gp_[0] + gp_[(size_t)NT * 256]), g1 = sigmoid_f(gp_[1] + gp_[(size_t)NT * 256 + 1]), g2 = sigmoid_f(gp_[2] + gp_[(size_t)NT * 256 + 2]);
            const float* ocrow = OC + ((size_t)b * SEQ + t) * 1024 + h * 128 + 4 * hi; float* ptrow = (float*)(p.ws + WS_PART) + ((size_t)b * SEQ + t) * 1024 + h * 128 + 4 * hi;
            attn_branch<1>((LASP unsigned char*)smem, yb, vtb, g, qb, half, qi, hi, wid, lane, qf, sel, tiles_s, O);
            { float4 cc[16];
#pragma unroll
              for (int i = 0; i < 16; ++i) cc[i] = *(const float4*)(ocrow + 32 * (i >> 2) + 8 * (i & 3));
#pragma unroll
              for (int i = 0; i < 16; ++i) { const int dt = i >> 2, rq = i & 3; float4 c = cc[i];
                  c.x = g0 * c.x + g1 * O[dt][4 * rq + 0]; c.y = g0 * c.y + g1 * O[dt][4 * rq + 1]; c.z = g0 * c.z + g1 * O[dt][4 * rq + 2]; c.w = g0 * c.w + g1 * O[dt][4 * rq + 3];
                  *(float4*)(ptrow + 32 * dt + 8 * rq) = c; } }
            attn_branch<2>((LASP unsigned char*)smem, yb, vtb, g, qb, half, qi, hi, wid, lane, qf, sel, tiles_w, O);
            float ss = 0.f;
            { float4 cc[16];
#pragma unroll
              for (int i = 0; i < 16; ++i) cc[i] = *(const float4*)(ptrow + 32 * (i >> 2) + 8 * (i & 3));
#pragma unroll
              for (int i = 0; i < 16; ++i) { const int dt = i >> 2, rq = i & 3; const float4 c = cc[i];
                  O[dt][4 * rq + 0] = c.x + g2 * O[dt][4 * rq + 0]; O[dt][4 * rq + 1] = c.y + g2 * O[dt][4 * rq + 1]; O[dt][4 * rq + 2] = c.z + g2 * O[dt][4 * rq + 2]; O[dt][4 * rq + 3] = c.w + g2 * O[dt][4 * rq + 3];
                  ss += O[dt][4 * rq + 0] * O[dt][4 * rq + 0] + O[dt][4 * rq + 1] * O[dt][4 * rq + 1] + O[dt][4 * rq + 2] * O[dt][4 * rq + 2] + O[dt][4 * rq + 3] * O[dt][4 * rq + 3]; } }
            { auto sw = __builtin_amdgcn_permlane32_swap(__float_as_uint(ss), __float_as_uint(ss), false, false); ss = __uint_as_float(sw[0]) + __uint_as_float(sw[1]); }
            const float rn = rsqrtf(ss * (1.f / 128.f) + EPS);
            const float* ng = p.nsa_g + (size_t)l * 1024 + h * 128 + 4 * hi; bf16_t* orow = YM + ((size_t)b * SEQ + t) * DM + 512 + h * 128 + 4 * hi;
            { float4 gg[16];
#pragma unroll
              for (int i = 0; i < 16; ++i) gg[i] = *(const float4*)(ng + 32 * (i >> 2) + 8 * (i & 3));
#pragma unroll
              for (int i = 0; i < 16; ++i) { const int dt = i >> 2, rq = i & 3;
                  uint2 w; w.x = pg8::cvt_pk_bf16(O[dt][4 * rq + 0] * rn * gg[i].x, O[dt][4 * rq + 1] * rn * gg[i].y); w.y = pg8::cvt_pk_bf16(O[dt][4 * rq + 2] * rn * gg[i].z, O[dt][4 * rq + 3] * rn * gg[i].w);
                  *(uint2*)(orow + 32 * dt + 8 * rq) = w; } }
        }
    }
}

constexpr int RP = 136;
DI int kv_unit(int c, int i, int G) {
    if (G == 256) { if (c < 192) return i == 0 ? c : -1; return i < 5 ? 192 + (c - 192) * 5 + i : -1; }
    const int u = c + i * G; return u < 16 * 32 ? u : -1;
}
DI void st_kvchunk_mm(const Params& p, int l, unsigned char* smem, const int WV) {
    const int TIDX = opq_tid(WV), BIDX = opq_bid();
    const int wid = __builtin_amdgcn_readfirstlane(TIDX >> 6), lane = TIDX & 63, li = lane & 31, hi = lane >> 5;
    const bf16_t* Y = (const bf16_t*)(p.ws + WS_Y); float* KVC = (float*)(p.ws + WS_KVC);
    LDSF bf16_t* KT = (LDSF bf16_t*)smem; LDSF bf16_t* VTt = KT + 128 * RP;
    const int m = TIDX >> 2, seg = (TIDX & 3) * 32;
    uint4 kq[4], vq[4];
    const int G = gridDim.x; int u = kv_unit(BIDX, 0, G);
    if (u >= 0) { const int bh = u >> 5, c = u & 31, b = bh >> 2, h = bh & 3; const bf16_t* row = Y + ((size_t)b * SEQ + c * 128 + m) * LDY;
        const uint4* ks = (const uint4*)(row + Y_KR + h * 128 + seg); const uint4* vs = (const uint4*)(row + Y_VR + h * 128 + seg);
#pragma unroll
        for (int q4 = 0; q4 < 4; ++q4) { kq[q4] = ks[q4]; vq[q4] = vs[q4]; } }
    for (int it = 0; u >= 0; ++it) {
        const int bh = u >> 5, c = u & 31, h = bh & 3; const float lg = ret_loggamma(h);
        { const float z = __expf((float)(127 - m) * lg) * 0.08838834764831845f;
#pragma unroll
          for (int q4 = 0; q4 < 4; ++q4) { const uint4 kk = kq[q4], vv = vq[q4]; const unsigned kw[4] = {kk.x, kk.y, kk.z, kk.w}, vw[4] = {vv.x, vv.y, vv.z, vv.w};
#pragma unroll
              for (int i = 0; i < 4; ++i) { const int d = seg + q4 * 8 + 2 * i;
                  KT[d * RP + m] = f2bf(__uint_as_float(kw[i] << 16) * z); KT[(d + 1) * RP + m] = f2bf(__uint_as_float(kw[i] & 0xffff0000u) * z);
                  VTt[d * RP + m] = (bf16_t)(vw[i] & 0xffffu); VTt[(d + 1) * RP + m] = (bf16_t)(vw[i] >> 16); } } }
        const int un = kv_unit(BIDX, it + 1, G);
        { if (un >= 0) { const int bh2 = un >> 5, c2 = un & 31, b2 = bh2 >> 2, h2 = bh2 & 3; const bf16_t* row = Y + ((size_t)b2 * SEQ + c2 * 128 + m) * LDY;
              const uint4* ks = (const uint4*)(row + Y_KR + h2 * 128 + seg); const uint4* vs = (const uint4*)(row + Y_VR + h2 * 128 + seg);
#pragma unroll
              for (int q4 = 0; q4 < 4; ++q4) { kq[q4] = ks[q4]; vq[q4] = vs[q4]; } } }
        __syncthreads();
        const int db = wid & 3, eb0 = 2 * (wid >> 2);
        f32x16_t acc[2];
#pragma unroll
        for (int r = 0; r < 16; ++r) { acc[0][r] = 0.f; acc[1][r] = 0.f; }
#pragma unroll
        for (int ks = 0; ks < 8; ++ks) { const bf16x8_t a = *(const LDSF bf16x8_t*)(KT + (32 * db + li) * RP + 16 * ks + 8 * hi);
#pragma unroll
            for (int t = 0; t < 2; ++t) { const bf16x8_t bb = *(const LDSF bf16x8_t*)(VTt + (32 * (eb0 + t) + li) * RP + 16 * ks + 8 * hi); acc[t] = __builtin_amdgcn_mfma_f32_32x32x16_bf16(a, bb, acc[t], 0, 0, 0); } }
#pragma unroll
        for (int t = 0; t < 2; ++t) { float* orow = KVC + ((size_t)(bh * 32 + c) * 128 + 32 * (eb0 + t) + li) * 128 + 32 * db + 4 * hi;
#pragma unroll
            for (int rq = 0; rq < 4; ++rq) *(float4*)(orow + 8 * rq) = make_float4(acc[t][4 * rq], acc[t][4 * rq + 1], acc[t][4 * rq + 2], acc[t][4 * rq + 3]); }
        __syncthreads();
        u = un;
    }
}
DI void st_retout_mm(const Params& p, int l, unsigned char* smem, const int WV) {
    const int TIDX = opq_tid(WV), BIDX = opq_bid();
    const int wid = __builtin_amdgcn_readfirstlane(TIDX >> 6), lane = TIDX & 63, li = lane & 31, hi = lane >> 5, nb = wid & 3, eh = wid >> 2;
    const bf16_t* Y = (const bf16_t*)(p.ws + WS_Y); const bf16_t* STB = (const bf16_t*)(p.ws + WS_STATEB); bf16_t* YM = (bf16_t*)(p.ws + WS_YMIX);
    LDSF bf16_t* KL = (LDSF bf16_t*)smem; LDSF bf16_t* VL = KL + 128 * RP; LDSF bf16_t* SL = VL + 128 * RP; LDSF float* ssq = (LDSF float*)(SL + 128 * RP);
    typedef unsigned u4v_t __attribute__((ext_vector_type(4)));
    const int m = TIDX >> 2, seg = (TIDX & 3) * 32;
    u4v_t kq[4], sq[4]; uint4 vq[4]; bf16x8_t qn[8];
    if (BIDX < 16 * 32) { const int bh = BIDX >> 5, c = BIDX & 31, b = bh >> 2, h = bh & 3; const bf16_t* row = Y + ((size_t)b * SEQ + c * 128 + m) * LDY;
        const u4v_t* ks = (const u4v_t*)(row + Y_KR + h * 128 + seg); const uint4* vs = (const uint4*)(row + Y_VR + h * 128 + seg);
        const u4v_t* ss = (const u4v_t*)(STB + (size_t)(bh * 32 + c) * 16384 + (size_t)m * 128 + seg);
        const bf16_t* qrow = Y + ((size_t)b * SEQ + c * 128 + 32 * nb + li) * LDY;
#pragma unroll
        for (int q4 = 0; q4 < 4; ++q4) { kq[q4] = ks[q4]; sq[q4] = ss[q4]; vq[q4] = vs[q4]; }
#pragma unroll
        for (int ks2 = 0; ks2 < 8; ++ks2) qn[ks2] = *(const bf16x8_t*)(qrow + Y_QR + h * 128 + 16 * ks2 + 8 * hi); }
    for (int u = BIDX; u < 16 * 32; u += gridDim.x) {
        const int bh = u >> 5, c = u & 31, b = bh >> 2, h = bh & 3; const float lg2 = ret_loggamma(h) * 1.4426950408889634f;
        { const int pos = (m & ~15) | kperm16(m & 15);
#pragma unroll
          for (int q4 = 0; q4 < 4; ++q4) { *(LDSF u4v_t*)(KL + m * RP + seg + q4 * 8) = kq[q4]; *(LDSF u4v_t*)(SL + m * RP + seg + q4 * 8) = sq[q4];
              const uint4 vv = vq[q4]; const unsigned vw[4] = {vv.x, vv.y, vv.z, vv.w};
#pragma unroll
              for (int i = 0; i < 4; ++i) { const int e = seg + q4 * 8 + 2 * i; VL[e * RP + pos] = (bf16_t)(vw[i] & 0xffffu); VL[(e + 1) * RP + pos] = (bf16_t)(vw[i] >> 16); } } }
        const int n = 32 * nb + li; const bf16_t* qrow = Y + ((size_t)b * SEQ + c * 128 + n) * LDY;
        bf16x8_t qf[8];
#pragma unroll
        for (int ks = 0; ks < 8; ++ks) qf[ks] = qn[ks];
        { const int un = u + gridDim.x;
          if (un < 16 * 32) { const int bh2 = un >> 5, c2 = un & 31, b2 = bh2 >> 2, h2 = bh2 & 3; const bf16_t* row = Y + ((size_t)b2 * SEQ + c2 * 128 + m) * LDY;
              const u4v_t* ks = (const u4v_t*)(row + Y_KR + h2 * 128 + seg); const uint4* vs = (const uint4*)(row + Y_VR + h2 * 128 + seg);
              const u4v_t* ss = (const u4v_t*)(STB + (size_t)(bh2 * 32 + c2) * 16384 + (size_t)m * 128 + seg);
              const bf16_t* qrow2 = Y + ((size_t)b2 * SEQ + c2 * 128 + n) * LDY;
#pragma unroll
              for (int q4 = 0; q4 < 4; ++q4) { kq[q4] = ks[q4]; sq[q4] = ss[q4]; vq[q4] = vs[q4]; }
#pragma unroll
              for (int ks2 = 0; ks2 < 8; ++ks2) qn[ks2] = *(const bf16x8_t*)(qrow2 + Y_QR + h2 * 128 + 16 * ks2 + 8 * hi); } }
        __syncthreads();
        f32x16_t O[2];
#pragma unroll
        for (int r = 0; r < 16; ++r) { O[0][r] = 0.f; O[1][r] = 0.f; }
#pragma unroll
        for (int ks = 0; ks < 8; ++ks)
#pragma unroll
            for (int dt = 0; dt < 2; ++dt) { const bf16x8_t a = *(const LDSF bf16x8_t*)(SL + (64 * eh + 32 * dt + li) * RP + 16 * ks + 8 * hi); O[dt] = __builtin_amdgcn_mfma_f32_32x32x16_bf16(a, qf[ks], O[dt], 0, 0, 0); }
        { const float xi = fast_exp2((float)(n + 1) * lg2);
#pragma unroll
          for (int r = 0; r < 16; ++r) { O[0][r] *= xi; O[1][r] *= xi; } }
        for (int ms = 0; ms <= nb; ++ms) {
            f32x16_t s;
#pragma unroll
            for (int r = 0; r < 16; ++r) s[r] = 0.f;
#pragma unroll
            for (int ks = 0; ks < 8; ++ks) { const bf16x8_t a = *(const LDSF bf16x8_t*)(KL + (32 * ms + li) * RP + 16 * ks + 8 * hi); s = __builtin_amdgcn_mfma_f32_32x32x16_bf16(a, qf[ks], s, 0, 0, 0); }
#pragma unroll
            for (int r = 0; r < 16; ++r) { const int m = 32 * ms + (r & 3) + 8 * (r >> 2) + 4 * hi; const int df = n - m;
                s[r] = df >= 0 ? s[r] * 0.08838834764831845f * fast_exp2((float)df * lg2) : 0.f; }
#pragma unroll
            for (int sp = 0; sp < 2; ++sp) { const int o = sp * 8;
                typedef unsigned u4_t __attribute__((ext_vector_type(4))); u4_t ww = {pg8::cvt_pk_bf16(s[o + 0], s[o + 1]), pg8::cvt_pk_bf16(s[o + 2], s[o + 3]), pg8::cvt_pk_bf16(s[o + 4], s[o + 5]), pg8::cvt_pk_bf16(s[o + 6], s[o + 7])};
                const bf16x8_t pf = *reinterpret_cast<bf16x8_t*>(&ww);
#pragma unroll
                for (int dt = 0; dt < 2; ++dt) { const bf16x8_t a = *(const LDSF bf16x8_t*)(VL + (64 * eh + 32 * dt + li) * RP + 32 * ms + 16 * sp + 8 * hi); O[dt] = __builtin_amdgcn_mfma_f32_32x32x16_bf16(a, pf, O[dt], 0, 0, 0); } }
        }
        float ss = 0.f;
#pragma unroll
        for (int r = 0; r < 16; ++r) ss += O[0][r] * O[0][r] + O[1][r] * O[1][r];
        ss += __shfl_xor(ss, 32);
        if (hi == 0) ssq[wid * 32 + li] = ss;
        __syncthreads();
        const float rn = rsqrtf((ss + ssq[(wid ^ 4) * 32 + li]) * (1.f / 128.f) + EPS);
        const int e0 = 64 * eh + 4 * hi; const float* rg = p.ret_g + (size_t)l * 512 + h * 128 + e0; bf16_t* orow = YM + ((size_t)b * SEQ + c * 128 + n) * DM + 1536 + h * 128 + e0;
#pragma unroll
        for (int dt = 0; dt < 2; ++dt)
#pragma unroll
            for (int rq = 0; rq < 4; ++rq) { const int eo = 32 * dt + 8 * rq; const float4 gg = *(const float4*)(rg + eo); const uint2 gw = *(const uint2*)(qrow + Y_GR + h * 128 + e0 + eo);
                const float g0 = __uint_as_float(gw.x << 16), g1 = __uint_as_float(gw.x & 0xffff0000u), g2 = __uint_as_float(gw.y << 16), g3 = __uint_as_float(gw.y & 0xffff0000u);
                uint2 w; w.x = pg8::cvt_pk_bf16(silu_f(g0) * O[dt][4 * rq] * rn * gg.x, silu_f(g1) * O[dt][4 * rq + 1] * rn * gg.y);
                w.y = pg8::cvt_pk_bf16(silu_f(g2) * O[dt][4 * rq + 2] * rn * gg.z, silu_f(g3) * O[dt][4 * rq + 3] * rn * gg.w);
                *(uint2*)(orow + eo) = w; }
        __syncthreads();
    }
}

DI void st_cmpattn_mm(const Params& p, int l, unsigned char* smem, const int WV) {
    const int TIDX = opq_tid(WV), BIDX = opq_bid();
    const int wid = __builtin_amdgcn_readfirstlane(TIDX >> 6), lane = TIDX & 63, qi = lane & 31, hi = lane >> 5, rr = wid >> 1, half = wid & 1;
    constexpr float C2 = 0.08838834764831845f * 1.4426950408889634f;
    const float NEGINF = -__builtin_inff();
    const bf16_t* Y = (const bf16_t*)(p.ws + WS_Y); const bf16_t* KC = (const bf16_t*)(p.ws + WS_KC); const bf16_t* VCT = (const bf16_t*)(p.ws + WS_VC);
    float* OC = (float*)(p.ws + WS_OCMP); unsigned long long* SEL = (unsigned long long*)(p.ws + WS_SEL);
    const LASP unsigned char* lds = (const LASP unsigned char*)smem; LASP unsigned char* ldsw = (LASP unsigned char*)smem;
    int* impL = (int*)(smem + 131072);
    typedef unsigned u4v_t __attribute__((ext_vector_type(4)));
    const int skey = TIDX >> 3, scp = TIDX & 7; const unsigned kwa = (unsigned)(skey * 256 + (((2 * scp) ^ (skey & 15)) << 4));
    const int sd = TIDX >> 2, vcp = TIDX & 3; const unsigned vwa = (unsigned)(65536 + sd * 128 + (((2 * vcp) ^ ((sd >> 1) & 7)) << 4));
    const int x = qi & 15, xh = x >> 1; const unsigned kra = (unsigned)(qi * 256 + (((hi ^ x) & 1) << 4));
    const int yv = (qi >> 1) & 7, yh = yv >> 1; const unsigned vra = (unsigned)(65536 + qi * 128 + (((hi ^ yv) & 1) << 4));
    for (int item = BIDX; item < 256; item += gridDim.x) {
        const int bg = item & 7, pr = item >> 3, b = bg >> 1, g = bg & 1, h = g * 4 + rr;
#pragma unroll 1
        for (int pass = 0; pass < 2; ++pass) {
            const int qb = pass ? pr : 63 - pr, t = qb * 64 + 32 * half + qi;
            const int ntile = (4 * qb + 3 + 63) >> 6;
            const bf16_t* yrow = Y + ((size_t)b * SEQ + t) * LDY;
            bf16x8_t qf[8];
#pragma unroll
            for (int ks = 0; ks < 8; ++ks) qf[ks] = *(const bf16x8_t*)(yrow + Y_QN + h * 128 + 16 * ks + 8 * hi);
#pragma unroll 1
            for (int tl = 0; tl < ntile; tl += 2) {
                const int t2 = tl + 1 < ntile ? tl + 1 : tl;
                const u4v_t* ks = (const u4v_t*)(KC + ((size_t)bg * 256 + tl * 64 + skey) * 128 + scp * 16); const u4v_t* vs = (const u4v_t*)(VCT + ((size_t)bg * 128 + sd) * 256 + tl * 64 + vcp * 16);
                const u4v_t* ks2 = (const u4v_t*)(KC + ((size_t)bg * 256 + t2 * 64 + skey) * 128 + scp * 16); const u4v_t* vs2 = (const u4v_t*)(VCT + ((size_t)bg * 128 + sd) * 256 + t2 * 64 + vcp * 16);
                const u4v_t k0 = ks[0], k1 = ks[1], v0 = vs[0], v1 = vs[1], k2 = ks2[0], k3 = ks2[1], v2 = vs2[0], v3 = vs2[1];
                *(LASP u4v_t*)(ldsw + tl * 16384 + kwa) = k0; *(LASP u4v_t*)(ldsw + tl * 16384 + (kwa ^ 16u)) = k1; *(LASP u4v_t*)(ldsw + tl * 16384 + vwa) = v0; *(LASP u4v_t*)(ldsw + tl * 16384 + (vwa ^ 16u)) = v1;
                *(LASP u4v_t*)(ldsw + t2 * 16384 + kwa) = k2; *(LASP u4v_t*)(ldsw + t2 * 16384 + (kwa ^ 16u)) = k3; *(LASP u4v_t*)(ldsw + t2 * 16384 + vwa) = v2; *(LASP u4v_t*)(ldsw + t2 * 16384 + (vwa ^ 16u)) = v3; }
            for (int i = TIDX; i < 64 * 64; i += 512) impL[i] = 0;
            __syncthreads();
            const int cmax = t >= 31 ? (t - 31) >> 4 : -1;
            float m_run = -1.0e30f, l_run = 0.f;
            for (int tl = 0; tl < ntile; ++tl) {
                f32x16_t s0, s1;
                qk_tile_pipe(s0, s1, (unsigned)(uintptr_t)lds + (unsigned)(tl * 16384) + kra, xh, qf);
                float mx = NEGINF;
#pragma unroll
                for (int r = 0; r < 16; ++r) { const int c = tl * 64 + (r & 3) + 8 * (r >> 2) + 4 * hi; s0[r] = c <= cmax ? s0[r] * C2 : NEGINF; s1[r] = c + 32 <= cmax ? s1[r] * C2 : NEGINF; mx = fmaxf(mx, fmaxf(s0[r], s1[r])); }
                mx = fmaxf(mx, __shfl_xor(mx, 32));
                const float m_new = fmaxf(m_run, mx); float ps = 0.f;
#pragma unroll
                for (int r = 0; r < 16; ++r) ps += fast_exp2(s0[r] - m_new) + fast_exp2(s1[r] - m_new);
                l_run = l_run * fast_exp2(m_run - m_new) + ps; m_run = m_new;
            }
            l_run += __shfl_xor(l_run, 32);
            const float inv = l_run > 0.f ? 1.f / l_run : 0.f;
            f32x16_t O[4];
#pragma unroll
            for (int dt = 0; dt < 4; ++dt)
#pragma unroll
                for (int r = 0; r < 16; ++r) O[dt][r] = 0.f;
            LASP int* imrow = (LASP int*)(LASP unsigned char*)(smem + 131072) + (32 * half + qi) * 64;
            for (int tl = 0; tl < ntile; ++tl) {
                f32x16_t s0, s1;
                qk_tile_pipe(s0, s1, (unsigned)(uintptr_t)lds + (unsigned)(tl * 16384) + kra, xh, qf);
#pragma unroll
                for (int r = 0; r < 16; ++r) { const int c = tl * 64 + (r & 3) + 8 * (r >> 2) + 4 * hi;
                    s0[r] = c <= cmax ? fast_exp2(s0[r] * C2 - m_run) * inv : 0.f; s1[r] = c + 32 <= cmax ? fast_exp2(s1[r] * C2 - m_run) * inv : 0.f; }
#pragma unroll
                for (int sub = 0; sub < 2; ++sub)
#pragma unroll
                    for (int rq = 0; rq < 4; ++rq) { const f32x16_t& sv = sub ? s1 : s0; const int j = 16 * tl + 8 * sub + 2 * rq + hi;
                        const float hp = 0.5f * sv[4 * rq + 3]; const int ia = (int)((sv[4 * rq] + sv[4 * rq + 1] + sv[4 * rq + 2] + hp) * 67108864.f + 0.5f), ib = (int)(hp * 67108864.f + 0.5f);
                        (void)__hip_atomic_fetch_add(imrow + j, ia, __ATOMIC_RELAXED, __HIP_MEMORY_SCOPE_WORKGROUP); if (j < 63) (void)__hip_atomic_fetch_add(imrow + j + 1, ib, __ATOMIC_RELAXED, __HIP_MEMORY_SCOPE_WORKGROUP); }
                bf16x8_t pf[4];
#pragma unroll
                for (int s = 0; s < 4; ++s) { const f32x16_t& sv = (s < 2) ? s0 : s1; const int o = (s & 1) * 8;
                    u4v_t ww = {pg8::cvt_pk_bf16(sv[o + 0], sv[o + 1]), pg8::cvt_pk_bf16(sv[o + 2], sv[o + 3]), pg8::cvt_pk_bf16(sv[o + 4], sv[o + 5]), pg8::cvt_pk_bf16(sv[o + 6], sv[o + 7])}; pf[s] = *reinterpret_cast<bf16x8_t*>(&ww); }
                pv_tile_pipe(O, (unsigned)(uintptr_t)lds + (unsigned)(tl * 16384) + vra, yh, pf);
            }
            { float* ocrow = OC + ((size_t)b * SEQ + t) * 1024 + h * 128 + 4 * hi;
#pragma unroll
              for (int dt = 0; dt < 4; ++dt)
#pragma unroll
                  for (int rq = 0; rq < 4; ++rq) *(float4*)(ocrow + 32 * dt + 8 * rq) = make_float4(O[dt][4 * rq], O[dt][4 * rq + 1], O[dt][4 * rq + 2], O[dt][4 * rq + 3]); }
            __syncthreads();
            for (int qq = 0; qq < 8; ++qq) { const int q = wid * 8 + qq, tq = qb * 64 + q, jq = qb, j = lane; const int* row = impL + q * 64;
                const int im = row[j]; const bool forced = (j == 0) || (j == jq) || (j == jq - 1); const int v = forced ? 0x7fffffff : (j <= jq ? im : -1);
                int rank = 0;
#pragma unroll 16
                for (int jj = 0; jj < 64; ++jj) { const int o = __builtin_amdgcn_readlane(v, jj); rank += (o > v || (o == v && jj < j)) ? 1 : 0; }
                const unsigned long long msk = __ballot(rank < 16);
                if (lane == 0) SEL[(size_t)bg * SEQ + tq] = msk; }
            __syncthreads();
        }
    }
}

namespace pg8 {
struct EpiF32Plain {
    static constexpr bool BP16 = false; static constexpr bool PERM = false, AFTER_DRAIN = false;
    float* C;
    __device__ __forceinline__ void operator()(const f32x4 (&acc)[2][2][4][2], const Unit& u, int wr, int wc, int fr, int fq) const {
        float* base = C + (size_t)(u.i0 + wr * 64 + fr) * 256 + wc * 32 + 4 * fq;
#pragma unroll
        for (int ai = 0; ai < 2; ++ai)
#pragma unroll
            for (int m = 0; m < 4; ++m) { float* rowp = base + (size_t)(ai * HALF + m * 16) * 256;
#pragma unroll
                for (int bj = 0; bj < 2; ++bj)
#pragma unroll
                    for (int n = 0; n < 2; ++n) *(f32x4*)(rowp + bj * HALF + n * 16) = acc[ai][bj][m][n]; }
    }
};
struct Cmp1Order {
    int G, c; const char* Y; const char* W;
    __device__ __forceinline__ bool next(int i, Unit& u) const {
        const int L = i * G + c; if (L >= 64) return false;
        const int kv = L >> 5, bg = (L >> 2) & 7, ks = L & 3, b = bg >> 1, g = bg & 1;
        u.A = Y + ((size_t)b * SEQ * LDY + (size_t)ks * 8 * LDY + Y_KV + kv * 256 + g * 128) * 2;
        u.B = W + ((size_t)kv * 256 * 4096 + (size_t)ks * 1024) * 2; u.i0 = (ks * 16 + kv * 8 + bg) * 256; u.i1 = 0; return true;
    }
    __device__ __forceinline__ void a_ready(const Unit&) const {}
    __device__ __forceinline__ void done(const Unit&) const {}
};
}
DI void st_cmp1_mm(const Params& p, int l, unsigned char* smem, const int WV) {
    const int TIDX = opq_tid(WV), BIDX = opq_bid();
    pg8::Cmp1Order S; S.G = gridDim.x; S.c = BIDX; S.Y = (const char*)(p.ws + WS_Y); S.W = (const char*)wl_ptr(p, l, WL_CW1);
    pg8::EpiF32Plain E{(float*)(p.ws + WS_CP)};
    pg8::gemm_phase((PG8_LAS unsigned char*)smem, 1024, S, E, TIDX, (size_t)16 * LDY * 2, (size_t)LDY * 2, (size_t)4096 * 2);
}
DI void st_slots(const Params& p, int l, unsigned char* smem, const int WV) {
    const int TIDX = opq_tid(WV), BIDX = opq_bid();
    const int* TOPE = (const int*)(p.ws + WS_TOPE); const int* RANK = (const int*)(p.ws + WS_RANK); int* SLOT = (int*)(p.ws + WS_SLOT); int* TOKOF = (int*)(p.ws + WS_TOKOF);
    const unsigned* CNT = (const unsigned*)(p.ws + WS_CTL) + CW_CNT + l * 64;
    int* po = (int*)smem; pad_offsets(CNT, po, WV);
    for (int i = BIDX * 512 + TIDX; i < NT * 8; i += gridDim.x * 512) { const int slot = po[TOPE[i]] + RANK[i]; SLOT[i] = slot; TOKOF[slot] = i >> 3; }
    for (int e = BIDX; e < 64; e += gridDim.x) { const int a = po[e] + (int)CNT[e], b = po[e + 1]; for (int s = a + TIDX; s < b; s += 512) TOKOF[s] = 0; }
}

namespace pg8 {
struct RouterOrder {
    int G, c; const char* H; const char* HLO; const char* W;
    __device__ __forceinline__ bool next(int i, Unit& u) const {
        const int L = i * G + c; if (L >= 256) return false;
        const int kq = L & 3, pm = L >> 2;
        u.A = H + ((size_t)pm * 256 * DM + (size_t)kq * 512) * 2; u.B = W + (size_t)kq * 512 * 2; u.i0 = kq * NT + pm * 256; u.i1 = 0; return true;
    }
    __device__ __forceinline__ void a_ready(const Unit&) const {}
    __device__ __forceinline__ void done(const Unit&) const {}
};
}
DI void st_rlogit_mm(const Params& p, int l, unsigned char* smem, const int WV) {
    const int TIDX = opq_tid(WV), BIDX = opq_bid();
    pg8::RouterOrder S; S.G = gridDim.x; S.c = BIDX; S.H = (const char*)(p.ws + WS_H); S.HLO = (const char*)(p.ws + WS_HLO); S.W = (const char*)wl_ptr(p, l, WL_RTH);
    pg8::EpiF32Plain E{(float*)(p.ws + WS_LOGP)};
    pg8::gemm_phase((PG8_LAS unsigned char*)smem, 512, S, E, TIDX, (size_t)DM * 2, 256, (size_t)DM * 2);
}
DI void st_route(const Params& p, int l, unsigned char* smem, const int WV, const int cnt_l_off = 0) {
    const int TIDX = opq_tid(WV), BIDX = opq_bid();
    const int wave = __builtin_amdgcn_readfirstlane(TIDX >> 6), lane = TIDX & 63;
    const float* LP = (const float*)(p.ws + WS_LOGP);
    int* TOPE = (int*)(p.ws + WS_TOPE); float* TOPW = (float*)(p.ws + WS_TOPW); int* RANK = (int*)(p.ws + WS_RANK); unsigned* CNT = (unsigned*)(p.ws + WS_CTL) + CW_CNT + (l + cnt_l_off) * 64;
    unsigned* lcnt = (unsigned*)smem; unsigned* lbase = lcnt + 64;
    if (TIDX < 64) lcnt[TIDX] = 0u;
    __syncthreads();
    const float rbias = p.router_bias[l * 64 + lane];
    float lpc[8];
    { const int t0 = BIDX * 8 + wave;
#pragma unroll
      for (int q = 0; q < 4; ++q) { lpc[2 * q] = t0 < NT ? LP[(size_t)(q * NT + t0) * 256 + lane] : 0.f; lpc[2 * q + 1] = t0 < NT ? LP[(size_t)(q * NT + t0) * 256 + 64 + lane] : 0.f; } }
    for (int t = BIDX * 8 + wave; t < NT; t += gridDim.x * 8) {
        float lpn[8]; { const int tn = t + gridDim.x * 8; const int tc = tn < NT ? tn : t;
#pragma unroll
          for (int q = 0; q < 4; ++q) { lpn[2 * q] = LP[(size_t)(q * NT + tc) * 256 + lane]; lpn[2 * q + 1] = LP[(size_t)(q * NT + tc) * 256 + 64 + lane]; } }
        float logit = 0.f;
#pragma unroll
        for (int q = 0; q < 4; ++q) logit += lpc[2 * q] + lpc[2 * q + 1];
#pragma unroll
        for (int q = 0; q < 8; ++q) lpc[q] = lpn[q];
        const float score = sigmoid_f(logit); const float biased = score + rbias;
        int rk = 0; const int gb = lane & ~7;
#pragma unroll
        for (int j = 0; j < 8; ++j) { const float o = __shfl(biased, gb + j); rk += (o > biased || (o == biased && (gb + j) < lane)) ? 1 : 0; }
        float gsum = rk < 2 ? biased : 0.f; gsum += __shfl_xor(gsum, 1); gsum += __shfl_xor(gsum, 2); gsum += __shfl_xor(gsum, 4);
        int grk = 0; const int myg = lane >> 3;
#pragma unroll
        for (int gg = 0; gg < 8; ++gg) { const float o = __shfl(gsum, gg * 8); grk += (o > gsum || (o == gsum && gg < myg)) ? 1 : 0; }
        const float masked = grk < 4 ? biased : -__builtin_inff();
        int erk = 0;
#pragma unroll 16
        for (int j = 0; j < 64; ++j) { const float o = __uint_as_float(__builtin_amdgcn_readlane(__float_as_uint(masked), j)); erk += (o > masked || (o == masked && j < lane)) ? 1 : 0; }
        const bool selx = erk < 8; const float wsum = wave_sum(selx ? score : 0.f);
        if (selx) { const unsigned rr = atomicAdd(lcnt + lane, 1u);
            TOPE[(size_t)t * 8 + erk] = lane; TOPW[(size_t)t * 8 + erk] = 2.5f * score / wsum; RANK[(size_t)t * 8 + erk] = (int)rr; }
    }
    __syncthreads();
    if (TIDX < 64) lbase[TIDX] = lcnt[TIDX] ? atomicAdd(CNT + TIDX, lcnt[TIDX]) : 0u;
    asm volatile("s_waitcnt vmcnt(0)" ::: "memory");
    __syncthreads();
    for (int t = BIDX * 8 + wave; t < NT; t += gridDim.x * 8)
        if (lane < 8) { const int e = TOPE[(size_t)t * 8 + lane]; const int rk = RANK[(size_t)t * 8 + lane] + (int)lbase[e]; RANK[(size_t)t * 8 + lane] = rk;
            ((int*)(p.ws + WS_XS))[(size_t)e * NT + rk] = t; }
}

namespace pg8 {
struct GateOrder {
    int G, c; const char* H; const char* W;
    __device__ __forceinline__ bool next(int i, Unit& u) const {
        const int cc = G >= 192 ? (c >= 64 ? c - 64 : c + G - 64) : c;
        const int L = i * G + cc; if (L >= 128) return false;
        const int kh = L & 1, pm = L >> 1;
        u.A = H + ((size_t)pm * 256 * DM + (size_t)kh * 1024) * 2; u.B = W + ((size_t)6144 * DM + (size_t)kh * 1024) * 2; u.i0 = kh * NT + pm * 256; u.i1 = 0; return true;
    }
    __device__ __forceinline__ void a_ready(const Unit&) const {}
    __device__ __forceinline__ void done(const Unit&) const {}
};
}
DI void st_gate_mm(const Params& p, int l, unsigned char* smem, const int WV) {
    const int TIDX = opq_tid(WV), BIDX = opq_bid();
    pg8::GateOrder S; S.G = gridDim.x; S.c = BIDX; S.H = (const char*)(p.ws + WS_H); S.W = (const char*)wl_ptr(p, l, WL_WIN);
    pg8::EpiF32Plain E{(float*)(p.ws + WS_GATEP)};
    pg8::gemm_phase((PG8_LAS unsigned char*)smem, 1024, S, E, TIDX, (size_t)DM * 2, 256, (size_t)DM * 2);
}


#define XB_TMO      128
#define XB_XCNT(j)  (256  + 64 * (j))
#define XB_XSUB(j)  (1280 + 64 * (j))
#define XB_XGEN(j)  (2304 + 64 * (j))
#define XB_TOP      3328
#define XB_TOPGEN   3392
#define XCD_BAR_WORDS 3456
#define XB_SPIN_CAP (1u << 18)
#define LAS __attribute__((address_space(3)))

__device__ __forceinline__ unsigned xb_ld(unsigned* p)              { return __hip_atomic_load(p, __ATOMIC_RELAXED, __HIP_MEMORY_SCOPE_AGENT); }
__device__ __forceinline__ unsigned xb_add(unsigned* p, unsigned v) { return __hip_atomic_fetch_add(p, v, __ATOMIC_RELAXED, __HIP_MEMORY_SCOPE_AGENT); }
__device__ __forceinline__ unsigned xb_xcc_id() { return (unsigned)__builtin_amdgcn_s_getreg((3 << 11) | 20) & 0xFu; }
#define XB_SPIN(cond, bar) do { unsigned _sp = 0; while (cond) { __builtin_amdgcn_s_sleep(1); \
    if ((++_sp & 255u) == 0u) { if (xb_ld(&(bar)[XB_TMO])) break; if (_sp > XB_SPIN_CAP) { atomicAdd(&(bar)[XB_TMO], 1u); break; } } } } while (0)

struct XcdBarrier {
    bool t0;
    unsigned* bar; unsigned x;
    volatile LAS unsigned* st;
};

__device__ __forceinline__ XcdBarrier xcd_barrier_post(unsigned* bar, volatile LAS unsigned* st) {
    XcdBarrier b; b.bar = bar; b.x = xb_xcc_id(); b.st = st;
    if (threadIdx.x == 0) (void)xb_add(&bar[XB_XCNT(b.x)], 1u);
    return b;
}
__device__ __forceinline__ void xcd_barrier_complete(unsigned* bar, unsigned x, unsigned& nloc, unsigned& nx) {
    const unsigned G = gridDim.x * gridDim.y * gridDim.z;
    unsigned sum, cnt, mine, sp = 0u;
    for (;;) {
        sum = 0u; cnt = 0u; mine = 0u;
#pragma unroll
        for (unsigned j = 0; j < 16; ++j) { const unsigned c = xb_ld(&bar[XB_XCNT(j)]); sum += c; cnt += (c > 0u) ? 1u : 0u; mine = (j == x) ? c : mine; }
        if (sum == G) break;
        __builtin_amdgcn_s_sleep(1);
        if ((++sp & 255u) == 0u) { if (xb_ld(&bar[XB_TMO])) break; if (sp > XB_SPIN_CAP) { atomicAdd(&bar[XB_TMO], 1u); break; } }
    }
    nloc = mine > 0u ? mine : 1u; nx = cnt > 0u ? cnt : 1u;
}

__device__ __forceinline__ void xcd_barrier(const XcdBarrier& b) {
    asm volatile("s_waitcnt vmcnt(0)" ::: "memory");
    __syncthreads();
    if (b.t0) {
        unsigned* bar = b.bar;
        __builtin_amdgcn_s_waitcnt(0);
        unsigned nloc = b.st[0], nx = b.st[1];
        if (nloc == 0u) { xcd_barrier_complete(bar, b.x, nloc, nx); b.st[0] = nloc; b.st[1] = nx; }
        const unsigned old = xb_add(&bar[XB_XSUB(b.x)], 1u);
        const unsigned gen = old / nloc;
        if (old + 1u == (gen + 1u) * nloc) {
            __builtin_amdgcn_fence(__ATOMIC_RELEASE, "agent");
            asm volatile("s_waitcnt vmcnt(0)" ::: "memory");
            const unsigned og = xb_add(&bar[XB_TOP], 1u);
            const unsigned tg = og / nx;
            if (og + 1u == (tg + 1u) * nx) xb_add(&bar[XB_TOPGEN], 1u);
            else XB_SPIN(xb_ld(&bar[XB_TOPGEN]) == tg, bar);
            __builtin_amdgcn_fence(__ATOMIC_ACQUIRE, "agent");
            xb_add(&bar[XB_XGEN(b.x)], 1u);
            asm volatile("s_waitcnt vmcnt(0)" ::: "memory");
        } else {
            XB_SPIN(xb_ld(&bar[XB_XGEN(b.x)]) == gen, bar);
            __builtin_amdgcn_fence(__ATOMIC_ACQUIRE, "agent");
            asm volatile("s_waitcnt vmcnt(0)" ::: "memory");
        }
    }
    __syncthreads();
}


DI void launder(Params& q, int& l) {
    long z = 0; asm volatile("" : "+s"(z));
#define L_(f) q.f = (decltype(q.f))((const char*)q.f + z)
    L_(x); L_(c); L_(pos); L_(ada_w); L_(ada_b); L_(norm1_g); L_(norm2_g); L_(w_in); L_(conv_w); L_(conv_g); L_(cmp_pe); L_(cmp_w1); L_(cmp_w2); L_(nsa_g); L_(ret_g); L_(w_out);
    L_(router_w); L_(router_bias); L_(exp_w_gu); L_(exp_w_down); L_(shared_w_gu); L_(shared_w_down); L_(final_g);
#undef L_
    q.out = (float*)((char*)q.out + z); q.ws = q.ws + z;
    asm volatile("" : "+s"(l));
}
constexpr int CW_BAR = 16384;
constexpr int SMEM_MEGA = 152 * 1024;
__global__ void __launch_bounds__(512, 2) k_mega(Params p) {
    extern __shared__ __attribute__((aligned(16))) unsigned char smem[];
    volatile LAS unsigned* bst = (volatile LAS unsigned*)(smem + LDS_BST);
    const int WV = __builtin_amdgcn_readfirstlane(threadIdx.x >> 6);
    if (threadIdx.x < 4) bst[threadIdx.x] = 0u;
    __syncthreads();
    (void)xcd_barrier_post((unsigned*)(p.ws + WS_CTL) + CW_BAR, bst);
#define GRID_BAR() do { Params q = p; int l_ = 0; launder(q, l_); XcdBarrier b_; b_.t0 = (opq_tid(WV) == 0); b_.bar = (unsigned*)(q.ws + WS_CTL) + CW_BAR; b_.x = xb_xcc_id(); b_.st = bst; xcd_barrier(b_); if (MK_PROBE == 18) xcd_barrier(b_); } while (0)
#define STG(call) do { Params q = p; launder(q, l); call; } while (0)
#define REP(n, call) do { if (MK_PROBE == (n)) { STG(call); __syncthreads(); } } while (0)
    { int l = 0; REP(1, st_convert(q, smem, WV)); STG(st_convert(q, smem, WV)); __syncthreads(); REP(17, st_mod(q, smem, WV)); STG(st_mod(q, smem, WV)); GRID_BAR(); REP(17, st_norm(q, 0, q.x, 0, smem, WV)); STG(st_norm(q, 0, q.x, 0, smem, WV)); GRID_BAR(); }
#pragma clang loop unroll(disable)
    for (int l0 = 0; l0 < NL; ++l0) {
        int l = l0;
        REP(8, st_inproj_mm(q, l, smem, WV)); STG(st_inproj_mm(q, l, smem, WV)); GRID_BAR();
        REP(20, st_post(q, l, smem, WV)); REP(20, st_post(q, l, smem, WV, -1.f)); STG(st_post(q, l, smem, WV)); __syncthreads(); REP(15, st_vt(q, l, smem, WV)); STG(st_vt(q, l, smem, WV)); GRID_BAR();
        REP(2, st_cmp1_mm(q, l, smem, WV)); STG(st_cmp1_mm(q, l, smem, WV)); STG(st_gate_mm(q, l, smem, WV)); __syncthreads(); REP(16, st_kvchunk_mm(q, l, smem, WV)); STG(st_kvchunk_mm(q, l, smem, WV)); GRID_BAR();
        REP(16, st_cmp2(q, l, smem, WV)); REP(16, st_scan(q, l, WV)); STG(st_cmp2(q, l, smem, WV)); STG(st_scan(q, l, WV)); GRID_BAR();
        REP(12, st_cmpattn_mm(q, l, smem, WV)); REP(24, st_retout_mm(q, l, smem, WV)); STG(st_cmpattn_mm(q, l, smem, WV)); __syncthreads(); STG(st_retout_mm(q, l, smem, WV)); GRID_BAR();
        REP(14, st_attn_mm(q, l, smem, WV)); STG(st_attn_mm(q, l, smem, WV)); GRID_BAR();
        REP(13, st_outproj_mm(q, l, q.x, l == 0 ? (const bf16_t*)nullptr : (const bf16_t*)(q.ws + WS_X2), smem, WV)); STG(st_outproj_mm(q, l, q.x, l == 0 ? (const bf16_t*)nullptr : (const bf16_t*)(q.ws + WS_X2), smem, WV)); GRID_BAR();
        REP(17, st_norm(q, l, (const float*)(q.ws + WS_X1), 1, smem, WV)); STG(st_norm(q, l, (const float*)(q.ws + WS_X1), 1, smem, WV)); GRID_BAR();
        REP(23, st_rlogit_mm(q, l, smem, WV)); STG(st_rlogit_mm(q, l, smem, WV)); GRID_BAR();
        REP(25, st_route(q, l, smem, WV, 2)); STG(st_route(q, l, smem, WV)); GRID_BAR();
        REP(9, st_gemm1_mm(q, l, smem, WV)); STG(st_gemm1_mm(q, l, smem, WV)); GRID_BAR();
        REP(10, st_gemm2_mm(q, l, smem, WV)); STG(st_gemm2_mm(q, l, smem, WV)); GRID_BAR();
        REP(7, st_combine(q, l, smem, WV)); REP(11, st_combine(q, l, smem, WV)); STG(st_combine(q, l, smem, WV)); if (l0 + 1 < NL) GRID_BAR();
    }
#undef STG
#undef GRID_BAR
}
extern "C" void kernel_launch(void* const* d_in, const int* in_sizes, int n_in, void* d_out, int out_size, void* d_ws, size_t ws_size, hipStream_t stream) {
    if (n_in != 23 || ws_size < WS_END) { fprintf(stderr, "kernel_launch: unexpected n_in %d or ws_size %zu < %zu\n", n_in, ws_size, (size_t)WS_END); return; }
    Params p; memset(&p, 0, sizeof(p));
    p.x = (const float*)d_in[0]; p.c = (const float*)d_in[1]; p.pos = (const int*)d_in[2];
    p.ada_w = (const float*)d_in[3]; p.ada_b = (const float*)d_in[4]; p.norm1_g = (const float*)d_in[5]; p.norm2_g = (const float*)d_in[6]; p.w_in = (const float*)d_in[7];
    p.conv_w = (const float*)d_in[8]; p.conv_g = (const float*)d_in[9]; p.cmp_pe = (const float*)d_in[10]; p.cmp_w1 = (const float*)d_in[11]; p.cmp_w2 = (const float*)d_in[12];
    p.nsa_g = (const float*)d_in[13]; p.ret_g = (const float*)d_in[14]; p.w_out = (const float*)d_in[15]; p.router_w = (const float*)d_in[16]; p.router_bias = (const float*)d_in[17];
    p.exp_w_gu = (const float*)d_in[18]; p.exp_w_down = (const float*)d_in[19]; p.shared_w_gu = (const float*)d_in[20]; p.shared_w_down = (const float*)d_in[21]; p.final_g = (const float*)d_in[22];
    p.out = (float*)d_out; p.ws = (unsigned char*)d_ws;
    (void)hipMemsetAsync((char*)d_ws + WS_CTL, 0, 1 * MiB, stream);
    static int grid = 0;
    if (!grid) {
        int dev = 0, cus = 0, per_cu = 0;
        (void)hipGetDevice(&dev); (void)hipDeviceGetAttribute(&cus, hipDeviceAttributeMultiprocessorCount, dev);
        (void)hipFuncSetAttribute((const void*)k_mega, hipFuncAttributeMaxDynamicSharedMemorySize, SMEM_MEGA);
        if (hipOccupancyMaxActiveBlocksPerMultiprocessor(&per_cu, (const void*)k_mega, 512, SMEM_MEGA) != hipSuccess || per_cu < 1) { fprintf(stderr, "kernel_launch: occupancy query says %d\n", per_cu); (void)hipGetLastError(); }
        grid = cus > 0 ? cus : 256;
    }
    hipLaunchKernelGGL(k_mega, dim3(grid), dim3(512), SMEM_MEGA, stream, p);
}
```

```cpp
#include <hip/hip_runtime.h>
#include <stdint.h>
#include <stdio.h>
#include <string.h>
#ifndef MK_PROBE
#define MK_PROBE 0
#endif

typedef unsigned short bf16_t;
#define DI __device__ __forceinline__
#define LDS_WAIT() asm volatile("s_waitcnt lgkmcnt(0)" ::: "memory")

constexpr int NB = 4, SEQ = 4096, DM = 2048, NT = NB * SEQ, NL = 2;
constexpr int HD = 128;
constexpr int D_IN = 6168, LDY = 6400;
constexpr int Y_CB = 0, Y_CC = 512, Y_CU = 1024, Y_QN = 1536, Y_KV = 2560, Y_QR = 4096, Y_KR = 4608, Y_VR = 5120, Y_GR = 5632, Y_GATE = 6144;
constexpr int NEXP = 64, TOPK = 8, DEXP = 512;
constexpr int NSLOT = 576 * 256;
constexpr int NROWS_E = NSLOT + NT;
constexpr float EPS = 1e-6f;
constexpr int NCMP = 255;

constexpr size_t MiB = 1ull << 20;
constexpr size_t WS_CTL = 0;
constexpr size_t WS_MOD = 1 * MiB;
constexpr size_t WS_CMPB = WS_MOD + 512 * 1024;
constexpr size_t WS_W = 2 * MiB;
constexpr size_t WL_WIN = 0;
constexpr size_t WL_WOUT = WL_WIN + (size_t)LDY * DM * 2;
constexpr size_t WL_CW1 = WL_WOUT + (size_t)DM * DM * 2;
constexpr size_t WL_CW2 = WL_CW1 + (size_t)2 * 256 * 4096 * 2;
constexpr size_t WL_RTH = WL_CW2 + (size_t)2 * 128 * 256 * 2;
constexpr size_t WL_RTL = WL_RTH + (size_t)64 * DM * 2;
constexpr size_t WL_RTZ = WL_RTL + (size_t)64 * DM * 2;
constexpr size_t WL_EGU = WL_RTZ + (size_t)128 * DM * 2;
constexpr size_t WL_EDN = WL_EGU + (size_t)65 * 1024 * DM * 2;
constexpr size_t WL_END = WL_EDN + (size_t)65 * DM * 512 * 2;
constexpr size_t WL_STRIDE = 429 * MiB;
static_assert(WL_END <= WL_STRIDE, "layer weights");
constexpr size_t WS_H = WS_W + NL * WL_STRIDE;
constexpr size_t WS_HLO = WS_H + (size_t)NT * DM * 2;
constexpr size_t WS_Y = WS_HLO + (size_t)NT * DM * 2;
constexpr size_t WS_YMIX = WS_Y + (size_t)NT * LDY * 2;
constexpr size_t WS_X1 = WS_YMIX + (size_t)NT * DM * 2;
constexpr size_t WS_X2 = WS_X1 + (size_t)NT * DM * 4;
constexpr size_t WS_OCMP = WS_X2 + (size_t)NT * DM * 4;
constexpr size_t WS_SEL = WS_OCMP + (size_t)NT * 1024 * 4;
constexpr size_t WS_HID = WS_SEL + (size_t)NB * 2 * SEQ * 8;
constexpr size_t WS_KC = WS_HID + (size_t)2 * 8 * 256 * 256 * 2;
constexpr size_t WS_VC = WS_KC + (size_t)8 * 256 * 128 * 2;
constexpr size_t WS_KVC = WS_VC + (size_t)8 * 256 * 128 * 2;
constexpr size_t WS_STATE = WS_KVC + (size_t)16 * 32 * 16384 * 4;
constexpr size_t WS_TOPE = WS_STATE + (size_t)16 * 32 * 16384 * 4;
constexpr size_t WS_TOPW = WS_TOPE + (size_t)NT * 8 * 4;
constexpr size_t WS_RANK = WS_TOPW + (size_t)NT * 8 * 4;
constexpr size_t WS_SLOT = WS_RANK + (size_t)NT * 8 * 4;
constexpr size_t WS_XS = WS_SLOT + (size_t)NT * 8 * 4;
constexpr size_t WS_GU = WS_XS + (size_t)NSLOT * DM * 2;
constexpr size_t WS_ACT = WS_GU + (size_t)NROWS_E * 1024 * 2;
constexpr size_t WS_YS = WS_ACT + (size_t)NROWS_E * 512 * 2;
constexpr size_t WS_VT = WS_YS + (size_t)NROWS_E * DM * 2;
constexpr size_t WS_STATEB = WS_VT + (size_t)NB * 2 * 2 * 128 * SEQ * 2;
constexpr size_t WS_PART = WS_STATEB + (size_t)16 * 32 * 16384 * 2;
constexpr size_t WS_TOKOF = WS_PART + (size_t)NT * 1024 * 4;
constexpr size_t WS_LOGP = WS_TOKOF + (size_t)NSLOT * 4;
constexpr size_t WS_CP = WS_LOGP + (size_t)4 * NT * 256 * 4;
constexpr size_t WS_GATEP = WS_CP + (size_t)4 * 16 * 256 * 256 * 4;
constexpr size_t WS_END = WS_GATEP + (size_t)2 * NT * 256 * 4;
constexpr int CW_CNT = 8192;

struct Params {
    const float *x, *c; const int* pos;
    const float *ada_w, *ada_b, *norm1_g, *norm2_g, *w_in, *conv_w, *conv_g, *cmp_pe, *cmp_w1, *cmp_w2, *nsa_g, *ret_g, *w_out,
                *router_w, *router_bias, *exp_w_gu, *exp_w_down, *shared_w_gu, *shared_w_down, *final_g;
    float* out; unsigned char* ws;
};

DI float bf2f(bf16_t b) { return __uint_as_float(((unsigned)b) << 16); }
DI bf16_t f2bf(float f) { unsigned u = __float_as_uint(f); u += 0x7fffu + ((u >> 16) & 1u); return (bf16_t)(u >> 16); }
DI unsigned pk2(float lo, float hi) { return (unsigned)f2bf(lo) | ((unsigned)f2bf(hi) << 16); }
DI float wave_sum(float v) {
#pragma unroll
    for (int o = 1; o < 64; o <<= 1) v += __shfl_xor(v, o);
    return v;
}
DI float wave_max(float v) {
#pragma unroll
    for (int o = 1; o < 64; o <<= 1) v = fmaxf(v, __shfl_xor(v, o));
    return v;
}
DI int kperm16(int k) { return (k & ~12) | ((k & 4) << 1) | ((k & 8) >> 1); }
DI float silu_f(float v) { return v / (1.f + __expf(-v)); }
DI float sigmoid_f(float v) { return 1.f / (1.f + __expf(-v)); }
DI float gelu_tanh_f(float v) { const float u = 0.7978845608028654f * (v + 0.044715f * v * v * v); return 0.5f * v * (1.f + tanhf(u)); }
DI bf16_t* wl_ptr(const Params& p, int l, size_t off) { return (bf16_t*)(p.ws + WS_W + (size_t)l * WL_STRIDE + off); }
DI float* mod_ptr(const Params& p, int l, int b, int chunk) { return (float*)(p.ws + WS_MOD) + ((size_t)(l * NB + b) * 6 + chunk) * DM; }
DI float ret_loggamma(int h) { return h == 0 ? -0.0317486983145803f : (h == 1 ? -0.015748356968139168f : (h == 2 ? -0.007843177461025893f : -0.003913899321136329f)); }
DI float ret_chunkdecay(int h) { return h == 0 ? 0.01718302357081791f : (h == 1 ? 0.13321516287964844f : (h == 2 ? 0.3664377159220373f : 0.6059370882290803f)); }

DI int opq_tid(const int WV) { unsigned z = 0u; asm volatile("" : "+v"(z)); int t = (WV << 6) | (int)__builtin_amdgcn_mbcnt_hi(~0u, __builtin_amdgcn_mbcnt_lo(~0u, z)); asm volatile("" : "+v"(t)); return t; }
DI int opq_bid() { int b = blockIdx.x; asm volatile("" : "+s"(b)); return b; }
DI int maprow(int kind, int n) {
    if (kind == 1) return n < 4096 ? n : (n < 4120 ? n + 2048 : n - 24);
    if (kind == 2) { if (n < 512) return (n >> 7) * 256 + (n & 127); const int j = n - 512; return (j >> 7) * 256 + 128 + (j & 127); }
    return n;
}
DI void tr_item(const float* __restrict__ W, int ldw, int ncols, int Kd, bf16_t* WT, int k0, int n0, int kind, float* scr, int lane) {
    const int n4 = (lane & 15) * 4, kr = lane >> 4; const bool inb = (n0 + n4) < ncols;
    float4 v[16];
#pragma unroll
    for (int i = 0; i < 16; ++i) { typedef float f4v_t __attribute__((ext_vector_type(4))); if (inb) { const f4v_t t_ = __builtin_nontemporal_load((const f4v_t*)(W + (size_t)(k0 + 4 * i + kr) * ldw + n0 + n4)); v[i] = make_float4(t_.x, t_.y, t_.z, t_.w); } else v[i] = make_float4(0.f, 0.f, 0.f, 0.f); }
#pragma unroll
    for (int i = 0; i < 16; ++i) { float* s = scr + (4 * i + kr) * 65 + n4; s[0] = v[i].x; s[1] = v[i].y; s[2] = v[i].z; s[3] = v[i].w; }
    LDS_WAIT();
    const int c = lane & 7;
#pragma unroll
    for (int j = 0; j < 8; ++j) { const int nn = (lane >> 3) + 8 * j, n = n0 + nn;
        if (n < ncols) { const float* s = scr + (8 * c) * 65 + nn;
            uint4 o; o.x = pk2(s[0 * 65], s[1 * 65]); o.y = pk2(s[2 * 65], s[3 * 65]); o.z = pk2(s[4 * 65], s[5 * 65]); o.w = pk2(s[6 * 65], s[7 * 65]);
            *(uint4*)(WT + (size_t)maprow(kind, n) * Kd + k0 + 8 * c) = o; } }
    LDS_WAIT();
}
DI void tr_job(const float* W, int ldw, int ncols, int Kd, bf16_t* WT, int kind, int r, float* scr, int lane) {
    const int nblk = (ncols + 63) / 64; const int kb = r / nblk, nb = r % nblk;
    tr_item(W, ldw, ncols, Kd, WT, kb * 64, nb * 64, kind, scr, lane);
}
DI void st_convert(const Params& p, unsigned char* smem, const int WV) {
    const int TIDX = opq_tid(WV); const int BIDX = opq_bid(); (void)TIDX; (void)BIDX;
    const int tid = TIDX, lane = tid & 63, wave = tid >> 6;
    float* scr = (float*)smem + wave * (64 * 65);
    const int gw = BIDX * 8 + wave, NGW = gridDim.x * 8;
    constexpr int I_WIN = 32 * 97, I_WOUT = 32 * 32, I_C1 = 64 * 4, I_C2 = 4 * 2, I_GU = 32 * 16, I_DN = 8 * 32;
    constexpr int PER_L = I_WIN + I_WOUT + 2 * I_C1 + 2 * I_C2 + 65 * I_GU + 65 * I_DN;
    for (int it = gw; it < NL * PER_L; it += NGW) {
        const int l = it / PER_L; int r = it % PER_L;
        if (r < I_WIN) { tr_job(p.w_in + (size_t)l * DM * D_IN, D_IN, D_IN, DM, wl_ptr(p, l, WL_WIN), 1, r, scr, lane); continue; } r -= I_WIN;
        if (r < I_WOUT) { tr_job(p.w_out + (size_t)l * DM * DM, DM, DM, DM, wl_ptr(p, l, WL_WOUT), 0, r, scr, lane); continue; } r -= I_WOUT;
        if (r < 2 * I_C1) { const int kv = r / I_C1; tr_job(p.cmp_w1 + (size_t)(l * 2 + kv) * 4096 * 256, 256, 256, 4096, wl_ptr(p, l, WL_CW1) + (size_t)kv * 256 * 4096, 0, r % I_C1, scr, lane); continue; } r -= 2 * I_C1;
        if (r < 2 * I_C2) { const int kv = r / I_C2; tr_job(p.cmp_w2 + (size_t)(l * 2 + kv) * 256 * 128, 128, 128, 256, wl_ptr(p, l, WL_CW2) + (size_t)kv * 128 * 256, 0, r % I_C2, scr, lane); continue; } r -= 2 * I_C2;
        if (r < 65 * I_GU) { const int e = r / I_GU; const float* src = e < 64 ? p.exp_w_gu + (size_t)(l * 64 + e) * DM * 1024 : p.shared_w_gu + (size_t)l * DM * 1024;
            tr_job(src, 1024, 1024, DM, wl_ptr(p, l, WL_EGU) + (size_t)e * 1024 * DM, 2, r % I_GU, scr, lane); continue; } r -= 65 * I_GU;
        { const int e = r / I_DN; const float* src = e < 64 ? p.exp_w_down + (size_t)(l * 64 + e) * 512 * DM : p.shared_w_down + (size_t)l * 512 * DM;
            tr_job(src, DM, DM, 512, wl_ptr(p, l, WL_EDN) + (size_t)e * DM * 512, 0, r % I_DN, scr, lane); }
    }
    const size_t gt = (size_t)BIDX * 512 + tid, NGT = (size_t)gridDim.x * 512;
    for (int l = 0; l < NL; ++l) {
        bf16_t* wt = wl_ptr(p, l, WL_WIN);
        for (size_t i = gt; i < (size_t)(LDY - D_IN) * DM / 8; i += NGT) ((uint4*)(wt + (size_t)D_IN * DM))[i] = make_uint4(0, 0, 0, 0);
        { uint4* rz = (uint4*)wl_ptr(p, l, WL_RTZ); for (size_t i = gt; i < (size_t)128 * DM / 8; i += NGT) rz[i] = make_uint4(0, 0, 0, 0); }
        bf16_t* rh = wl_ptr(p, l, WL_RTH); bf16_t* rl = wl_ptr(p, l, WL_RTL);
        for (size_t i = gt; i < (size_t)64 * DM; i += NGT) { const int e = (int)(i / DM), k = (int)(i % DM); const float w = p.router_w[((size_t)l * DM + k) * 64 + e];
            const bf16_t h = f2bf(w); rh[i] = h; rl[i] = f2bf(w - bf2f(h)); }
    }
    { const int ub = (int)gridDim.x - 1 - BIDX;
      if (ub < 64) {
        const int l = ub >> 5, kv = (ub >> 4) & 1, jb = (ub >> 2) & 3, ic = ub & 3;
        const float* pe = p.cmp_pe + (size_t)(l * 2 + kv) * 4096; const float* w1 = p.cmp_w1 + (size_t)(l * 2 + kv) * 4096 * 256;
        float acc = 0.f; const int j = jb * 64 + lane; const int i0 = ic * 1024 + wave * 128;
#pragma unroll 16
        for (int i = i0; i < i0 + 128; ++i) acc += pe[i] * w1[(size_t)i * 256 + j];
        __syncthreads();
        float* red = (float*)smem; red[wave * 64 + lane] = acc; __syncthreads();
        if (wave == 0) { float s = 0.f; for (int w = 0; w < 8; ++w) s += red[w * 64 + lane]; ((float*)(p.ws + WS_CMPB))[ic * 1024 + (l * 2 + kv) * 256 + j] = s; }
      } }
}

DI void st_mod(const Params& p, unsigned char* smem, const int WV) {
    const int TIDX = opq_tid(WV); const int BIDX = opq_bid(); (void)TIDX; (void)BIDX;
    const int tid = TIDX, lane = tid & 63, wave = tid >> 6;
    float* ca = (float*)smem;
    float* red = ca + 4 * DM;
#pragma unroll
    for (int it = 0; it < 4 * DM / 512; ++it) { const int i = tid + it * 512; ca[i] = silu_f(p.c[i]); }
    __syncthreads();
    for (int u = BIDX; u < NL * 96; u += gridDim.x) {
        const int l = u / 96, cb = u % 96; const int col = cb * 128 + (lane & 31) * 4;
        const float* W = p.ada_w + (size_t)l * DM * 12288;
        float acc[4][4] = {};
#pragma unroll 8
        for (int i = 0; i < 128; ++i) { const int k = 2 * (wave + 8 * i) + (lane >> 5);
            typedef float f4v_t __attribute__((ext_vector_type(4))); const f4v_t w = __builtin_nontemporal_load((const f4v_t*)(W + (size_t)k * 12288 + col));
#pragma unroll
            for (int b = 0; b < 4; ++b) { const float cv = ca[b * DM + k]; acc[b][0] += cv * w.x; acc[b][1] += cv * w.y; acc[b][2] += cv * w.z; acc[b][3] += cv * w.w; } }
#pragma unroll
        for (int b = 0; b < 4; ++b)
#pragma unroll
            for (int j = 0; j < 4; ++j) acc[b][j] += __shfl_xor(acc[b][j], 32);
        __syncthreads();
        if (lane < 32) {
#pragma unroll
            for (int b = 0; b < 4; ++b)
#pragma unroll
                for (int j = 0; j < 4; ++j) red[(wave * 4 + b) * 128 + lane * 4 + j] = acc[b][j]; }
        __syncthreads();
        { const int b = tid >> 7, cc = tid & 127; float s = 0.f;
            for (int w = 0; w < 8; ++w) s += red[(w * 4 + b) * 128 + cc];
            const int gcol = cb * 128 + cc;
            ((float*)(p.ws + WS_MOD))[(size_t)(l * NB + b) * 12288 + gcol] = s + p.ada_b[(size_t)l * 12288 + gcol]; }
    }
}

typedef float f4v_t __attribute__((ext_vector_type(4)));
#define LDSF __attribute__((address_space(3)))
DI void norm_row_store(float4 (&v)[8], int lane, const LDSF float* gs, const LDSF float* sh, bf16_t* hrow, bf16_t* lorow) {
    float ss = 0.f;
#pragma unroll
    for (int j = 0; j < 8; ++j) ss += v[j].x * v[j].x + v[j].y * v[j].y + v[j].z * v[j].z + v[j].w * v[j].w;
    const float r = rsqrtf(wave_sum(ss) * (1.f / DM) + EPS);
#pragma unroll
    for (int j = 0; j < 8; ++j) { const unsigned e = ((unsigned)j * 64u + (unsigned)lane) * 4u;
        const f4v_t gg = *(const LDSF f4v_t*)(gs + e), s0 = *(const LDSF f4v_t*)(sh + e);
        const float h0 = v[j].x * r * gg.x + s0.x, h1 = v[j].y * r * gg.y + s0.y, h2 = v[j].z * r * gg.z + s0.z, h3 = v[j].w * r * gg.w + s0.w;
        const bf16_t b0 = f2bf(h0), b1 = f2bf(h1), b2 = f2bf(h2), b3 = f2bf(h3);
        uint2 o; o.x = (unsigned)b0 | ((unsigned)b1 << 16); o.y = (unsigned)b2 | ((unsigned)b3 << 16);
        *(uint2*)(hrow + e) = o;
        if (lorow) { uint2 q; q.x = pk2(h0 - bf2f(b0), h1 - bf2f(b1)); q.y = pk2(h2 - bf2f(b2), h3 - bf2f(b3)); *(uint2*)(lorow + e) = q; } }
}
DI void norm_tables(const Params& p, int l, int which, const float* g, LDSF float* gs, LDSF float* sh, int tid) {
#pragma unroll
    for (int it = 0; it < 4 * DM / 512; ++it) { const int i = tid + it * 512; const int b = i >> 11, kk = i & (DM - 1);
        gs[i] = g[kk] * (1.f + mod_ptr(p, l, b, which * 3 + 1)[kk]); sh[i] = mod_ptr(p, l, b, which * 3 + 0)[kk]; }
}
DI void st_norm(const Params& p, int l, const float* xin, int which, unsigned char* smem, const int WV) {
    const int TIDX = opq_tid(WV); const int BIDX = opq_bid(); (void)TIDX; (void)BIDX;
    const int lane = TIDX & 63, wave = __builtin_amdgcn_readfirstlane(TIDX >> 6);
    bf16_t* H = (bf16_t*)(p.ws + WS_H); bf16_t* HLO = (bf16_t*)(p.ws + WS_HLO);
    LDSF float* gs = (LDSF float*)(LDSF unsigned char*)smem; LDSF float* sh = gs + 4 * DM;
    norm_tables(p, l, which, (which == 0 ? p.norm1_g : p.norm2_g) + (size_t)l * DM, gs, sh, TIDX);
    __syncthreads();
    if (which) {
        const bf16_t* xb = (const bf16_t*)xin; const int step = gridDim.x * 8; int t = BIDX * 8 + wave; uint2 raw[8];
        if (t < NT) {
#pragma unroll
            for (int j = 0; j < 8; ++j) raw[j] = *(const uint2*)(xb + (size_t)t * DM + (j * 64 + lane) * 4); }
        for (; t < NT; t += step) {
            const int b = t / SEQ; float4 v[8];
#pragma unroll
            for (int j = 0; j < 8; ++j) v[j] = make_float4(__uint_as_float(raw[j].x << 16), __uint_as_float(raw[j].x & 0xffff0000u), __uint_as_float(raw[j].y << 16), __uint_as_float(raw[j].y & 0xffff0000u));
            const int tn = t + step;
            if (tn < NT) {
#pragma unroll
                for (int j = 0; j < 8; ++j) raw[j] = *(const uint2*)(xb + (size_t)tn * DM + (j * 64 + lane) * 4); }
            norm_row_store(v, lane, gs + b * DM, sh + b * DM, H + (size_t)t * DM, nullptr);
        }
        return;
    }
    for (int t = BIDX * 8 + wave; t < NT; t += gridDim.x * 8) {
        const int b = t / SEQ; float4 v[8];
#pragma unroll
        for (int j = 0; j < 8; ++j) {
            if (which) { const uint2 w = *(const uint2*)((const bf16_t*)xin + (size_t)t * DM + (j * 64 + lane) * 4);
                v[j] = make_float4(__uint_as_float(w.x << 16), __uint_as_float(w.x & 0xffff0000u), __uint_as_float(w.y << 16), __uint_as_float(w.y & 0xffff0000u)); }
            else v[j] = *(const float4*)(xin + (size_t)t * DM + (j * 64 + lane) * 4); }
        norm_row_store(v, lane, gs + b * DM, sh + b * DM, H + (size_t)t * DM, nullptr);
    }
}

template <class Epi>
DI void sgemm_tile(unsigned char* smem, const bf16_t* A, size_t lda, size_t kseg, int mvalid, const bf16_t* Bt, size_t ldb, int K, const Epi& epi, const int WV) {
    const int TIDX = opq_tid(WV); const int BIDX = opq_bid(); (void)TIDX; (void)BIDX;
    float* As = (float*)smem; float* Bs = As + 16 * 132;
    const int tid = TIDX, tx = tid & 31, ty = tid >> 5;
    const int lr = tid >> 2, lk = (tid & 3) * 4;
    const int ar = lr < mvalid ? lr : mvalid - 1;
    float acc[8][4] = {};
    for (int k0 = 0; k0 < K; k0 += 16) {
        const int k = k0 + lk;
        const uint2 av = *(const uint2*)(A + (size_t)ar * lda + (size_t)(k >> 7) * kseg + (k & 127));
        const uint2 bv = *(const uint2*)(Bt + (size_t)lr * ldb + k);
        __syncthreads();
        As[(lk + 0) * 132 + lr] = __uint_as_float(av.x << 16); As[(lk + 1) * 132 + lr] = __uint_as_float(av.x & 0xffff0000u);
        As[(lk + 2) * 132 + lr] = __uint_as_float(av.y << 16); As[(lk + 3) * 132 + lr] = __uint_as_float(av.y & 0xffff0000u);
        Bs[(lk + 0) * 132 + lr] = __uint_as_float(bv.x << 16); Bs[(lk + 1) * 132 + lr] = __uint_as_float(bv.x & 0xffff0000u);
        Bs[(lk + 2) * 132 + lr] = __uint_as_float(bv.y << 16); Bs[(lk + 3) * 132 + lr] = __uint_as_float(bv.y & 0xffff0000u);
        __syncthreads();
#pragma unroll
        for (int kk = 0; kk < 16; ++kk) {
            const float4 a0 = *(const float4*)(As + kk * 132 + ty * 8), a1 = *(const float4*)(As + kk * 132 + ty * 8 + 4);
            const float4 b = *(const float4*)(Bs + kk * 132 + tx * 4);
            const float a[8] = {a0.x, a0.y, a0.z, a0.w, a1.x, a1.y, a1.z, a1.w};
#pragma unroll
            for (int i = 0; i < 8; ++i) { acc[i][0] += a[i] * b.x; acc[i][1] += a[i] * b.y; acc[i][2] += a[i] * b.z; acc[i][3] += a[i] * b.w; }
        }
    }
    __syncthreads();
#pragma unroll
    for (int i = 0; i < 8; ++i) { const int r = ty * 8 + i; if (r < mvalid) {
#pragma unroll
        for (int j = 0; j < 4; ++j) epi(r, tx * 4 + j, acc[i][j]); } }
}


DI void rot8(uint4& A, uint4& B, const float* cs, const float* sn) {
    unsigned a[4] = {A.x, A.y, A.z, A.w}, b[4] = {B.x, B.y, B.z, B.w};
#pragma unroll
    for (int j = 0; j < 4; ++j) { const float a0 = __uint_as_float(a[j] << 16), a1 = __uint_as_float(a[j] & 0xffff0000u), b0 = __uint_as_float(b[j] << 16), b1 = __uint_as_float(b[j] & 0xffff0000u);
        const float c0 = cs[2 * j], c1 = cs[2 * j + 1], s0 = sn[2 * j], s1 = sn[2 * j + 1];
        a[j] = pk2(a0 * c0 - b0 * s0, a1 * c1 - b1 * s1); b[j] = pk2(a0 * s0 + b0 * c0, a1 * s1 + b1 * c1); }
    A = make_uint4(a[0], a[1], a[2], a[3]); B = make_uint4(b[0], b[1], b[2], b[3]);
}
DI void st_post(const Params& p, int l, unsigned char* smem, const int WV, const float sgn = 1.f) {
    const int TIDX = opq_tid(WV); const int BIDX = opq_bid(); (void)TIDX; (void)BIDX;
    const int lane = TIDX & 63, wave = __builtin_amdgcn_readfirstlane(TIDX >> 6);
    bf16_t* Y = (bf16_t*)(p.ws + WS_Y); bf16_t* YM = (bf16_t*)(p.ws + WS_YMIX);
    float* tab = (float*)smem + wave * 160;
    const float inv_n = exp2f(-(float)(lane & 15) * (18.931568569324174f / 16.f));
    const float inv_r = exp2f(-(float)lane * (13.287712379549449f / 64.f));
    const int c0 = lane * 8;
    float cw[24], cg[8];
    { const float4* w4 = (const float4*)(p.conv_w + ((size_t)l * 512 + c0) * 3);
#pragma unroll
      for (int i = 0; i < 6; ++i) { const float4 v = w4[i]; cw[4 * i] = v.x; cw[4 * i + 1] = v.y; cw[4 * i + 2] = v.z; cw[4 * i + 3] = v.w; }
      const float4* g4 = (const float4*)(p.conv_g + (size_t)l * 512 + c0); const float4 g0 = g4[0], g1 = g4[1];
      cg[0] = g0.x; cg[1] = g0.y; cg[2] = g0.z; cg[3] = g0.w; cg[4] = g1.x; cg[5] = g1.y; cg[6] = g1.z; cg[7] = g1.w; }
    int posn = (BIDX * 8 + wave) < NT ? p.pos[BIDX * 8 + wave] : 0;
    for (int t = BIDX * 8 + wave; t < NT; t += gridDim.x * 8) {
        bf16_t* y = Y + (size_t)t * LDY; const float pos = (float)posn; const int s = t % SEQ;
        { const int tn = t + gridDim.x * 8; posn = p.pos[tn < NT ? tn : t]; }
        { float sn, cs; sincosf(pos * inv_r, &sn, &cs); tab[32 + lane] = cs; tab[96 + lane] = sn * sgn;
          if (lane < 16) { sincosf(pos * inv_n, &sn, &cs); tab[lane] = cs; tab[16 + lane] = sn * sgn; } }
        const uint4 qb_ = *(const uint4*)(y + Y_CB + c0), qc0 = *(const uint4*)(y + Y_CC + c0), qu0 = *(const uint4*)(y + Y_CU + c0);
        uint4 qc1 = make_uint4(0, 0, 0, 0), qu1 = qc1, qc2 = qc1, qu2 = qc1;
        if (s >= 1) { qc1 = *(const uint4*)(y + Y_CC + c0 - LDY); qu1 = *(const uint4*)(y + Y_CU + c0 - LDY); }
        if (s >= 2) { qc2 = *(const uint4*)(y + Y_CC + c0 - 2 * LDY); qu2 = *(const uint4*)(y + Y_CU + c0 - 2 * LDY); }
        const int rv = lane >> 3, rkk = lane & 7; bf16_t* rbase = y + (rv < 4 ? Y_QR : Y_KR) + (rv & 3) * 128 + 8 * rkk;
        uint4 rA = *(const uint4*)rbase, rB = *(const uint4*)(rbase + 64);
        const int nl = lane < 28 ? lane : 27, nv = nl >> 1, ncp = nl & 1; bf16_t* nbase = y + (nv < 8 ? Y_QN + nv * 128 : Y_KV + ((nv - 8) >> 1) * 512 + ((nv - 8) & 1) * 128) + 8 * ncp;
        uint4 nA = *(const uint4*)nbase, nB = *(const uint4*)(nbase + 16);
        LDS_WAIT();
        { rot8(rA, rB, tab + 32 + 8 * rkk, tab + 96 + 8 * rkk); *(uint4*)rbase = rA; *(uint4*)(rbase + 64) = rB; }
        if (lane < 28) { rot8(nA, nB, tab + 8 * ncp, tab + 16 + 8 * ncp); *(uint4*)nbase = nA; *(uint4*)(nbase + 16) = nB; }
        const unsigned wb[4] = {qb_.x, qb_.y, qb_.z, qb_.w}, wc0[4] = {qc0.x, qc0.y, qc0.z, qc0.w}, wu0[4] = {qu0.x, qu0.y, qu0.z, qu0.w}, wc1[4] = {qc1.x, qc1.y, qc1.z, qc1.w}, wu1[4] = {qu1.x, qu1.y, qu1.z, qu1.w},
                       wc2[4] = {qc2.x, qc2.y, qc2.z, qc2.w}, wu2[4] = {qu2.x, qu2.y, qu2.z, qu2.w};
        float yc[8]; float ss = 0.f;
#pragma unroll
        for (int i = 0; i < 8; ++i) { const int w = i >> 1; const bool hi_ = i & 1;
#define BFX(arr) (hi_ ? __uint_as_float(arr[w] & 0xffff0000u) : __uint_as_float(arr[w] << 16))
            const float v0 = BFX(wc0) * BFX(wu0), v1 = BFX(wc1) * BFX(wu1), v2 = BFX(wc2) * BFX(wu2);
            yc[i] = BFX(wb) * (cw[3 * i] * v2 + cw[3 * i + 1] * v1 + cw[3 * i + 2] * v0); ss += yc[i] * yc[i]; }
#undef BFX
        ss += __shfl_xor(ss, 1); ss += __shfl_xor(ss, 2); ss += __shfl_xor(ss, 4); ss += __shfl_xor(ss, 8);
        const float rs = rsqrtf(ss * (1.f / 128.f) + EPS);
        uint4 o; o.x = pk2(yc[0] * rs * cg[0], yc[1] * rs * cg[1]); o.y = pk2(yc[2] * rs * cg[2], yc[3] * rs * cg[3]); o.z = pk2(yc[4] * rs * cg[4], yc[5] * rs * cg[5]); o.w = pk2(yc[6] * rs * cg[6], yc[7] * rs * cg[7]);
        *(uint4*)(YM + (size_t)t * DM + c0) = o;
        LDS_WAIT();
    }
}

DI void st_cmp2(const Params& p, int l, unsigned char* smem, const int WV) {
    const int TIDX = opq_tid(WV); const int BIDX = opq_bid(); (void)TIDX; (void)BIDX;
    typedef short c2_bf16x8 __attribute__((ext_vector_type(8))); typedef float c2_f32x16 __attribute__((ext_vector_type(16))); typedef unsigned c2_u4 __attribute__((ext_vector_type(4)));
    constexpr int HP = 264;
    const float* CP = (const float*)(p.ws + WS_CP); const float* bias = (const float*)(p.ws + WS_CMPB) + l * 512;
    bf16_t* hid = (bf16_t*)(smem + 32768);
    const int wid = __builtin_amdgcn_readfirstlane(TIDX >> 6), lane = TIDX & 63, li = lane & 31, hi = lane >> 5, cb = wid & 1, db = wid >> 1;
    for (int u = BIDX; u < 2 * 8 * 4; u += gridDim.x) {
        const int kv = u >> 5, bg = (u >> 2) & 7, mq = u & 3;
        const bf16_t* W2 = wl_ptr(p, l, WL_CW2) + (size_t)kv * 128 * 256;
        c2_bf16x8 wf[8];
#pragma unroll
        for (int ks = 0; ks < 8; ++ks) wf[ks] = *(const c2_bf16x8*)(W2 + (size_t)(32 * db + li) * 256 + 16 * ks + 8 * hi);
        __syncthreads();
        for (int i = TIDX; i < 64 * 64; i += 512) { const int r = i >> 6, c4 = (i & 63) * 4; const size_t o = ((size_t)((kv * 8 + bg) * 256 + mq * 64 + r)) * 256 + c4;
            const float4 a0 = *(const float4*)(CP + o), a1 = *(const float4*)(CP + (size_t)16 * 65536 + o), a2 = *(const float4*)(CP + (size_t)32 * 65536 + o), a3 = *(const float4*)(CP + (size_t)48 * 65536 + o);
            const float4 b0_ = *(const float4*)(bias + kv * 256 + c4), b1_ = *(const float4*)(bias + 1024 + kv * 256 + c4), b2_ = *(const float4*)(bias + 2048 + kv * 256 + c4), b3_ = *(const float4*)(bias + 3072 + kv * 256 + c4);
            const float4 bb = make_float4((b0_.x + b1_.x) + (b2_.x + b3_.x), (b0_.y + b1_.y) + (b2_.y + b3_.y), (b0_.z + b1_.z) + (b2_.z + b3_.z), (b0_.w + b1_.w) + (b2_.w + b3_.w));
            uint2 w; w.x = pk2(gelu_tanh_f((a0.x + a1.x) + (a2.x + a3.x) + bb.x), gelu_tanh_f((a0.y + a1.y) + (a2.y + a3.y) + bb.y)); w.y = pk2(gelu_tanh_f((a0.z + a1.z) + (a2.z + a3.z) + bb.z), gelu_tanh_f((a0.w + a1.w) + (a2.w + a3.w) + bb.w));
            *(uint2*)(hid + r * HP + c4) = w; }
        __syncthreads();
        const LDSF bf16_t* hl = (const LDSF bf16_t*)(LDSF unsigned char*)(smem + 32768);
        c2_f32x16 acc;
#pragma unroll
        for (int r = 0; r < 16; ++r) acc[r] = 0.f;
#pragma unroll
        for (int kh = 0; kh < 2; ++kh) {
            if (kh == 1) {
#pragma unroll
                for (int ks = 0; ks < 8; ++ks) wf[ks] = *(const c2_bf16x8*)(W2 + (size_t)(32 * db + li) * 256 + 128 + 16 * ks + 8 * hi); }
#pragma unroll
            for (int ks = 0; ks < 8; ++ks) { const c2_bf16x8 hf = *(const LDSF c2_bf16x8*)(hl + (32 * cb + li) * HP + 128 * kh + 16 * ks + 8 * hi);
                acc = kv ? __builtin_amdgcn_mfma_f32_32x32x16_bf16(hf, wf[ks], acc, 0, 0, 0) : __builtin_amdgcn_mfma_f32_32x32x16_bf16(wf[ks], hf, acc, 0, 0, 0); } }
        bf16_t* kc = (bf16_t*)(p.ws + WS_KC) + (size_t)bg * 256 * 128; bf16_t* vct = (bf16_t*)(p.ws + WS_VC) + (size_t)bg * 128 * 256;
        if (kv == 0) { const int g = mq * 64 + 32 * cb + li;
#pragma unroll
            for (int rq = 0; rq < 4; ++rq) { uint2 w; w.x = pk2(acc[4 * rq], acc[4 * rq + 1]); w.y = pk2(acc[4 * rq + 2], acc[4 * rq + 3]); if (g == 255) { w.x = 0u; w.y = 0u; }
                *(uint2*)(kc + (size_t)g * 128 + 32 * db + 8 * rq + 4 * hi) = w; } }
        else {
#pragma unroll
            for (int h2 = 0; h2 < 2; ++h2) { const int base = mq * 64 + 32 * cb + 16 * h2 + 8 * hi;
                c2_u4 w; w.x = pk2(acc[8 * h2 + 0], acc[8 * h2 + 1]); w.y = pk2(acc[8 * h2 + 2], acc[8 * h2 + 3]); w.z = pk2(acc[8 * h2 + 4], acc[8 * h2 + 5]); w.w = pk2(acc[8 * h2 + 6], acc[8 * h2 + 7]);
                if (base + 7 == 255) w.w &= 0x0000ffffu;
                *(c2_u4*)(vct + (size_t)(32 * db + li) * 256 + base) = w; } }
    }
}

DI void st_scan(const Params& p, int l, const int WV) {
    const int TIDX = opq_tid(WV); const int BIDX = opq_bid(); (void)TIDX; (void)BIDX;
    const float* KVC = (const float*)(p.ws + WS_KVC); bf16_t* STB = (bf16_t*)(p.ws + WS_STATEB);
    const bool split = gridDim.x == 256;
    if (split && BIDX < 64) return;
    const int vb = split ? BIDX - 64 : BIDX, vg = split ? 192 : (int)gridDim.x;
    for (size_t i = (size_t)vb * 512 + TIDX; i < (size_t)16 * 16384; i += (size_t)vg * 512) {
        const int bh = (int)(i >> 14), ed = (int)(i & 16383); const float cd = ret_chunkdecay(bh & 3);
        float kv[32];
#pragma unroll
        for (int c = 0; c < 32; ++c) kv[c] = KVC[(size_t)(bh * 32 + c) * 16384 + ed];
        float st = 0.f;
#pragma unroll
        for (int c = 0; c < 32; ++c) { STB[(size_t)(bh * 32 + c) * 16384 + ed] = f2bf(st); st = st * cd + kv[c]; }
    }
}


DI void pad_offsets(const unsigned* CNT, int* po, const int WV) {
    const int TIDX = opq_tid(WV); const int BIDX = opq_bid(); (void)TIDX; (void)BIDX;
    if (TIDX < 64) { const int pad = (int)((CNT[TIDX] + 255u) >> 8) << 8; int inc = pad;
#pragma unroll
        for (int o = 1; o < 64; o <<= 1) { const int v = __shfl_up(inc, o); if (TIDX >= o) inc += v; }
        po[TIDX] = inc - pad; if (TIDX == 63) po[64] = inc; }
    __syncthreads();
}
DI int blk_expert(const int* po, int blk) { int e = 0; while (e < 63 && po[e + 1] <= blk * 256) ++e; return e; }
typedef unsigned u2v_t __attribute__((ext_vector_type(2)));
typedef unsigned u4w_t __attribute__((ext_vector_type(4)));
DI void st_combine(const Params& p, int l, unsigned char* smem, const int WV) {
    const int TIDX = opq_tid(WV); const int BIDX = opq_bid(); (void)TIDX; (void)BIDX;
    bf16_t* X2 = (bf16_t*)(p.ws + WS_X2);
    LDSF float* tg2 = (LDSF float*)(LDSF unsigned char*)smem; LDSF float* tgs = tg2 + 4 * DM; LDSF float* tsh = tgs + 4 * DM;
#pragma unroll
    for (int it = 0; it < 4 * DM / 512; ++it) { const int i = TIDX + it * 512; tg2[i] = mod_ptr(p, l, i >> 11, 5)[i & (DM - 1)]; }
    if (l + 1 < NL) norm_tables(p, l + 1, 0, p.norm1_g + (size_t)(l + 1) * DM, tgs, tsh, TIDX); else for (int i = TIDX; i < DM; i += 512) tgs[i] = p.final_g[i];
    __syncthreads();
    const int* TOPE = (const int*)(p.ws + WS_TOPE); const int* RANK = (const int*)(p.ws + WS_RANK); const float* TOPW = (const float*)(p.ws + WS_TOPW);
    int* po = (int*)(smem + 100 * 1024); pad_offsets((const unsigned*)(p.ws + WS_CTL) + CW_CNT + l * 64, po, WV);
    const int lane = TIDX & 63, wave = __builtin_amdgcn_readfirstlane(TIDX >> 6);
    const __amdgpu_buffer_rsrc_t rys = __builtin_amdgcn_make_buffer_rsrc((void*)(p.ws + WS_YS), 0, (int)((size_t)NROWS_E * DM), 0x00020000);
    const __amdgpu_buffer_rsrc_t rx1 = __builtin_amdgcn_make_buffer_rsrc((void*)(p.ws + WS_X1), 0, (int)((size_t)NT * DM * 2), 0x00020000);
    const int lane0 = lane;
    for (int t = BIDX * 8 + wave; t < NT; t += gridDim.x * 8) {
        int lane = opq_tid(WV) & 63;
        const int b = t / SEQ; float4 acc[8];
        const int lo4 = lane * 4;
        { const int so = (NSLOT + t) * DM;
#pragma unroll
          for (int j = 0; j < 8; ++j) { const int w = (int)__builtin_amdgcn_raw_buffer_load_b32(rys, lo4 + j * 256, so, 2);
              acc[j] = make_float4(__builtin_amdgcn_cvt_f32_fp8(w, 0), __builtin_amdgcn_cvt_f32_fp8(w, 1), __builtin_amdgcn_cvt_f32_fp8(w, 2), __builtin_amdgcn_cvt_f32_fp8(w, 3)); } }
        { const int sv = po[TOPE[(size_t)t * 8 + (lane & 7)]] + RANK[(size_t)t * 8 + (lane & 7)]; const float wv = TOPW[(size_t)t * 8 + (lane & 7)];
#pragma unroll 1
          for (int kk = 0; kk < 8; kk += 4) { int w[4][8];
#pragma unroll
              for (int k2 = 0; k2 < 4; ++k2) { const int so = __builtin_amdgcn_readlane(sv, kk + k2) * DM;
#pragma unroll
                  for (int j = 0; j < 8; ++j) w[k2][j] = (int)__builtin_amdgcn_raw_buffer_load_b32(rys, lo4 + j * 256, so, 2); }
#pragma unroll
              for (int k2 = 0; k2 < 4; ++k2) { const float wk = __uint_as_float(__builtin_amdgcn_readlane(__float_as_uint(wv), kk + k2));
#pragma unroll
                  for (int j = 0; j < 8; ++j) { acc[j].x += wk * __builtin_amdgcn_cvt_f32_fp8(w[k2][j], 0); acc[j].y += wk * __builtin_amdgcn_cvt_f32_fp8(w[k2][j], 1); acc[j].z += wk * __builtin_amdgcn_cvt_f32_fp8(w[k2][j], 2); acc[j].w += wk * __builtin_amdgcn_cvt_f32_fp8(w[k2][j], 3); } }
              asm volatile("" ::: "memory"); } }
        asm volatile("" : "+v"(lane));
        float4 v[8];
#pragma unroll
        for (int j = 0; j < 8; ++j) { const u2v_t xw = __builtin_amdgcn_raw_buffer_load_b64(rx1, lane * 8 + j * 512, t * (DM * 2), 0); const f4v_t gg = *(const LDSF f4v_t*)(tg2 + b * DM + ((unsigned)j * 64u + (unsigned)lane) * 4u);
            v[j] = make_float4(__uint_as_float(xw.x << 16) + gg.x * acc[j].x, __uint_as_float(xw.x & 0xffff0000u) + gg.y * acc[j].y, __uint_as_float(xw.y << 16) + gg.z * acc[j].z, __uint_as_float(xw.y & 0xffff0000u) + gg.w * acc[j].w);
            if ((j & 3) == 3) asm volatile("" ::: "memory"); }
        if (l + 1 < NL) {
#pragma unroll
            for (int j = 0; j < 8; ++j) { uint2 o; o.x = pk2(v[j].x, v[j].y); o.y = pk2(v[j].z, v[j].w); *(uint2*)(X2 + (size_t)t * DM + ((unsigned)j * 64u + (unsigned)lane) * 4u) = o; }
            norm_row_store(v, lane, tgs + b * DM, tsh + b * DM, (bf16_t*)(p.ws + WS_H) + (size_t)t * DM, nullptr);
        } else {
            float ss = 0.f;
#pragma unroll
            for (int j = 0; j < 8; ++j) ss += v[j].x * v[j].x + v[j].y * v[j].y + v[j].z * v[j].z + v[j].w * v[j].w;
            const float r = rsqrtf(wave_sum(ss) * (1.f / DM) + EPS);
#pragma unroll
            for (int j = 0; j < 8; ++j) { const unsigned e = ((unsigned)j * 64u + (unsigned)lane) * 4u; const f4v_t gg = *(const LDSF f4v_t*)(tgs + e);
                *(float4*)(p.out + (size_t)t * DM + e) = make_float4(v[j].x * r * gg.x, v[j].y * r * gg.y, v[j].z * r * gg.z, v[j].w * r * gg.w); }
        }
    }
}


namespace pg8 {
#define PG8_LAS __attribute__((address_space(3)))
typedef short bf16x8 __attribute__((ext_vector_type(8)));
typedef float f32x4 __attribute__((ext_vector_type(4)));
typedef unsigned u32x4 __attribute__((ext_vector_type(4)));
constexpr int BM = 256, BK = 64, HALF = 128, HTB = HALF * BK * 2, STAGE_BYTES = 8 * HTB, NXCD = 8, WGM = 8;
__host__ __device__ __forceinline__ int lds_byte(int r, int c) { const int st = (r >> 4) * 2 + (c >> 5), rr = r & 15, cc = c & 31, ob = rr * 64 + cc * 2; return st * 1024 + (ob ^ (((ob >> 9) & 1) << 5)); }
__host__ __device__ __forceinline__ void stage_rc(int b, int& R, int& C) { const int st = b / 1024, sb = b % 1024, swz = sb ^ (((sb >> 9) & 1) << 5); R = (st >> 1) * 16 + swz / 64; C = (st & 1) * 32 + (swz % 64) / 2; }
__host__ __device__ __forceinline__ int perm32(int rho) { const int n = rho >> 4, i = rho & 15; return 8 * (i >> 2) + 4 * n + (i & 3); }
struct Unit { const char* A; const char* B; int i0, i1; };
__device__ __forceinline__ unsigned cvt_pk_bf16(float lo, float hi) { unsigned r; asm volatile("v_cvt_pk_bf16_f32 %0, %1, %2" : "=v"(r) : "v"(lo), "v"(hi)); return r; }
template <class Epi, class Sched, bool GATHER = false>
__device__ __forceinline__ void gemm_phase(PG8_LAS unsigned char* lds, const int K, const Sched& S, const Epi& E, const int tid, const size_t pitchA = 0, const size_t segA = 256, const size_t pitchB = 0) {
    const int wid = __builtin_amdgcn_readfirstlane(tid >> 6), lane = tid & 63, wr = wid >> 2, wc = wid & 3, fr = lane & 15, fq = lane >> 4;
    const int nt = K / BK;
    unsigned voffB[2], cva[2][2], nva[2][2]; int RA[2]; unsigned CA[2];
    const size_t pA = pitchA ? pitchA : (size_t)K * 2;
#pragma unroll
    for (int i = 0; i < 2; ++i) { int R, C; stage_rc(tid * 16 + i * 8192, R, C);
        const int Rb = Epi::BP16 ? (64 * (R >> 5) + 16 * ((R >> 2) & 3) + 4 * ((R >> 4) & 1) + (R & 3)) : (Epi::PERM ? ((R & ~31) + perm32(R & 31)) : R);
        RA[i] = R; CA[i] = (unsigned)C * 2u; voffB[i] = (unsigned)((size_t)Rb * (pitchB ? pitchB : (size_t)K * 2)) + (unsigned)C * 2u;
        cva[0][i] = (unsigned)((size_t)R * pA) + CA[i]; cva[1][i] = (unsigned)((size_t)(R + HALF) * pA) + CA[i]; nva[0][i] = cva[0][i]; nva[1][i] = cva[1][i]; }
    const size_t kstep = (size_t)(BK * 2);
    const size_t hstep = (size_t)(Epi::BP16 ? 8 : HALF) * (pitchB ? pitchB : (size_t)K * 2);
    const unsigned ldsw = (unsigned)wid * 1024u;
    const int aoff = lds_byte(wr * 64 + fr, fq * 8), boff = lds_byte(wc * 32 + fr, fq * 8);
#define PG8_SA(b, h) (((b) * 2 + (h)) * HTB)
#define PG8_SB(b, h) ((4 + (b) * 2 + (h)) * HTB)
#define PG8_STAGE(bufoff, gbase, voff) do { _Pragma("unroll") for (int _i = 0; _i < 2; ++_i) \
        __builtin_amdgcn_global_load_lds((const unsigned*)((const char*)(gbase) + (voff)[_i]), (PG8_LAS unsigned*)(lds + (bufoff) + ldsw + _i * 8192), 16, 0, 0); } while (0)
#define PG8_LDA(dst, b, h) do { _Pragma("unroll") for (int m = 0; m < 4; ++m) _Pragma("unroll") for (int k = 0; k < 2; ++k) dst[m][k] = *(const PG8_LAS bf16x8*)(lds + PG8_SA(b, h) + aoff + m * 2048 + k * 1024); } while (0)
#define PG8_LDB(dst, b, h) do { _Pragma("unroll") for (int n = 0; n < 2; ++n) _Pragma("unroll") for (int k = 0; k < 2; ++k) dst[n][k] = *(const PG8_LAS bf16x8*)(lds + PG8_SB(b, h) + boff + n * 2048 + k * 1024); } while (0)
#define PG8_MMA(ai, bj, At, Bt) do { __builtin_amdgcn_s_setprio(1); _Pragma("unroll") for (int m = 0; m < 4; ++m) _Pragma("unroll") for (int n = 0; n < 2; ++n) _Pragma("unroll") for (int k = 0; k < 2; ++k) \
        acc[ai][bj][m][n] = __builtin_amdgcn_mfma_f32_16x16x32_bf16(Bt[n][k], At[m][k], acc[ai][bj][m][n], 0, 0, 0); __builtin_amdgcn_s_setprio(0); } while (0)
#define PG8_WAIT_V(n) asm volatile("s_waitcnt vmcnt(" #n ")" ::: "memory")
#define PG8_WAIT_L(n) asm volatile("s_waitcnt lgkmcnt(" #n ")" ::: "memory")
#define PG8_BAR __builtin_amdgcn_s_barrier()
#define PG8_SCHED __builtin_amdgcn_sched_barrier(0)
    Unit cur, nxt; int ui = 0;
    if (!S.next(0, cur)) return;
    f32x4 acc[2][2][4][2];
#pragma unroll
    for (int a = 0; a < 2; ++a)
#pragma unroll
        for (int b = 0; b < 2; ++b)
#pragma unroll
            for (int m = 0; m < 4; ++m)
#pragma unroll
                for (int n = 0; n < 2; ++n) acc[a][b][m][n] = (f32x4){0.f, 0.f, 0.f, 0.f};
    bf16x8 At[4][2], B0[2][2], B1[2][2];
    const char* cA = cur.A; const char* cB = cur.B;
    if constexpr (GATHER) {
#pragma unroll
        for (int h = 0; h < 2; ++h)
#pragma unroll
            for (int i = 0; i < 2; ++i) cva[h][i] = S.rowoff(cur, h * HALF + RA[i]) + CA[i]; }
    S.a_ready(cur);
    PG8_STAGE(PG8_SB(0, 0), cB, voffB); PG8_STAGE(PG8_SA(0, 0), cA, cva[0]); PG8_STAGE(PG8_SB(0, 1), cB + hstep, voffB); PG8_STAGE(PG8_SA(0, 1), cA, cva[1]);
    if (wr == 1) PG8_BAR;
    PG8_WAIT_V(4); PG8_BAR;
    PG8_STAGE(PG8_SB(1, 0), cB + kstep, voffB); PG8_STAGE(PG8_SA(1, 0), cA + kstep, cva[0]); PG8_STAGE(PG8_SB(1, 1), cB + hstep + kstep, voffB);
    PG8_WAIT_V(6); PG8_BAR;
    for (;;) {
        const bool has_next = S.next(ui + 1, nxt);
        if constexpr (GATHER) { if (has_next) {
#pragma unroll
            for (int h = 0; h < 2; ++h)
#pragma unroll
                for (int i = 0; i < 2; ++i) nva[h][i] = S.rowoff(nxt, h * HALF + RA[i]) + CA[i]; } }
        const char* nA = has_next ? nxt.A : cA; const char* nB = has_next ? nxt.B : cB;
        for (int t = 0; t < nt; t += 2) {
            const bool last = (t == nt - 2);
            const char* a1 = cA + (size_t)(t >> 1) * segA + kstep;
            unsigned va2[2][2];
#pragma unroll
            for (int h = 0; h < 2; ++h)
#pragma unroll
                for (int i = 0; i < 2; ++i) va2[h][i] = (GATHER && last) ? nva[h][i] : cva[h][i];
            const char* a2 = last ? nA : cA + (size_t)((t >> 1) + 1) * segA; const char* b2 = last ? nB : cB + (size_t)(t + 2) * kstep;
            const char* a3 = a2 + kstep; const char* b3 = b2 + kstep;
            if (last && has_next) S.a_ready(nxt);
            PG8_LDB(B0, 0, 0); PG8_SCHED; PG8_LDA(At, 0, 0); PG8_STAGE(PG8_SA(1, 1), a1, cva[1]);
            PG8_WAIT_L(8); PG8_BAR; PG8_WAIT_L(0); PG8_MMA(0, 0, At, B0); PG8_BAR; PG8_SCHED;
            PG8_LDB(B1, 0, 1); PG8_STAGE(PG8_SB(0, 0), b2, voffB);
            PG8_BAR; PG8_WAIT_L(0); PG8_MMA(0, 1, At, B1); PG8_BAR;
            PG8_LDA(At, 0, 1); PG8_STAGE(PG8_SA(0, 0), a2, va2[0]);
            PG8_BAR; PG8_WAIT_L(0); PG8_MMA(1, 0, At, B0); PG8_BAR; PG8_SCHED;
            PG8_STAGE(PG8_SB(0, 1), b2 + hstep, voffB);
            PG8_WAIT_V(6); PG8_BAR; PG8_MMA(1, 1, At, B1); PG8_BAR;
            PG8_LDB(B0, 1, 0); PG8_SCHED; PG8_LDA(At, 1, 0); PG8_STAGE(PG8_SA(0, 1), a2, va2[1]);
            PG8_WAIT_L(8); PG8_BAR; PG8_WAIT_L(0); PG8_MMA(0, 0, At, B0); PG8_BAR; PG8_SCHED;
            PG8_LDB(B1, 1, 1); PG8_STAGE(PG8_SB(1, 0), b3, voffB);
            PG8_BAR; PG8_WAIT_L(0); PG8_MMA(0, 1, At, B1); PG8_BAR;
            PG8_LDA(At, 1, 1); PG8_STAGE(PG8_SA(1, 0), a3, va2[0]);
            PG8_BAR; PG8_WAIT_L(0); PG8_MMA(1, 0, At, B0); PG8_BAR; PG8_SCHED;
            PG8_STAGE(PG8_SB(1, 1), b3 + hstep, voffB);
            PG8_WAIT_V(6); PG8_BAR; PG8_MMA(1, 1, At, B1); PG8_BAR;
        }
        if (wr == 0) PG8_BAR;
        if constexpr (!Epi::AFTER_DRAIN) { E(acc, cur, wr, wc, fr, fq); S.done(cur); }
        if (!has_next) break;
#pragma unroll
        for (int a = 0; a < 2; ++a)
#pragma unroll
            for (int b = 0; b < 2; ++b)
#pragma unroll
                for (int m = 0; m < 4; ++m)
#pragma unroll
                    for (int n = 0; n < 2; ++n) acc[a][b][m][n] = (f32x4){0.f, 0.f, 0.f, 0.f};
        cur = nxt; cA = nA; cB = nB; ++ui;
        if constexpr (GATHER) {
#pragma unroll
            for (int h = 0; h < 2; ++h)
#pragma unroll
                for (int i = 0; i < 2; ++i) cva[h][i] = nva[h][i]; }
        if (wr == 1) PG8_BAR;
    }
    PG8_WAIT_V(0);
    PG8_BAR;
    if constexpr (Epi::AFTER_DRAIN) { E.fused(acc, cur, wr, wc, fr, fq, lds, wid, lane); S.done(cur); }
#undef PG8_SA
#undef PG8_SB
#undef PG8_STAGE
#undef PG8_LDA
#undef PG8_LDB
#undef PG8_MMA
#undef PG8_WAIT_V
#undef PG8_WAIT_L
#undef PG8_BAR
#undef PG8_SCHED
}

struct GridOrder {
    int nM, nN, nwg, G, c; const char* A; const char* B; size_t tstep;
    __device__ __forceinline__ void init(int M, int N, int K, int G_, int c_, const void* A_, const void* B_) { nM = M / BM; nN = N / BM; nwg = nM * nN; G = G_; c = c_; A = (const char*)A_; B = (const char*)B_; tstep = (size_t)BM * K * 2; }
    __device__ __forceinline__ bool next(int i, Unit& u) const {
        const long L = (long)i * G + c; if (L >= nwg) return false;
        int wgid = (int)L; { const int q = nwg / NXCD, r = nwg % NXCD, xcd = wgid % NXCD, off = wgid / NXCD; wgid = (xcd < r ? xcd * (q + 1) : r * (q + 1) + (xcd - r) * q) + off; }
        const int nig = WGM * nN, gid = wgid / nig, fm = gid * WGM, gsz = (nM - fm) < WGM ? (nM - fm) : WGM;
        const int pm = fm + ((wgid % nig) % gsz), pn = (wgid % nig) / gsz;
        u.A = A + (size_t)pm * tstep; u.B = B + (size_t)pn * tstep; u.i0 = pm * BM; u.i1 = pn; return true;
    }
    __device__ __forceinline__ void a_ready(const Unit&) const {}
    __device__ __forceinline__ void done(const Unit&) const {}
};
struct MoeOrder {
    int G, c, nblk, npn; const PG8_LAS int* be; const char* XS; const char* HS; const char* W; size_t a_tile, w_exp, w_tile;
    __device__ __forceinline__ bool next(int i, Unit& u) const {
        int blk, pn;
        if ((G & 7) == 0) { const int x = c & 7, r = c >> 3, W = G >> 3, nb = nblk + NT / 256, q = nb >> 3, rem = nb & 7;
            const int b0 = x * q + (x < rem ? x : rem), cntb = q + (x < rem ? 1 : 0); const long kk = (long)i * W + r; if (kk >= (long)cntb * npn) return false;
            blk = b0 + (int)(kk / npn); pn = (int)(kk % npn); }
        else { const long L = (long)i * G + c; if (L >= (long)(nblk + NT / 256) * npn) return false; blk = (int)(L / npn); pn = (int)(L % npn); }
        int e;
        if (blk < nblk) { e = be[blk]; u.A = XS + (size_t)blk * a_tile; u.i0 = blk * 256; }
        else { e = 64; u.A = HS + (size_t)(blk - nblk) * a_tile; u.i0 = NSLOT + (blk - nblk) * 256; }
        if (tokof) u.A = HS;
        u.B = W + (size_t)e * w_exp + (size_t)pn * w_tile; u.i1 = pn; return true;
    }
    __device__ __forceinline__ void a_ready(const Unit&) const {}
    __device__ __forceinline__ void done(const Unit&) const {}
    const int* tokof; unsigned rowbytes; const PG8_LAS int* po; const PG8_LAS int* lc;
    __device__ __forceinline__ unsigned rowoff(const Unit& u, int r) const {
        int t;
        if (u.i0 < NSLOT) { const int e = be[u.i0 >> 8], rk = u.i0 - po[e] + r, c = lc[e]; const int tt = tokof[(size_t)e * NT + (rk < c ? rk : 0)]; t = rk < c ? tt : 0; }
        else t = u.i0 - NSLOT + r;
        return (unsigned)t * rowbytes; }
};
template <bool NT_ST = false> struct EpiStoreBf16T {
    static constexpr bool BP16 = false; static constexpr bool PERM = true, AFTER_DRAIN = false;
    bf16_t* O; int ldc;
    __device__ __forceinline__ void operator()(const f32x4 (&acc)[2][2][4][2], const Unit& u, int wr, int wc, int fr, int fq) const {
        bf16_t* base = O + (size_t)(u.i0 + wr * 64 + fr) * ldc + u.i1 * BM + wc * 32 + 8 * fq;
#pragma unroll
        for (int ai = 0; ai < 2; ++ai)
#pragma unroll
            for (int m = 0; m < 4; ++m) { bf16_t* rowp = base + (size_t)(ai * HALF + m * 16) * ldc;
#pragma unroll
                for (int bj = 0; bj < 2; ++bj) { const f32x4 v0 = acc[ai][bj][m][0], v1 = acc[ai][bj][m][1];
                    u32x4 w; w.x = cvt_pk_bf16(v0[0], v0[1]); w.y = cvt_pk_bf16(v0[2], v0[3]); w.z = cvt_pk_bf16(v1[0], v1[1]); w.w = cvt_pk_bf16(v1[2], v1[3]);
                    if constexpr (NT_ST) __builtin_nontemporal_store(w, (u32x4*)(rowp + bj * HALF)); else *(u32x4*)(rowp + bj * HALF) = w; } }
    }
};
typedef EpiStoreBf16T<false> EpiStoreBf16;
struct EpiSwiglu {
    static constexpr bool BP16 = false; static constexpr bool PERM = true, AFTER_DRAIN = false;
    bf16_t* O;
    __device__ __forceinline__ void operator()(const f32x4 (&acc)[2][2][4][2], const Unit& u, int wr, int wc, int fr, int fq) const {
        bf16_t* base = O + (size_t)(u.i0 + wr * 64 + fr) * 512 + u.i1 * 128 + wc * 32 + 8 * fq;
#pragma unroll
        for (int ai = 0; ai < 2; ++ai)
#pragma unroll
            for (int m = 0; m < 4; ++m) { float r[8];
#pragma unroll
                for (int n = 0; n < 2; ++n)
#pragma unroll
                    for (int j = 0; j < 4; ++j) { const float g = acc[ai][0][m][n][j], up = acc[ai][1][m][n][j]; r[n * 4 + j] = g * __builtin_amdgcn_rcpf(1.f + __expf(-g)) * up; }
                u32x4 w; w.x = cvt_pk_bf16(r[0], r[1]); w.y = cvt_pk_bf16(r[2], r[3]); w.z = cvt_pk_bf16(r[4], r[5]); w.w = cvt_pk_bf16(r[6], r[7]);
                *(u32x4*)(base + (size_t)(ai * HALF + m * 16) * 512) = w; }
    }
};
struct EpiResid {
    static constexpr bool BP16 = false, PACED = false; static constexpr bool PERM = true, AFTER_DRAIN = false;
    const float* xin; const bf16_t* xinb; bf16_t* xo; const float* mod_g1;
    __device__ __forceinline__ void operator()(const f32x4 (&acc)[2][2][4][2], const Unit& u, int wr, int wc, int fr, int fq) const {
        const int col0 = u.i1 * BM + wc * 32 + 8 * fq; const float* g1 = mod_g1 + (size_t)(u.i0 / SEQ) * 12288 + col0;
        f32x4 gv[2][2];
#pragma unroll
        for (int bj = 0; bj < 2; ++bj)
#pragma unroll
            for (int n = 0; n < 2; ++n) gv[bj][n] = *(const f32x4*)(g1 + bj * HALF + n * 4);
        const bool xb = xinb != nullptr;
#pragma unroll
        for (int ai = 0; ai < 2; ++ai)
#pragma unroll
            for (int m = 0; m < 4; ++m) { const size_t off = (size_t)(u.i0 + wr * 64 + fr + ai * HALF + m * 16) * DM + col0;
#pragma unroll
                for (int bj = 0; bj < 2; ++bj) { f32x4 x0, x1;
                    if (xb) { const u32x4 w = *(const u32x4*)(xinb + off + bj * HALF);
                        x0 = (f32x4){__uint_as_float(w.x << 16), __uint_as_float(w.x & 0xffff0000u), __uint_as_float(w.y << 16), __uint_as_float(w.y & 0xffff0000u)};
                        x1 = (f32x4){__uint_as_float(w.z << 16), __uint_as_float(w.z & 0xffff0000u), __uint_as_float(w.w << 16), __uint_as_float(w.w & 0xffff0000u)}; }
                    else { x0 = *(const f32x4*)(xin + off + bj * HALF); x1 = *(const f32x4*)(xin + off + bj * HALF + 4); }
                    const f32x4 r0 = x0 + gv[bj][0] * acc[ai][bj][m][0], r1 = x1 + gv[bj][1] * acc[ai][bj][m][1];
                    u32x4 o; o.x = cvt_pk_bf16(r0[0], r0[1]); o.y = cvt_pk_bf16(r0[2], r0[3]); o.z = cvt_pk_bf16(r1[0], r1[1]); o.w = cvt_pk_bf16(r1[2], r1[3]);
                    *(u32x4*)(xo + off + bj * HALF) = o; }
                if (m & 1) asm volatile("" ::: "memory"); }
    }
};
}

namespace pg8 {
struct EpiStoreFp8 {
    static constexpr bool BP16 = true, PERM = true, AFTER_DRAIN = false;
    unsigned char* O;
    __device__ __forceinline__ static unsigned pk4(const f32x4 v) {
        int w = __builtin_amdgcn_cvt_pk_fp8_f32(__builtin_amdgcn_fmed3f(v[0], -448.f, 448.f), __builtin_amdgcn_fmed3f(v[1], -448.f, 448.f), 0, false);
        w = __builtin_amdgcn_cvt_pk_fp8_f32(__builtin_amdgcn_fmed3f(v[2], -448.f, 448.f), __builtin_amdgcn_fmed3f(v[3], -448.f, 448.f), w, true); return (unsigned)w; }
    __device__ __forceinline__ void operator()(const f32x4 (&acc)[2][2][4][2], const Unit& u, int wr, int wc, int fr, int fq) const {
        unsigned char* base = O + (size_t)(u.i0 + wr * 64 + fr) * DM + u.i1 * BM + wc * 64 + 16 * fq;
#pragma unroll
        for (int ai = 0; ai < 2; ++ai)
#pragma unroll
            for (int m = 0; m < 4; ++m) { u32x4 w; w.x = pk4(acc[ai][0][m][0]); w.y = pk4(acc[ai][0][m][1]); w.z = pk4(acc[ai][1][m][0]); w.w = pk4(acc[ai][1][m][1]);
                *(u32x4*)(base + (size_t)(ai * HALF + m * 16) * DM) = w; }
    }
};
}
constexpr int LDS_PO = 148 * 1024;
constexpr int LDS_BE = 148 * 1024 + 512;
constexpr int LDS_BST = 148 * 1024 + 3072;
constexpr int LDS_LC = 148 * 1024 + 3200;
DI void st_inproj_mm(const Params& p, int l, unsigned char* smem, const int WV) {
    const int TIDX = opq_tid(WV), BIDX = opq_bid();
    pg8::GridOrder S; S.init(NT, 6144, DM, gridDim.x, BIDX, p.ws + WS_H, wl_ptr(p, l, WL_WIN));
    pg8::EpiStoreBf16 E{(bf16_t*)(p.ws + WS_Y), LDY};
    pg8::gemm_phase(( PG8_LAS unsigned char*)smem, DM, S, E, TIDX);
}
DI void st_outproj_mm(const Params& p, int l, const float* xin, const bf16_t* xinb, unsigned char* smem, const int WV) {
    const int TIDX = opq_tid(WV), BIDX = opq_bid();
    pg8::GridOrder S; S.init(NT, DM, DM, gridDim.x, BIDX, p.ws + WS_YMIX, wl_ptr(p, l, WL_WOUT));
    pg8::EpiResid E{xin, xinb, (bf16_t*)(p.ws + WS_X1), mod_ptr(p, l, 0, 2)};
    pg8::gemm_phase((PG8_LAS unsigned char*)smem, DM, S, E, TIDX);
}
DI void moe_offsets(const Params& p, int l, unsigned char* smem, int TIDX) {
    const unsigned* CNT = (const unsigned*)(p.ws + WS_CTL) + CW_CNT + l * 64; int* po = (int*)(smem + LDS_PO);
    __syncthreads();
    if (TIDX < 64) { const int pad = (int)((CNT[TIDX] + 255u) >> 8) << 8; int inc = pad;
        ((int*)(smem + LDS_LC))[TIDX] = (int)CNT[TIDX];
#pragma unroll
        for (int o = 1; o < 64; o <<= 1) { const int v = __shfl_up(inc, o); if (TIDX >= o) inc += v; }
        po[TIDX] = inc - pad; if (TIDX == 63) po[64] = inc; }
    __syncthreads();
    int* be = (int*)(smem + LDS_BE);
    for (int blk = TIDX; blk < 576; blk += 512) { int lo = 0, hi = 63;
#pragma unroll
        for (int it = 0; it < 6; ++it) { const int mid = (lo + hi) >> 1; const bool gt = po[mid + 1] > blk * 256; hi = gt ? mid : hi; lo = gt ? lo : (lo < hi ? mid + 1 : lo); }
        be[blk] = lo; }
    __syncthreads();
}
DI void st_gemm1_mm(const Params& p, int l, unsigned char* smem, const int WV) {
    const int TIDX = opq_tid(WV), BIDX = opq_bid();
    moe_offsets(p, l, smem, TIDX);
    const PG8_LAS int* po = (const PG8_LAS int*)(PG8_LAS unsigned char*)(smem + LDS_PO);
    pg8::MoeOrder S; S.tokof = (const int*)(p.ws + WS_XS); S.po = po; S.lc = (const PG8_LAS int*)(PG8_LAS unsigned char*)(smem + LDS_LC); S.rowbytes = DM * 2; S.G = gridDim.x; S.c = BIDX; S.nblk = po[64] / 256; S.npn = 4; S.be = (const PG8_LAS int*)(PG8_LAS unsigned char*)(smem + LDS_BE); S.XS = (const char*)(p.ws + WS_XS); S.HS = (const char*)(p.ws + WS_H); S.W = (const char*)wl_ptr(p, l, WL_EGU);
    S.a_tile = (size_t)256 * DM * 2; S.w_exp = (size_t)1024 * DM * 2; S.w_tile = (size_t)256 * DM * 2;
    pg8::EpiSwiglu E{(bf16_t*)(p.ws + WS_ACT)};
    pg8::gemm_phase<pg8::EpiSwiglu, pg8::MoeOrder, true>((PG8_LAS unsigned char*)smem, DM, S, E, TIDX);
}
DI void st_gemm2_mm(const Params& p, int l, unsigned char* smem, const int WV) {
    const int TIDX = opq_tid(WV), BIDX = opq_bid();
    moe_offsets(p, l, smem, TIDX);
    const PG8_LAS int* po = (const PG8_LAS int*)(PG8_LAS unsigned char*)(smem + LDS_PO);
    pg8::MoeOrder S; S.tokof = nullptr; S.po = po; S.lc = (const PG8_LAS int*)(PG8_LAS unsigned char*)(smem + LDS_LC); S.rowbytes = 0; S.G = gridDim.x; S.c = BIDX; S.nblk = po[64] / 256; S.npn = 8; S.be = (const PG8_LAS int*)(PG8_LAS unsigned char*)(smem + LDS_BE); S.XS = (const char*)(p.ws + WS_ACT); S.HS = (const char*)(p.ws + WS_ACT) + (size_t)NSLOT * 512 * 2; S.W = (const char*)wl_ptr(p, l, WL_EDN);
    S.a_tile = (size_t)256 * 512 * 2; S.w_exp = (size_t)DM * 512 * 2; S.w_tile = (size_t)256 * 512 * 2;
    pg8::EpiStoreFp8 E{(unsigned char*)(p.ws + WS_YS)};
    pg8::gemm_phase((PG8_LAS unsigned char*)smem, 512, S, E, TIDX);
}

typedef short bf16x8_t __attribute__((ext_vector_type(8)));
typedef float f32x16_t __attribute__((ext_vector_type(16)));
#define LASP __attribute__((address_space(3)))
DI void st_vt(const Params& p, int l, unsigned char* smem, const int WV) {
    const int TIDX = opq_tid(WV), BIDX = opq_bid();
    const bf16_t* Y = (const bf16_t*)(p.ws + WS_Y); bf16_t* VT = (bf16_t*)(p.ws + WS_VT);
    LDSF bf16_t* T = (LDSF bf16_t*)(LDSF unsigned char*)smem;
    constexpr int TSZ = 128 * 72;
    for (int u0 = BIDX; u0 < NB * 64 * 4; u0 += 4 * gridDim.x) {
        { const int tok = TIDX & 63, dseg = (TIDX >> 6) * 16; uint4 v[4][2];
#pragma unroll
          for (int k = 0; k < 4; ++k) { const int u = u0 + k * gridDim.x;
              if (u < NB * 64 * 4) { const int b = u >> 8, tile = (u >> 2) & 63, wh = u & 3, br = 1 + (wh >> 1), g = wh & 1;
                  const uint4* src = (const uint4*)(Y + ((size_t)b * SEQ + tile * 64 + tok) * LDY + Y_KV + br * 512 + 256 + g * 128 + dseg); v[k][0] = src[0]; v[k][1] = src[1]; }
              else { v[k][0] = make_uint4(0u, 0u, 0u, 0u); v[k][1] = v[k][0]; } }
          const int pos = (tok & ~15) | kperm16(tok & 15);
#pragma unroll
          for (int k = 0; k < 4; ++k) { const unsigned w[8] = {v[k][0].x, v[k][0].y, v[k][0].z, v[k][0].w, v[k][1].x, v[k][1].y, v[k][1].z, v[k][1].w};
#pragma unroll
              for (int i = 0; i < 8; ++i) { T[k * TSZ + (dseg + 2 * i) * 72 + pos] = (bf16_t)(w[i] & 0xffffu); T[k * TSZ + (dseg + 2 * i + 1) * 72 + pos] = (bf16_t)(w[i] >> 16); } } }
        __syncthreads();
        { const int d = TIDX >> 2, seg = (TIDX & 3) * 16;
          typedef unsigned u4v_t __attribute__((ext_vector_type(4)));
#pragma unroll
          for (int k = 0; k < 4; ++k) { const int u = u0 + k * gridDim.x;
              if (u < NB * 64 * 4) { const int b = u >> 8, tile = (u >> 2) & 63, wh = u & 3, br = 1 + (wh >> 1), g = wh & 1;
                  const LDSF u4v_t* sp = (const LDSF u4v_t*)(T + k * TSZ + d * 72 + seg);
                  u4v_t* dst = (u4v_t*)(VT + ((size_t)((b * 2 + g) * 2 + (br - 1)) * 128 + d) * SEQ + tile * 64 + seg); const u4v_t s0 = sp[0], s1 = sp[1]; dst[0] = s0; dst[1] = s1; } } }
        __syncthreads();
    }
}
DI float fast_exp2(float x) { return __builtin_amdgcn_exp2f(x); }
#define DSR(dst, addr, off) asm volatile("ds_read_b128 %0, %1 offset:%2" : "=v"(dst) : "v"(addr), "i"(off) : "memory")
#define LWAIT(n, var) asm volatile("s_waitcnt lgkmcnt(" #n ")" : "+v"(var) :: "memory")
DI void qk_tile_pipe(f32x16_t& s0, f32x16_t& s1, const unsigned kb, const int xh, const bf16x8_t (&qf)[8]) {
    bf16x8_t f0, f1, f2, f3;
#pragma unroll
    for (int r = 0; r < 16; ++r) { s0[r] = 0.f; s1[r] = 0.f; }
    DSR(f0, (kb + (unsigned)((0 ^ xh) << 5)), 0);
    DSR(f1, (kb + (unsigned)((0 ^ xh) << 5)), 8192);
    DSR(f2, (kb + (unsigned)((1 ^ xh) << 5)), 0);
    DSR(f3, (kb + (unsigned)((1 ^ xh) << 5)), 8192);
    LWAIT(3, f0); s0 = __builtin_amdgcn_mfma_f32_32x32x16_bf16(f0, qf[0], s0, 0, 0, 0); DSR(f0, (kb + (unsigned)((2 ^ xh) << 5)), 0);
    LWAIT(3, f1); s1 = __builtin_amdgcn_mfma_f32_32x32x16_bf16(f1, qf[0], s1, 0, 0, 0); DSR(f1, (kb + (unsigned)((2 ^ xh) << 5)), 8192);
    LWAIT(3, f2); s0 = __builtin_amdgcn_mfma_f32_32x32x16_bf16(f2, qf[1], s0, 0, 0, 0); DSR(f2, (kb + (unsigned)((3 ^ xh) << 5)), 0);
    LWAIT(3, f3); s1 = __builtin_amdgcn_mfma_f32_32x32x16_bf16(f3, qf[1], s1, 0, 0, 0); DSR(f3, (kb + (unsigned)((3 ^ xh) << 5)), 8192);
    LWAIT(3, f0); s0 = __builtin_amdgcn_mfma_f32_32x32x16_bf16(f0, qf[2], s0, 0, 0, 0); DSR(f0, (kb + (unsigned)((4 ^ xh) << 5)), 0);
    LWAIT(3, f1); s1 = __builtin_amdgcn_mfma_f32_32x32x16_bf16(f1, qf[2], s1, 0, 0, 0); DSR(f1, (kb + (unsigned)((4 ^ xh) << 5)), 8192);
    LWAIT(3, f2); s0 = __builtin_amdgcn_mfma_f32_32x32x16_bf16(f2, qf[3], s0, 0, 0, 0); DSR(f2, (kb + (unsigned)((5 ^ xh) << 5)), 0);
    LWAIT(3, f3); s1 = __builtin_amdgcn_mfma_f32_32x32x16_bf16(f3, qf[3], s1, 0, 0, 0); DSR(f3, (kb + (unsigned)((5 ^ xh) << 5)), 8192);
    LWAIT(3, f0); s0 = __builtin_amdgcn_mfma_f32_32x32x16_bf16(f0, qf[4], s0, 0, 0, 0); DSR(f0, (kb + (unsigned)((6 ^ xh) << 5)), 0);
    LWAIT(3, f1); s1 = __builtin_amdgcn_mfma_f32_32x32x16_bf16(f1, qf[4], s1, 0, 0, 0); DSR(f1, (kb + (unsigned)((6 ^ xh) << 5)), 8192);
    LWAIT(3, f2); s0 = __builtin_amdgcn_mfma_f32_32x32x16_bf16(f2, qf[5], s0, 0, 0, 0); DSR(f2, (kb + (unsigned)((7 ^ xh) << 5)), 0);
    LWAIT(3, f3); s1 = __builtin_amdgcn_mfma_f32_32x32x16_bf16(f3, qf[5], s1, 0, 0, 0); DSR(f3, (kb + (unsigned)((7 ^ xh) << 5)), 8192);
    LWAIT(3, f0); s0 = __builtin_amdgcn_mfma_f32_32x32x16_bf16(f0, qf[6], s0, 0, 0, 0);
    LWAIT(2, f1); s1 = __builtin_amdgcn_mfma_f32_32x32x16_bf16(f1, qf[6], s1, 0, 0, 0);
    LWAIT(1, f2); s0 = __builtin_amdgcn_mfma_f32_32x32x16_bf16(f2, qf[7], s0, 0, 0, 0);
    LWAIT(0, f3); s1 = __builtin_amdgcn_mfma_f32_32x32x16_bf16(f3, qf[7], s1, 0, 0, 0);
}
DI void pv_tile_pipe(f32x16_t (&O)[4], const unsigned vb, const int yh, const bf16x8_t (&pf)[4]) {
    bf16x8_t f0, f1, f2, f3;
    const unsigned av0 = vb + (unsigned)((0 ^ yh) << 5), av1 = vb + (unsigned)((1 ^ yh) << 5), av2 = vb + (unsigned)((2 ^ yh) << 5), av3 = vb + (unsigned)((3 ^ yh) << 5);
    DSR(f0, av0, 0);
    DSR(f1, av0, 4096);
    DSR(f2, av0, 8192);
    DSR(f3, av0, 12288);
    LWAIT(3, f0); O[0] = __builtin_amdgcn_mfma_f32_32x32x16_bf16(f0, pf[0], O[0], 0, 0, 0); DSR(f0, av1, 0);
    LWAIT(3, f1); O[1] = __builtin_amdgcn_mfma_f32_32x32x16_bf16(f1, pf[0], O[1], 0, 0, 0); DSR(f1, av1, 4096);
    LWAIT(3, f2); O[2] = __builtin_amdgcn_mfma_f32_32x32x16_bf16(f2, pf[0], O[2], 0, 0, 0); DSR(f2, av1, 8192);
    LWAIT(3, f3); O[3] = __builtin_amdgcn_mfma_f32_32x32x16_bf16(f3, pf[0], O[3], 0, 0, 0); DSR(f3, av1, 12288);
    LWAIT(3, f0); O[0] = __builtin_amdgcn_mfma_f32_32x32x16_bf16(f0, pf[1], O[0], 0, 0, 0); DSR(f0, av2, 0);
    LWAIT(3, f1); O[1] = __builtin_amdgcn_mfma_f32_32x32x16_bf16(f1, pf[1], O[1], 0, 0, 0); DSR(f1, av2, 4096);
    LWAIT(3, f2); O[2] = __builtin_amdgcn_mfma_f32_32x32x16_bf16(f2, pf[1], O[2], 0, 0, 0); DSR(f2, av2, 8192);
    LWAIT(3, f3); O[3] = __builtin_amdgcn_mfma_f32_32x32x16_bf16(f3, pf[1], O[3], 0, 0, 0); DSR(f3, av2, 12288);
    LWAIT(3, f0); O[0] = __builtin_amdgcn_mfma_f32_32x32x16_bf16(f0, pf[2], O[0], 0, 0, 0); DSR(f0, av3, 0);
    LWAIT(3, f1); O[1] = __builtin_amdgcn_mfma_f32_32x32x16_bf16(f1, pf[2], O[1], 0, 0, 0); DSR(f1, av3, 4096);
    LWAIT(3, f2); O[2] = __builtin_amdgcn_mfma_f32_32x32x16_bf16(f2, pf[2], O[2], 0, 0, 0); DSR(f2, av3, 8192);
    LWAIT(3, f3); O[3] = __builtin_amdgcn_mfma_f32_32x32x16_bf16(f3, pf[2], O[3], 0, 0, 0); DSR(f3, av3, 12288);
    LWAIT(3, f0); O[0] = __builtin_amdgcn_mfma_f32_32x32x16_bf16(f0, pf[3], O[0], 0, 0, 0);
    LWAIT(2, f1); O[1] = __builtin_amdgcn_mfma_f32_32x32x16_bf16(f1, pf[3], O[1], 0, 0, 0);
    LWAIT(1, f2); O[2] = __builtin_amdgcn_mfma_f32_32x32x16_bf16(f2, pf[3], O[2], 0, 0, 0);
    LWAIT(0, f3); O[3] = __builtin_amdgcn_mfma_f32_32x32x16_bf16(f3, pf[3], O[3], 0, 0, 0);
}
#undef DSR
#undef LWAIT
template <int BR>
DI float attn_mask_max(f32x16_t& s0, f32x16_t& s1, int j, int qb, int qoff, int hi, unsigned long long sel) {
    constexpr float C2 = 0.08838834764831845f * 1.4426950408889634f;
    const float NEGINF = -__builtin_inff();
    if (j == qb) {
#pragma unroll
        for (int r = 0; r < 16; ++r) { const int kk = (r & 3) + 8 * (r >> 2) + 4 * hi; if (kk > qoff) s0[r] = NEGINF; if (kk + 32 > qoff) s1[r] = NEGINF; }
    } else if (BR == 1) { const bool on = (sel >> j) & 1ull;
        if (!__all(on)) {
#pragma unroll
            for (int r = 0; r < 16; ++r) { s0[r] = on ? s0[r] : NEGINF; s1[r] = on ? s1[r] : NEGINF; } }
    } else if (j == qb - 8) {
#pragma unroll
        for (int r = 0; r < 16; ++r) { const int kk = (r & 3) + 8 * (r >> 2) + 4 * hi; if (kk <= qoff) s0[r] = NEGINF; if (kk + 32 <= qoff) s1[r] = NEGINF; }
    }
    float mx = s0[0];
#pragma unroll
    for (int r = 1; r < 16; ++r) mx = fmaxf(mx, s0[r]);
#pragma unroll
    for (int r = 0; r < 16; ++r) mx = fmaxf(mx, s1[r]);
    auto sw = __builtin_amdgcn_permlane32_swap(__float_as_uint(mx), __float_as_uint(mx), false, false);
    return fmaxf(__uint_as_float(sw[0]), __uint_as_float(sw[1])) * C2;
}
template <int BR>
DI void attn_branch(LASP unsigned char* ldsw, const bf16_t* yb, const bf16_t* vtb, int g, int qb, int half, int qi, int hi, int wid, int lane, const bf16x8_t (&qf)[8], unsigned long long sel, unsigned long long tiles, f32x16_t (&O)[4]) {
    constexpr float C2 = 0.08838834764831845f * 1.4426950408889634f;
    const LASP unsigned char* lds = ldsw;
    const bool grpB = wid >= 4;
    unsigned kgo[2], vgo[2];
#pragma unroll
    for (int i = 0; i < 2; ++i) { const int pp = (2 * wid + i) * 64 + lane; const int key = pp >> 4, c = (pp & 15) ^ (key & 15); kgo[i] = (unsigned)(key * (LDY * 2) + c * 16);
        const int d = pp >> 3, cv = (pp & 7) ^ ((d >> 1) & 7); vgo[i] = (unsigned)(d * (SEQ * 2) + cv * 16); }
    const char* kbase = (const char*)(yb + Y_KV + BR * 512 + g * 128);
    const char* vbase = (const char*)(vtb + (size_t)(BR - 1) * 128 * SEQ);
#define DMA_TILE(jj, buf) do { const char* kb_ = kbase + (size_t)(jj) * (64 * LDY * 2); const char* vb_ = vbase + (size_t)(jj) * 128; \
        _Pragma("unroll") for (int i_ = 0; i_ < 2; ++i_) { \
            __builtin_amdgcn_global_load_lds((const unsigned*)(kb_ + kgo[i_]), (LASP unsigned*)(ldsw + (buf) * 32768u + (unsigned)((2 * wid + i_) * 1024)), 16, 0, 0); \
            __builtin_amdgcn_global_load_lds((const unsigned*)(vb_ + vgo[i_]), (LASP unsigned*)(ldsw + (buf) * 32768u + 16384u + (unsigned)((2 * wid + i_) * 1024)), 16, 0, 0); } } while (0)
#define BAR_ONLY() do { asm volatile("" ::: "memory"); __builtin_amdgcn_s_barrier(); asm volatile("" ::: "memory"); } while (0)
#define WAIT_DMA(newest_in_flight) do { if (newest_in_flight) asm volatile("s_waitcnt vmcnt(4)" ::: "memory"); else asm volatile("s_waitcnt vmcnt(0)" ::: "memory"); } while (0)
    const int x = qi & 15, xh = x >> 1; const unsigned kra = (unsigned)(qi * 256 + (((hi ^ x) & 1) << 4));
    const int yv = (qi >> 1) & 7, yh = yv >> 1; const unsigned vra = (unsigned)(16384 + qi * 128 + (((hi ^ yv) & 1) << 4));
    const int qoff = 32 * half + qi;
    float m_run = -1.0e30f, l_run = 0.f;
#pragma unroll
    for (int dt = 0; dt < 4; ++dt)
#pragma unroll
        for (int r = 0; r < 16; ++r) O[dt][r] = 0.f;
    unsigned long long rem = tiles;
    int jc = __builtin_ctzll(rem); rem &= rem - 1;
    int j1 = rem ? __builtin_ctzll(rem) : -1; rem &= rem - 1;
    int j2 = rem ? __builtin_ctzll(rem) : -1; rem &= rem - 1;
    asm volatile("s_waitcnt vmcnt(0)" ::: "memory");
    DMA_TILE(jc, 0u);
    if (j1 >= 0) DMA_TILE(j1, 1u);
    if (j2 >= 0) DMA_TILE(j2, 2u);
    WAIT_DMA(j2 >= 0);
    BAR_ONLY();
    f32x16_t s0, s1;
    qk_tile_pipe(s0, s1, (unsigned)(uintptr_t)ldsw + kra, xh, qf);
    m_run = fmaxf(m_run, attn_mask_max<BR>(s0, s1, jc, qb, qoff, hi, sel));
    if (grpB) BAR_ONLY();
    unsigned cur = 0;
    for (;;) {
        const int j3 = rem ? __builtin_ctzll(rem) : -1; rem &= rem - 1;
        if (grpB && j3 >= 0) DMA_TILE(j3, ((cur + 3u) & 3u));
        float ps = 0.f;
#pragma unroll
        for (int r = 0; r < 16; ++r) { s0[r] = fast_exp2(s0[r] * C2 - m_run); s1[r] = fast_exp2(s1[r] * C2 - m_run); ps += s0[r] + s1[r]; }
        l_run += ps;
        bf16x8_t pf[4];
#pragma unroll
        for (int s = 0; s < 4; ++s) { const f32x16_t& sv = (s < 2) ? s0 : s1; const int o = (s & 1) * 8;
            typedef unsigned u4_t __attribute__((ext_vector_type(4))); u4_t ww = {pg8::cvt_pk_bf16(sv[o + 0], sv[o + 1]), pg8::cvt_pk_bf16(sv[o + 2], sv[o + 3]), pg8::cvt_pk_bf16(sv[o + 4], sv[o + 5]), pg8::cvt_pk_bf16(sv[o + 6], sv[o + 7])};
            pf[s] = *reinterpret_cast<bf16x8_t*>(&ww); }
        if (!grpB) WAIT_DMA(j2 >= 0);
        BAR_ONLY();
        if (!grpB && j3 >= 0) DMA_TILE(j3, ((cur + 3u) & 3u));
        __builtin_amdgcn_s_setprio(1);
        const unsigned lbase = (unsigned)(uintptr_t)ldsw;
        pv_tile_pipe(O, lbase + cur * 32768u + vra, yh, pf);
        if (j1 >= 0) qk_tile_pipe(s0, s1, lbase + ((cur + 1u) & 3u) * 32768u + kra, xh, qf);
        __builtin_amdgcn_s_setprio(0);
        if (grpB) WAIT_DMA(j3 >= 0);
        BAR_ONLY();
        if (j1 < 0) break;
        { const float mx = attn_mask_max<BR>(s0, s1, j1, qb, qoff, hi, sel);
          if (__any(mx > m_run + 8.f)) { const float m_new = fmaxf(m_run, mx), alpha = fast_exp2(m_run - m_new); m_run = m_new; l_run *= alpha;
#pragma unroll
              for (int dt = 0; dt < 4; ++dt)
#pragma unroll
                  for (int r = 0; r < 16; ++r) O[dt][r] *= alpha; } }
        cur = (cur + 1u) & 3u; jc = j1; j1 = j2; j2 = j3;
    }
    if (!grpB) BAR_ONLY();
    asm volatile("s_waitcnt vmcnt(0)" ::: "memory");
    BAR_ONLY();
#undef DMA_TILE
#undef BAR_ONLY
#undef WAIT_DMA
    float lt;
    { auto sw = __builtin_amdgcn_permlane32_swap(__float_as_uint(l_run), __float_as_uint(l_run), false, false); lt = __uint_as_float(sw[0]) + __uint_as_float(sw[1]); }
    const float inv = 1.f / lt;
#pragma unroll
    for (int dt = 0; dt < 4; ++dt)
#pragma unroll
        for (int r = 0; r < 16; ++r) O[dt][r] *= inv;
}
DI void st_attn_mm(const Params& p, int l, unsigned char* smem, const int WV) {
    const int TIDX = opq_tid(WV), BIDX = opq_bid();
    const int wid = __builtin_amdgcn_readfirstlane(TIDX >> 6), lane0 = TIDX & 63, rr = wid >> 1, half = wid & 1;
    const bf16_t* Y = (const bf16_t*)(p.ws + WS_Y); const float* OC = (const float*)(p.ws + WS_OCMP); const unsigned long long* SEL = (const unsigned long long*)(p.ws + WS_SEL);
    bf16_t* YM = (bf16_t*)(p.ws + WS_YMIX); const bf16_t* VT = (const bf16_t*)(p.ws + WS_VT);
    const LASP unsigned char* lds = (const LASP unsigned char*)smem;
    LASP unsigned long long* sor = (LASP unsigned long long*)(LASP unsigned char*)(smem + 131072);
    for (int item = BIDX; item < 256; item += gridDim.x) {
        const int bg = item & 7, pr = item >> 3, b = bg >> 1, g = bg & 1, h = g * 4 + rr;
        const bf16_t* yb = Y + (size_t)b * SEQ * LDY; const bf16_t* vtb = VT + (size_t)bg * 2 * 128 * SEQ;
#pragma unroll 1
        for (int pass = 0; pass < 2; ++pass) {
            int lane = lane0; asm volatile("" : "+v"(lane));
            const int qi = lane & 31, hi = lane >> 5;
            const int qb = pass ? pr : 63 - pr, t = qb * 64 + 32 * half + qi;
            const bf16_t* yrow = yb + (size_t)t * LDY;
            bf16x8_t qf[8];
#pragma unroll
            for (int ks = 0; ks < 8; ++ks) qf[ks] = *(const bf16x8_t*)(yrow + Y_QN + h * 128 + 16 * ks + 8 * hi);
            const unsigned long long sel = SEL[(size_t)bg * SEQ + t];
            { unsigned lo = (unsigned)sel, hi32 = (unsigned)(sel >> 32);
#pragma unroll
              for (int o = 1; o < 32; o <<= 1) { lo |= __shfl_xor(lo, o); hi32 |= __shfl_xor(hi32, o); }
              if (wid < 2 && lane == 0) sor[wid] = ((unsigned long long)hi32 << 32) | lo; }
            __syncthreads();
            const unsigned long long lowmask = (qb == 63) ? ~0ull : ((2ull << qb) - 1ull);
            const unsigned long long tiles_s = (sor[0] | sor[1] | 1ull | (1ull << qb)) & lowmask;
            const int jlo = qb >= 8 ? qb - 8 : 0; const unsigned long long tiles_w = lowmask & ~((1ull << jlo) - 1ull);
            f32x16_t O[4];
            const float* gp_ = (const float*)(p.ws + WS_GATEP) + ((size_t)b * SEQ + t) * 256 + h * 3;
            const float g0 = sigmoid_f(gp_[0] + gp_[(size_t)NT * 256]), g1 = sigmoid_f(gp_[1] + gp_[(size_t)NT * 256 + 1]), g2 = sigmoid_f(gp_[2] + gp_[(size_t)NT * 256 + 2]);
            const float* ocrow = OC + ((size_t)b * SEQ + t) * 1024 + h * 128 + 4 * hi; float* ptrow = (float*)(p.ws + WS_PART) + ((size_t)b * SEQ + t) * 1024 + h * 128 + 4 * hi;
            attn_branch<1>((LASP unsigned char*)smem, yb, vtb, g, qb, half, qi, hi, wid, lane, qf, sel, tiles_s, O);
            { float4 cc[16];
#pragma unroll
              for (int i = 0; i < 16; ++i) cc[i] = *(const float4*)(ocrow + 32 * (i >> 2) + 8 * (i & 3));
#pragma unroll
              for (int i = 0; i < 16; ++i) { const int dt = i >> 2, rq = i & 3; float4 c = cc[i];
                  c.x = g0 * c.x + g1 * O[dt][4 * rq + 0]; c.y = g0 * c.y + g1 * O[dt][4 * rq + 1]; c.z = g0 * c.z + g1 * O[dt][4 * rq + 2]; c.w = g0 * c.w + g1 * O[dt][4 * rq + 3];
                  *(float4*)(ptrow + 32 * dt + 8 * rq) = c; } }
            attn_branch<2>((LASP unsigned char*)smem, yb, vtb, g, qb, half, qi, hi, wid, lane, qf, sel, tiles_w, O);
            float ss = 0.f;
            { float4 cc[16];
#pragma unroll
              for (int i = 0; i < 16; ++i) cc[i] = *(const float4*)(ptrow + 32 * (i >> 2) + 8 * (i & 3));
#pragma unroll
              for (int i = 0; i < 16; ++i) { const int dt = i >> 2, rq = i & 3; const float4 c = cc[i];
                  O[dt][4 * rq + 0] = c.x + g2 * O[dt][4 * rq + 0]; O[dt][4 * rq + 1] = c.y + g2 * O[dt][4 * rq + 1]; O[dt][4 * rq + 2] = c.z + g2 * O[dt][4 * rq + 2]; O[dt][4 * rq + 3] = c.w + g2 * O[dt][4 * rq + 3];
                  ss += O[dt][4 * rq + 0] * O[dt][4 * rq + 0] + O[dt][4 * rq + 1] * O[dt][4 * rq + 1] + O[dt][4 * rq + 2] * O[dt][4 * rq + 2] + O[dt][4 * rq + 3] * O[dt][4 * rq + 3]; } }
            { auto sw = __builtin_amdgcn_permlane32_swap(__float_as_uint(ss), __float_as_uint(ss), false, false); ss = __uint_as_float(sw[0]) + __uint_as_float(sw[1]); }
            const float rn = rsqrtf(ss * (1.f / 128.f) + EPS);
            const float* ng = p.nsa_g + (size_t)l * 1024 + h * 128 + 4 * hi; bf16_t* orow = YM + ((size_t)b * SEQ + t) * DM + 512 + h * 128 + 4 * hi;
            { float4 gg[16];
#pragma unroll
              for (int i = 0; i < 16; ++i) gg[i] = *(const float4*)(ng + 32 * (i >> 2) + 8 * (i & 3));
#pragma unroll
              for (int i = 0; i < 16; ++i) { const int dt = i >> 2, rq = i & 3;
                  uint2 w; w.x = pg8::cvt_pk_bf16(O[dt][4 * rq + 0] * rn * gg[i].x, O[dt][4 * rq + 1] * rn * gg[i].y); w.y = pg8::cvt_pk_bf16(O[dt][4 * rq + 2] * rn * gg[i].z, O[dt][4 * rq + 3] * rn * gg[i].w);
                  *(uint2*)(orow + 32 * dt + 8 * rq) = w; } }
        }
    }
}

constexpr int RP = 136;
DI int kv_unit(int c, int i, int G) {
    if (G == 256) { if (c < 192) return i == 0 ? c : -1; return i < 5 ? 192 + (c - 192) * 5 + i : -1; }
    const int u = c + i * G; return u < 16 * 32 ? u : -1;
}
DI void st_kvchunk_mm(const Params& p, int l, unsigned char* smem, const int WV) {
    const int TIDX = opq_tid(WV), BIDX = opq_bid();
    const int wid = __builtin_amdgcn_readfirstlane(TIDX >> 6), lane = TIDX & 63, li = lane & 31, hi = lane >> 5;
    const bf16_t* Y = (const bf16_t*)(p.ws + WS_Y); float* KVC = (float*)(p.ws + WS_KVC);
    LDSF bf16_t* KT = (LDSF bf16_t*)smem; LDSF bf16_t* VTt = KT + 128 * RP;
    const int m = TIDX >> 2, seg = (TIDX & 3) * 32;
    uint4 kq[4], vq[4];
    const int G = gridDim.x; int u = kv_unit(BIDX, 0, G);
    if (u >= 0) { const int bh = u >> 5, c = u & 31, b = bh >> 2, h = bh & 3; const bf16_t* row = Y + ((size_t)b * SEQ + c * 128 + m) * LDY;
        const uint4* ks = (const uint4*)(row + Y_KR + h * 128 + seg); const uint4* vs = (const uint4*)(row + Y_VR + h * 128 + seg);
#pragma unroll
        for (int q4 = 0; q4 < 4; ++q4) { kq[q4] = ks[q4]; vq[q4] = vs[q4]; } }
    for (int it = 0; u >= 0; ++it) {
        const int bh = u >> 5, c = u & 31, h = bh & 3; const float lg = ret_loggamma(h);
        { const float z = __expf((float)(127 - m) * lg) * 0.08838834764831845f;
#pragma unroll
          for (int q4 = 0; q4 < 4; ++q4) { const uint4 kk = kq[q4], vv = vq[q4]; const unsigned kw[4] = {kk.x, kk.y, kk.z, kk.w}, vw[4] = {vv.x, vv.y, vv.z, vv.w};
#pragma unroll
              for (int i = 0; i < 4; ++i) { const int d = seg + q4 * 8 + 2 * i;
                  KT[d * RP + m] = f2bf(__uint_as_float(kw[i] << 16) * z); KT[(d + 1) * RP + m] = f2bf(__uint_as_float(kw[i] & 0xffff0000u) * z);
                  VTt[d * RP + m] = (bf16_t)(vw[i] & 0xffffu); VTt[(d + 1) * RP + m] = (bf16_t)(vw[i] >> 16); } } }
        const int un = kv_unit(BIDX, it + 1, G);
        { if (un >= 0) { const int bh2 = un >> 5, c2 = un & 31, b2 = bh2 >> 2, h2 = bh2 & 3; const bf16_t* row = Y + ((size_t)b2 * SEQ + c2 * 128 + m) * LDY;
              const uint4* ks = (const uint4*)(row + Y_KR + h2 * 128 + seg); const uint4* vs = (const uint4*)(row + Y_VR + h2 * 128 + seg);
#pragma unroll
              for (int q4 = 0; q4 < 4; ++q4) { kq[q4] = ks[q4]; vq[q4] = vs[q4]; } } }
        __syncthreads();
        const int db = wid & 3, eb0 = 2 * (wid >> 2);
        f32x16_t acc[2];
#pragma unroll
        for (int r = 0; r < 16; ++r) { acc[0][r] = 0.f; acc[1][r] = 0.f; }
#pragma unroll
        for (int ks = 0; ks < 8; ++ks) { const bf16x8_t a = *(const LDSF bf16x8_t*)(KT + (32 * db + li) * RP + 16 * ks + 8 * hi);
#pragma unroll
            for (int t = 0; t < 2; ++t) { const bf16x8_t bb = *(const LDSF bf16x8_t*)(VTt + (32 * (eb0 + t) + li) * RP + 16 * ks + 8 * hi); acc[t] = __builtin_amdgcn_mfma_f32_32x32x16_bf16(a, bb, acc[t], 0, 0, 0); } }
#pragma unroll
        for (int t = 0; t < 2; ++t) { float* orow = KVC + ((size_t)(bh * 32 + c) * 128 + 32 * (eb0 + t) + li) * 128 + 32 * db + 4 * hi;
#pragma unroll
            for (int rq = 0; rq < 4; ++rq) *(float4*)(orow + 8 * rq) = make_float4(acc[t][4 * rq], acc[t][4 * rq + 1], acc[t][4 * rq + 2], acc[t][4 * rq + 3]); }
        __syncthreads();
        u = un;
    }
}
DI void st_retout_mm(const Params& p, int l, unsigned char* smem, const int WV) {
    const int TIDX = opq_tid(WV), BIDX = opq_bid();
    const int wid = __builtin_amdgcn_readfirstlane(TIDX >> 6), lane = TIDX & 63, li = lane & 31, hi = lane >> 5, nb = wid & 3, eh = wid >> 2;
    const bf16_t* Y = (const bf16_t*)(p.ws + WS_Y); const bf16_t* STB = (const bf16_t*)(p.ws + WS_STATEB); bf16_t* YM = (bf16_t*)(p.ws + WS_YMIX);
    LDSF bf16_t* KL = (LDSF bf16_t*)smem; LDSF bf16_t* VL = KL + 128 * RP; LDSF bf16_t* SL = VL + 128 * RP; LDSF float* ssq = (LDSF float*)(SL + 128 * RP);
    typedef unsigned u4v_t __attribute__((ext_vector_type(4)));
    const int m = TIDX >> 2, seg = (TIDX & 3) * 32;
    u4v_t kq[4], sq[4]; uint4 vq[4]; bf16x8_t qn[8];
    if (BIDX < 16 * 32) { const int bh = BIDX >> 5, c = BIDX & 31, b = bh >> 2, h = bh & 3; const bf16_t* row = Y + ((size_t)b * SEQ + c * 128 + m) * LDY;
        const u4v_t* ks = (const u4v_t*)(row + Y_KR + h * 128 + seg); const uint4* vs = (const uint4*)(row + Y_VR + h * 128 + seg);
        const u4v_t* ss = (const u4v_t*)(STB + (size_t)(bh * 32 + c) * 16384 + (size_t)m * 128 + seg);
        const bf16_t* qrow = Y + ((size_t)b * SEQ + c * 128 + 32 * nb + li) * LDY;
#pragma unroll
        for (int q4 = 0; q4 < 4; ++q4) { kq[q4] = ks[q4]; sq[q4] = ss[q4]; vq[q4] = vs[q4]; }
#pragma unroll
        for (int ks2 = 0; ks2 < 8; ++ks2) qn[ks2] = *(const bf16x8_t*)(qrow + Y_QR + h * 128 + 16 * ks2 + 8 * hi); }
    for (int u = BIDX; u < 16 * 32; u += gridDim.x) {
        const int bh = u >> 5, c = u & 31, b = bh >> 2, h = bh & 3; const float lg2 = ret_loggamma(h) * 1.4426950408889634f;
        { const int pos = (m & ~15) | kperm16(m & 15);
#pragma unroll
          for (int q4 = 0; q4 < 4; ++q4) { *(LDSF u4v_t*)(KL + m * RP + seg + q4 * 8) = kq[q4]; *(LDSF u4v_t*)(SL + m * RP + seg + q4 * 8) = sq[q4];
              const uint4 vv = vq[q4]; const unsigned vw[4] = {vv.x, vv.y, vv.z, vv.w};
#pragma unroll
              for (int i = 0; i < 4; ++i) { const int e = seg + q4 * 8 + 2 * i; VL[e * RP + pos] = (bf16_t)(vw[i] & 0xffffu); VL[(e + 1) * RP + pos] = (bf16_t)(vw[i] >> 16); } } }
        const int n = 32 * nb + li; const bf16_t* qrow = Y + ((size_t)b * SEQ + c * 128 + n) * LDY;
        bf16x8_t qf[8];
#pragma unroll
        for (int ks = 0; ks < 8; ++ks) qf[ks] = qn[ks];
        { const int un = u + gridDim.x;
          if (un < 16 * 32) { const int bh2 = un >> 5, c2 = un & 31, b2 = bh2 >> 2, h2 = bh2 & 3; const bf16_t* row = Y + ((size_t)b2 * SEQ + c2 * 128 + m) * LDY;
              const u4v_t* ks = (const u4v_t*)(row + Y_KR + h2 * 128 + seg); const uint4* vs = (const uint4*)(row + Y_VR + h2 * 128 + seg);
              const u4v_t* ss = (const u4v_t*)(STB + (size_t)(bh2 * 32 + c2) * 16384 + (size_t)m * 128 + seg);
              const bf16_t* qrow2 = Y + ((size_t)b2 * SEQ + c2 * 128 + n) * LDY;
#pragma unroll
              for (int q4 = 0; q4 < 4; ++q4) { kq[q4] = ks[q4]; sq[q4] = ss[q4]; vq[q4] = vs[q4]; }
#pragma unroll
              for (int ks2 = 0; ks2 < 8; ++ks2) qn[ks2] = *(const bf16x8_t*)(qrow2 + Y_QR + h2 * 128 + 16 * ks2 + 8 * hi); } }
        __syncthreads();
        f32x16_t O[2];
#pragma unroll
        for (int r = 0; r < 16; ++r) { O[0][r] = 0.f; O[1][r] = 0.f; }
#pragma unroll
        for (int ks = 0; ks < 8; ++ks)
#pragma unroll
            for (int dt = 0; dt < 2; ++dt) { const bf16x8_t a = *(const LDSF bf16x8_t*)(SL + (64 * eh + 32 * dt + li) * RP + 16 * ks + 8 * hi); O[dt] = __builtin_amdgcn_mfma_f32_32x32x16_bf16(a, qf[ks], O[dt], 0, 0, 0); }
        { const float xi = fast_exp2((float)(n + 1) * lg2);
#pragma unroll
          for (int r = 0; r < 16; ++r) { O[0][r] *= xi; O[1][r] *= xi; } }
        for (int ms = 0; ms <= nb; ++ms) {
            f32x16_t s;
#pragma unroll
            for (int r = 0; r < 16; ++r) s[r] = 0.f;
#pragma unroll
            for (int ks = 0; ks < 8; ++ks) { const bf16x8_t a = *(const LDSF bf16x8_t*)(KL + (32 * ms + li) * RP + 16 * ks + 8 * hi); s = __builtin_amdgcn_mfma_f32_32x32x16_bf16(a, qf[ks], s, 0, 0, 0); }
#pragma unroll
            for (int r = 0; r < 16; ++r) { const int m = 32 * ms + (r & 3) + 8 * (r >> 2) + 4 * hi; const int df = n - m;
                s[r] = df >= 0 ? s[r] * 0.08838834764831845f * fast_exp2((float)df * lg2) : 0.f; }
#pragma unroll
            for (int sp = 0; sp < 2; ++sp) { const int o = sp * 8;
                typedef unsigned u4_t __attribute__((ext_vector_type(4))); u4_t ww = {pg8::cvt_pk_bf16(s[o + 0], s[o + 1]), pg8::cvt_pk_bf16(s[o + 2], s[o + 3]), pg8::cvt_pk_bf16(s[o + 4], s[o + 5]), pg8::cvt_pk_bf16(s[o + 6], s[o + 7])};
                const bf16x8_t pf = *reinterpret_cast<bf16x8_t*>(&ww);
#pragma unroll
                for (int dt = 0; dt < 2; ++dt) { const bf16x8_t a = *(const LDSF bf16x8_t*)(VL + (64 * eh + 32 * dt + li) * RP + 32 * ms + 16 * sp + 8 * hi); O[dt] = __builtin_amdgcn_mfma_f32_32x32x16_bf16(a, pf, O[dt], 0, 0, 0); } }
        }
        float ss = 0.f;
#pragma unroll
        for (int r = 0; r < 16; ++r) ss += O[0][r] * O[0][r] + O[1][r] * O[1][r];
        ss += __shfl_xor(ss, 32);
        if (hi == 0) ssq[wid * 32 + li] = ss;
        __syncthreads();
        const float rn = rsqrtf((ss + ssq[(wid ^ 4) * 32 + li]) * (1.f / 128.f) + EPS);
        const int e0 = 64 * eh + 4 * hi; const float* rg = p.ret_g + (size_t)l * 512 + h * 128 + e0; bf16_t* orow = YM + ((size_t)b * SEQ + c * 128 + n) * DM + 1536 + h * 128 + e0;
#pragma unroll
        for (int dt = 0; dt < 2; ++dt)
#pragma unroll
            for (int rq = 0; rq < 4; ++rq) { const int eo = 32 * dt + 8 * rq; const float4 gg = *(const float4*)(rg + eo); const uint2 gw = *(const uint2*)(qrow + Y_GR + h * 128 + e0 + eo);
                const float g0 = __uint_as_float(gw.x << 16), g1 = __uint_as_float(gw.x & 0xffff0000u), g2 = __uint_as_float(gw.y << 16), g3 = __uint_as_float(gw.y & 0xffff0000u);
                uint2 w; w.x = pg8::cvt_pk_bf16(silu_f(g0) * O[dt][4 * rq] * rn * gg.x, silu_f(g1) * O[dt][4 * rq + 1] * rn * gg.y);
                w.y = pg8::cvt_pk_bf16(silu_f(g2) * O[dt][4 * rq + 2] * rn * gg.z, silu_f(g3) * O[dt][4 * rq + 3] * rn * gg.w);
                *(uint2*)(orow + eo) = w; }
        __syncthreads();
    }
}

DI void st_cmpattn_mm(const Params& p, int l, unsigned char* smem, const int WV) {
    const int TIDX = opq_tid(WV), BIDX = opq_bid();
    const int wid = __builtin_amdgcn_readfirstlane(TIDX >> 6), lane = TIDX & 63, qi = lane & 31, hi = lane >> 5, rr = wid >> 1, half = wid & 1;
    constexpr float C2 = 0.08838834764831845f * 1.4426950408889634f;
    const float NEGINF = -__builtin_inff();
    const bf16_t* Y = (const bf16_t*)(p.ws + WS_Y); const bf16_t* KC = (const bf16_t*)(p.ws + WS_KC); const bf16_t* VCT = (const bf16_t*)(p.ws + WS_VC);
    float* OC = (float*)(p.ws + WS_OCMP); unsigned long long* SEL = (unsigned long long*)(p.ws + WS_SEL);
    const LASP unsigned char* lds = (const LASP unsigned char*)smem; LASP unsigned char* ldsw = (LASP unsigned char*)smem;
    int* impL = (int*)(smem + 131072);
    typedef unsigned u4v_t __attribute__((ext_vector_type(4)));
    const int skey = TIDX >> 3, scp = TIDX & 7; const unsigned kwa = (unsigned)(skey * 256 + (((2 * scp) ^ (skey & 15)) << 4));
    const int sd = TIDX >> 2, vcp = TIDX & 3; const unsigned vwa = (unsigned)(65536 + sd * 128 + (((2 * vcp) ^ ((sd >> 1) & 7)) << 4));
    const int x = qi & 15, xh = x >> 1; const unsigned kra = (unsigned)(qi * 256 + (((hi ^ x) & 1) << 4));
    const int yv = (qi >> 1) & 7, yh = yv >> 1; const unsigned vra = (unsigned)(65536 + qi * 128 + (((hi ^ yv) & 1) << 4));
    for (int item = BIDX; item < 256; item += gridDim.x) {
        const int bg = item & 7, pr = item >> 3, b = bg >> 1, g = bg & 1, h = g * 4 + rr;
#pragma unroll 1
        for (int pass = 0; pass < 2; ++pass) {
            const int qb = pass ? pr : 63 - pr, t = qb * 64 + 32 * half + qi;
            const int ntile = (4 * qb + 3 + 63) >> 6;
            const bf16_t* yrow = Y + ((size_t)b * SEQ + t) * LDY;
            bf16x8_t qf[8];
#pragma unroll
            for (int ks = 0; ks < 8; ++ks) qf[ks] = *(const bf16x8_t*)(yrow + Y_QN + h * 128 + 16 * ks + 8 * hi);
#pragma unroll 1
            for (int tl = 0; tl < ntile; tl += 2) {
                const int t2 = tl + 1 < ntile ? tl + 1 : tl;
                const u4v_t* ks = (const u4v_t*)(KC + ((size_t)bg * 256 + tl * 64 + skey) * 128 + scp * 16); const u4v_t* vs = (const u4v_t*)(VCT + ((size_t)bg * 128 + sd) * 256 + tl * 64 + vcp * 16);
                const u4v_t* ks2 = (const u4v_t*)(KC + ((size_t)bg * 256 + t2 * 64 + skey) * 128 + scp * 16); const u4v_t* vs2 = (const u4v_t*)(VCT + ((size_t)bg * 128 + sd) * 256 + t2 * 64 + vcp * 16);
                const u4v_t k0 = ks[0], k1 = ks[1], v0 = vs[0], v1 = vs[1], k2 = ks2[0], k3 = ks2[1], v2 = vs2[0], v3 = vs2[1];
                *(LASP u4v_t*)(ldsw + tl * 16384 + kwa) = k0; *(LASP u4v_t*)(ldsw + tl * 16384 + (kwa ^ 16u)) = k1; *(LASP u4v_t*)(ldsw + tl * 16384 + vwa) = v0; *(LASP u4v_t*)(ldsw + tl * 16384 + (vwa ^ 16u)) = v1;
                *(LASP u4v_t*)(ldsw + t2 * 16384 + kwa) = k2; *(LASP u4v_t*)(ldsw + t2 * 16384 + (kwa ^ 16u)) = k3; *(LASP u4v_t*)(ldsw + t2 * 16384 + vwa) = v2; *(LASP u4v_t*)(ldsw + t2 * 16384 + (vwa ^ 16u)) = v3; }
            for (int i = TIDX; i < 64 * 64; i += 512) impL[i] = 0;
            __syncthreads();
            const int cmax = t >= 31 ? (t - 31) >> 4 : -1;
            float m_run = -1.0e30f, l_run = 0.f;
            for (int tl = 0; tl < ntile; ++tl) {
                f32x16_t s0, s1;
                qk_tile_pipe(s0, s1, (unsigned)(uintptr_t)lds + (unsigned)(tl * 16384) + kra, xh, qf);
                float mx = NEGINF;
#pragma unroll
                for (int r = 0; r < 16; ++r) { const int c = tl * 64 + (r & 3) + 8 * (r >> 2) + 4 * hi; s0[r] = c <= cmax ? s0[r] * C2 : NEGINF; s1[r] = c + 32 <= cmax ? s1[r] * C2 : NEGINF; mx = fmaxf(mx, fmaxf(s0[r], s1[r])); }
                mx = fmaxf(mx, __shfl_xor(mx, 32));
                const float m_new = fmaxf(m_run, mx); float ps = 0.f;
#pragma unroll
                for (int r = 0; r < 16; ++r) ps += fast_exp2(s0[r] - m_new) + fast_exp2(s1[r] - m_new);
                l_run = l_run * fast_exp2(m_run - m_new) + ps; m_run = m_new;
            }
            l_run += __shfl_xor(l_run, 32);
            const float inv = l_run > 0.f ? 1.f / l_run : 0.f;
            f32x16_t O[4];
#pragma unroll
            for (int dt = 0; dt < 4; ++dt)
#pragma unroll
                for (int r = 0; r < 16; ++r) O[dt][r] = 0.f;
            LASP int* imrow = (LASP int*)(LASP unsigned char*)(smem + 131072) + (32 * half + qi) * 64;
            for (int tl = 0; tl < ntile; ++tl) {
                f32x16_t s0, s1;
                qk_tile_pipe(s0, s1, (unsigned)(uintptr_t)lds + (unsigned)(tl * 16384) + kra, xh, qf);
#pragma unroll
                for (int r = 0; r < 16; ++r) { const int c = tl * 64 + (r & 3) + 8 * (r >> 2) + 4 * hi;
                    s0[r] = c <= cmax ? fast_exp2(s0[r] * C2 - m_run) * inv : 0.f; s1[r] = c + 32 <= cmax ? fast_exp2(s1[r] * C2 - m_run) * inv : 0.f; }
#pragma unroll
                for (int sub = 0; sub < 2; ++sub)
#pragma unroll
                    for (int rq = 0; rq < 4; ++rq) { const f32x16_t& sv = sub ? s1 : s0; const int j = 16 * tl + 8 * sub + 2 * rq + hi;
                        const float hp = 0.5f * sv[4 * rq + 3]; const int ia = (int)((sv[4 * rq] + sv[4 * rq + 1] + sv[4 * rq + 2] + hp) * 67108864.f + 0.5f), ib = (int)(hp * 67108864.f + 0.5f);
                        (void)__hip_atomic_fetch_add(imrow + j, ia, __ATOMIC_RELAXED, __HIP_MEMORY_SCOPE_WORKGROUP); if (j < 63) (void)__hip_atomic_fetch_add(imrow + j + 1, ib, __ATOMIC_RELAXED, __HIP_MEMORY_SCOPE_WORKGROUP); }
                bf16x8_t pf[4];
#pragma unroll
                for (int s = 0; s < 4; ++s) { const f32x16_t& sv = (s < 2) ? s0 : s1; const int o = (s & 1) * 8;
                    u4v_t ww = {pg8::cvt_pk_bf16(sv[o + 0], sv[o + 1]), pg8::cvt_pk_bf16(sv[o + 2], sv[o + 3]), pg8::cvt_pk_bf16(sv[o + 4], sv[o + 5]), pg8::cvt_pk_bf16(sv[o + 6], sv[o + 7])}; pf[s] = *reinterpret_cast<bf16x8_t*>(&ww); }
                pv_tile_pipe(O, (unsigned)(uintptr_t)lds + (unsigned)(tl * 16384) + vra, yh, pf);
            }
            { float* ocrow = OC + ((size_t)b * SEQ + t) * 1024 + h * 128 + 4 * hi;
#pragma unroll
              for (int dt = 0; dt < 4; ++dt)
#pragma unroll
                  for (int rq = 0; rq < 4; ++rq) *(float4*)(ocrow + 32 * dt + 8 * rq) = make_float4(O[dt][4 * rq], O[dt][4 * rq + 1], O[dt][4 * rq + 2], O[dt][4 * rq + 3]); }
            __syncthreads();
            for (int qq = 0; qq < 8; ++qq) { const int q = wid * 8 + qq, tq = qb * 64 + q, jq = qb, j = lane; const int* row = impL + q * 64;
                const int im = row[j]; const bool forced = (j == 0) || (j == jq) || (j == jq - 1); const int v = forced ? 0x7fffffff : (j <= jq ? im : -1);
                int rank = 0;
#pragma unroll 8
                for (int jj = 0; jj <= jq; ++jj) { const int o = __builtin_amdgcn_readlane(v, jj); rank += (o > v || (o == v && jj < j)) ? 1 : 0; }
                const unsigned long long msk = __ballot(rank < 16 && j <= jq);
                if (lane == 0) SEL[(size_t)bg * SEQ + tq] = msk; }
            __syncthreads();
        }
    }
}

namespace pg8 {
struct EpiF32Plain {
    static constexpr bool BP16 = false; static constexpr bool PERM = false, AFTER_DRAIN = false;
    float* C; int ncol;
    __device__ __forceinline__ void operator()(const f32x4 (&acc)[2][2][4][2], const Unit& u, int wr, int wc, int fr, int fq) const {
        float* base = C + (size_t)(u.i0 + wr * 64 + fr) * 256 + wc * 32 + 4 * fq;
#pragma unroll
        for (int bj = 0; bj < 2; ++bj)
#pragma unroll
            for (int n = 0; n < 2; ++n) {
                if (128 * bj + 32 * wc + 16 * n < ncol) {
#pragma unroll
                    for (int ai = 0; ai < 2; ++ai)
#pragma unroll
                        for (int m = 0; m < 4; ++m) *(f32x4*)(base + (size_t)(ai * HALF + m * 16) * 256 + bj * HALF + n * 16) = acc[ai][bj][m][n]; } }
    }
};
struct Cmp1Order {
    int G, c; const char* Y; const char* W;
    __device__ __forceinline__ bool next(int i, Unit& u) const {
        const int L = i * G + c; if (L >= 64) return false;
        const int kv = L >> 5, bg = (L >> 2) & 7, ks = L & 3, b = bg >> 1, g = bg & 1;
        u.A = Y + ((size_t)b * SEQ * LDY + (size_t)ks * 8 * LDY + Y_KV + kv * 256 + g * 128) * 2;
        u.B = W + ((size_t)kv * 256 * 4096 + (size_t)ks * 1024) * 2; u.i0 = (ks * 16 + kv * 8 + bg) * 256; u.i1 = 0; return true;
    }
    __device__ __forceinline__ void a_ready(const Unit&) const {}
    __device__ __forceinline__ void done(const Unit&) const {}
};
}
DI void st_cmp1_mm(const Params& p, int l, unsigned char* smem, const int WV) {
    const int TIDX = opq_tid(WV), BIDX = opq_bid();
    pg8::Cmp1Order S; S.G = gridDim.x; S.c = BIDX; S.Y = (const char*)(p.ws + WS_Y); S.W = (const char*)wl_ptr(p, l, WL_CW1);
    pg8::EpiF32Plain E{(float*)(p.ws + WS_CP), 256};
    pg8::gemm_phase((PG8_LAS unsigned char*)smem, 1024, S, E, TIDX, (size_t)16 * LDY * 2, (size_t)LDY * 2, (size_t)4096 * 2);
}
DI void st_slots(const Params& p, int l, unsigned char* smem, const int WV) {
    const int TIDX = opq_tid(WV), BIDX = opq_bid();
    const int* TOPE = (const int*)(p.ws + WS_TOPE); const int* RANK = (const int*)(p.ws + WS_RANK); int* SLOT = (int*)(p.ws + WS_SLOT); int* TOKOF = (int*)(p.ws + WS_TOKOF);
    const unsigned* CNT = (const unsigned*)(p.ws + WS_CTL) + CW_CNT + l * 64;
    int* po = (int*)smem; pad_offsets(CNT, po, WV);
    for (int i = BIDX * 512 + TIDX; i < NT * 8; i += gridDim.x * 512) { const int slot = po[TOPE[i]] + RANK[i]; SLOT[i] = slot; TOKOF[slot] = i >> 3; }
    for (int e = BIDX; e < 64; e += gridDim.x) { const int a = po[e] + (int)CNT[e], b = po[e + 1]; for (int s = a + TIDX; s < b; s += 512) TOKOF[s] = 0; }
}

namespace pg8 {
struct RouterOrder {
    int G, c; const char* H; const char* HLO; const char* W;
    __device__ __forceinline__ bool next(int i, Unit& u) const {
        const int L = i * G + c; if (L >= 256) return false;
        const int kq = L & 3, pm = L >> 2;
        u.A = H + ((size_t)pm * 256 * DM + (size_t)kq * 512) * 2; u.B = W + (size_t)kq * 512 * 2; u.i0 = kq * NT + pm * 256; u.i1 = 0; return true;
    }
    __device__ __forceinline__ void a_ready(const Unit&) const {}
    __device__ __forceinline__ void done(const Unit&) const {}
};
}
DI void st_rlogit_mm(const Params& p, int l, unsigned char* smem, const int WV) {
    const int TIDX = opq_tid(WV), BIDX = opq_bid();
    pg8::RouterOrder S; S.G = gridDim.x; S.c = BIDX; S.H = (const char*)(p.ws + WS_H); S.HLO = (const char*)(p.ws + WS_HLO); S.W = (const char*)wl_ptr(p, l, WL_RTH);
    pg8::EpiF32Plain E{(float*)(p.ws + WS_LOGP), 128};
    pg8::gemm_phase((PG8_LAS unsigned char*)smem, 512, S, E, TIDX, (size_t)DM * 2, 256, (size_t)DM * 2);
}
DI void st_route(const Params& p, int l, unsigned char* smem, const int WV, const int cnt_l_off = 0) {
    const int TIDX = opq_tid(WV), BIDX = opq_bid();
    const int wave = __builtin_amdgcn_readfirstlane(TIDX >> 6), lane = TIDX & 63;
    const float* LP = (const float*)(p.ws + WS_LOGP);
    int* TOPE = (int*)(p.ws + WS_TOPE); float* TOPW = (float*)(p.ws + WS_TOPW); int* RANK = (int*)(p.ws + WS_RANK); unsigned* CNT = (unsigned*)(p.ws + WS_CTL) + CW_CNT + (l + cnt_l_off) * 64;
    unsigned* lcnt = (unsigned*)smem; unsigned* lbase = lcnt + 64;
    if (TIDX < 64) lcnt[TIDX] = 0u;
    __syncthreads();
    const float rbias = p.router_bias[l * 64 + lane];
    float lpc[8];
    { const int t0 = BIDX * 8 + wave;
#pragma unroll
      for (int q = 0; q < 4; ++q) { lpc[2 * q] = t0 < NT ? LP[(size_t)(q * NT + t0) * 256 + lane] : 0.f; lpc[2 * q + 1] = t0 < NT ? LP[(size_t)(q * NT + t0) * 256 + 64 + lane] : 0.f; } }
    for (int t = BIDX * 8 + wave; t < NT; t += gridDim.x * 8) {
        float lpn[8]; { const int tn = t + gridDim.x * 8; const int tc = tn < NT ? tn : t;
#pragma unroll
          for (int q = 0; q < 4; ++q) { lpn[2 * q] = LP[(size_t)(q * NT + tc) * 256 + lane]; lpn[2 * q + 1] = LP[(size_t)(q * NT + tc) * 256 + 64 + lane]; } }
        float logit = 0.f;
#pragma unroll
        for (int q = 0; q < 4; ++q) logit += lpc[2 * q] + lpc[2 * q + 1];
#pragma unroll
        for (int q = 0; q < 8; ++q) lpc[q] = lpn[q];
        const float score = sigmoid_f(logit); const float biased = score + rbias;
        int rk = 0; const int gb = lane & ~7;
#pragma unroll
        for (int j = 0; j < 8; ++j) { const float o = __shfl(biased, gb + j); rk += (o > biased || (o == biased && (gb + j) < lane)) ? 1 : 0; }
        float gsum = rk < 2 ? biased : 0.f; gsum += __shfl_xor(gsum, 1); gsum += __shfl_xor(gsum, 2); gsum += __shfl_xor(gsum, 4);
        int grk = 0; const int myg = lane >> 3;
#pragma unroll
        for (int gg = 0; gg < 8; ++gg) { const float o = __shfl(gsum, gg * 8); grk += (o > gsum || (o == gsum && gg < myg)) ? 1 : 0; }
        const float masked = grk < 4 ? biased : -__builtin_inff();
        int erk = 0;
        { unsigned long long gm = __ballot(grk < 4 && (lane & 7) == 0);
#pragma unroll
          for (int k = 0; k < 4; ++k) { const int gbase = (int)__builtin_ctzll(gm); gm &= gm - 1ull;
#pragma unroll
              for (int jj = 0; jj < 8; ++jj) { const int j = gbase + jj; const float o = __uint_as_float(__builtin_amdgcn_readlane(__float_as_uint(masked), j)); erk += (o > masked || (o == masked && j < lane)) ? 1 : 0; } } }
        const bool selx = erk < 8; const float wsum = wave_sum(selx ? score : 0.f);
        if (selx) { const unsigned rr = atomicAdd(lcnt + lane, 1u);
            TOPE[(size_t)t * 8 + erk] = lane; TOPW[(size_t)t * 8 + erk] = 2.5f * score / wsum; RANK[(size_t)t * 8 + erk] = (int)rr; }
    }
    __syncthreads();
    if (TIDX < 64) lbase[TIDX] = lcnt[TIDX] ? atomicAdd(CNT + TIDX, lcnt[TIDX]) : 0u;
    asm volatile("s_waitcnt vmcnt(0)" ::: "memory");
    __syncthreads();
    for (int t = BIDX * 8 + wave; t < NT; t += gridDim.x * 8)
        if (lane < 8) { const int e = TOPE[(size_t)t * 8 + lane]; const int rk = RANK[(size_t)t * 8 + lane] + (int)lbase[e]; RANK[(size_t)t * 8 + lane] = rk;
            ((int*)(p.ws + WS_XS))[(size_t)e * NT + rk] = t; }
}

namespace pg8 {
struct GateOrder {
    int G, c; const char* H; const char* W;
    __device__ __forceinline__ bool next(int i, Unit& u) const {
        const int cc = G >= 192 ? (c >= 64 ? c - 64 : c + G - 64) : c;
        const int L = i * G + cc; if (L >= 128) return false;
        const int kh = L & 1, pm = L >> 1;
        u.A = H + ((size_t)pm * 256 * DM + (size_t)kh * 1024) * 2; u.B = W + ((size_t)6144 * DM + (size_t)kh * 1024) * 2; u.i0 = kh * NT + pm * 256; u.i1 = 0; return true;
    }
    __device__ __forceinline__ void a_ready(const Unit&) const {}
    __device__ __forceinline__ void done(const Unit&) const {}
};
}
DI void st_gate_mm(const Params& p, int l, unsigned char* smem, const int WV) {
    const int TIDX = opq_tid(WV), BIDX = opq_bid();
    pg8::GateOrder S; S.G = gridDim.x; S.c = BIDX; S.H = (const char*)(p.ws + WS_H); S.W = (const char*)wl_ptr(p, l, WL_WIN);
    pg8::EpiF32Plain E{(float*)(p.ws + WS_GATEP), 32};
    pg8::gemm_phase((PG8_LAS unsigned char*)smem, 1024, S, E, TIDX, (size_t)DM * 2, 256, (size_t)DM * 2);
}


#define XB_TMO      128
#define XB_XCNT(j)  (256  + 64 * (j))
#define XB_XSUB(j)  (1280 + 64 * (j))
#define XB_XGEN(j)  (2304 + 64 * (j))
#define XB_TOP      3328
#define XB_TOPGEN   3392
#define XCD_BAR_WORDS 3456
#define XB_SPIN_CAP (1u << 18)
#define LAS __attribute__((address_space(3)))

__device__ __forceinline__ unsigned xb_ld(unsigned* p)              { return __hip_atomic_load(p, __ATOMIC_RELAXED, __HIP_MEMORY_SCOPE_AGENT); }
__device__ __forceinline__ unsigned xb_add(unsigned* p, unsigned v) { return __hip_atomic_fetch_add(p, v, __ATOMIC_RELAXED, __HIP_MEMORY_SCOPE_AGENT); }
__device__ __forceinline__ unsigned xb_xcc_id() { return (unsigned)__builtin_amdgcn_s_getreg((3 << 11) | 20) & 0xFu; }
#define XB_SPIN(cond, bar) do { unsigned _sp = 0; while (cond) { __builtin_amdgcn_s_sleep(1); \
    if ((++_sp & 255u) == 0u) { if (xb_ld(&(bar)[XB_TMO])) break; if (_sp > XB_SPIN_CAP) { atomicAdd(&(bar)[XB_TMO], 1u); break; } } } } while (0)

struct XcdBarrier {
    bool t0;
    unsigned* bar; unsigned x;
    volatile LAS unsigned* st;
};

__device__ __forceinline__ XcdBarrier xcd_barrier_post(unsigned* bar, volatile LAS unsigned* st) {
    XcdBarrier b; b.bar = bar; b.x = xb_xcc_id(); b.st = st;
    if (threadIdx.x == 0) (void)xb_add(&bar[XB_XCNT(b.x)], 1u);
    return b;
}
__device__ __forceinline__ void xcd_barrier_complete(unsigned* bar, unsigned x, unsigned& nloc, unsigned& nx) {
    const unsigned G = gridDim.x * gridDim.y * gridDim.z;
    unsigned sum, cnt, mine, sp = 0u;
    for (;;) {
        sum = 0u; cnt = 0u; mine = 0u;
#pragma unroll
        for (unsigned j = 0; j < 16; ++j) { const unsigned c = xb_ld(&bar[XB_XCNT(j)]); sum += c; cnt += (c > 0u) ? 1u : 0u; mine = (j == x) ? c : mine; }
        if (sum == G) break;
        __builtin_amdgcn_s_sleep(1);
        if ((++sp & 255u) == 0u) { if (xb_ld(&bar[XB_TMO])) break; if (sp > XB_SPIN_CAP) { atomicAdd(&bar[XB_TMO], 1u); break; } }
    }
    nloc = mine > 0u ? mine : 1u; nx = cnt > 0u ? cnt : 1u;
}

__device__ __forceinline__ void xcd_barrier(const XcdBarrier& b) {
    asm volatile("s_waitcnt vmcnt(0)" ::: "memory");
    __syncthreads();
    if (b.t0) {
        unsigned* bar = b.bar;
        __builtin_amdgcn_s_waitcnt(0);
        unsigned nloc = b.st[0], nx = b.st[1];
        if (nloc == 0u) { xcd_barrier_complete(bar, b.x, nloc, nx); b.st[0] = nloc; b.st[1] = nx; }
        const unsigned old = xb_add(&bar[XB_XSUB(b.x)], 1u);
        const unsigned gen = old / nloc;
        if (old + 1u == (gen + 1u) * nloc) {
            __builtin_amdgcn_fence(__ATOMIC_RELEASE, "agent");
            asm volatile("s_waitcnt vmcnt(0)" ::: "memory");
            const unsigned og = xb_add(&bar[XB_TOP], 1u);
            const unsigned tg = og / nx;
            if (og + 1u == (tg + 1u) * nx) xb_add(&bar[XB_TOPGEN], 1u);
            else XB_SPIN(xb_ld(&bar[XB_TOPGEN]) == tg, bar);
            __builtin_amdgcn_fence(__ATOMIC_ACQUIRE, "agent");
            xb_add(&bar[XB_XGEN(b.x)], 1u);
            asm volatile("s_waitcnt vmcnt(0)" ::: "memory");
        } else {
            XB_SPIN(xb_ld(&bar[XB_XGEN(b.x)]) == gen, bar);
            __builtin_amdgcn_fence(__ATOMIC_ACQUIRE, "agent");
            asm volatile("s_waitcnt vmcnt(0)" ::: "memory");
        }
    }
    __syncthreads();
}


DI void launder(Params& q, int& l) {
    long z = 0; asm volatile("" : "+s"(z));
#define L_(f) q.f = (decltype(q.f))((const char*)q.f + z)
    L_(x); L_(c); L_(pos); L_(ada_w); L_(ada_b); L_(norm1_g); L_(norm2_g); L_(w_in); L_(conv_w); L_(conv_g); L_(cmp_pe); L_(cmp_w1); L_(cmp_w2); L_(nsa_g); L_(ret_g); L_(w_out);
    L_(router_w); L_(router_bias); L_(exp_w_gu); L_(exp_w_down); L_(shared_w_gu); L_(shared_w_down); L_(final_g);
#undef L_
    q.out = (float*)((char*)q.out + z); q.ws = q.ws + z;
    asm volatile("" : "+s"(l));
}
constexpr int CW_BAR = 16384;
constexpr int SMEM_MEGA = 152 * 1024;
__global__ void __launch_bounds__(512, 2) k_mega(Params p) {
    extern __shared__ __attribute__((aligned(16))) unsigned char smem[];
    volatile LAS unsigned* bst = (volatile LAS unsigned*)(smem + LDS_BST);
    const int WV = __builtin_amdgcn_readfirstlane(threadIdx.x >> 6);
    if (threadIdx.x < 4) bst[threadIdx.x] = 0u;
    __syncthreads();
    (void)xcd_barrier_post((unsigned*)(p.ws + WS_CTL) + CW_BAR, bst);
#define GRID_BAR() do { Params q = p; int l_ = 0; launder(q, l_); XcdBarrier b_; b_.t0 = (opq_tid(WV) == 0); b_.bar = (unsigned*)(q.ws + WS_CTL) + CW_BAR; b_.x = xb_xcc_id(); b_.st = bst; xcd_barrier(b_); if (MK_PROBE == 18) xcd_barrier(b_); } while (0)
#define STG(call) do { Params q = p; launder(q, l); call; } while (0)
#define REP(n, call) do { if (MK_PROBE == (n)) { STG(call); __syncthreads(); } } while (0)
    { int l = 0; REP(1, st_convert(q, smem, WV)); STG(st_convert(q, smem, WV)); __syncthreads(); REP(17, st_mod(q, smem, WV)); STG(st_mod(q, smem, WV)); GRID_BAR(); REP(17, st_norm(q, 0, q.x, 0, smem, WV)); STG(st_norm(q, 0, q.x, 0, smem, WV)); GRID_BAR(); }
#pragma clang loop unroll(disable)
    for (int l0 = 0; l0 < NL; ++l0) {
        int l = l0;
        REP(8, st_inproj_mm(q, l, smem, WV)); STG(st_inproj_mm(q, l, smem, WV)); GRID_BAR();
        REP(20, st_post(q, l, smem, WV)); REP(20, st_post(q, l, smem, WV, -1.f)); STG(st_post(q, l, smem, WV)); __syncthreads(); REP(15, st_vt(q, l, smem, WV)); STG(st_vt(q, l, smem, WV)); GRID_BAR();
        REP(2, st_cmp1_mm(q, l, smem, WV)); STG(st_cmp1_mm(q, l, smem, WV)); STG(st_gate_mm(q, l, smem, WV)); __syncthreads(); REP(16, st_kvchunk_mm(q, l, smem, WV)); STG(st_kvchunk_mm(q, l, smem, WV)); GRID_BAR();
        REP(16, st_cmp2(q, l, smem, WV)); REP(16, st_scan(q, l, WV)); STG(st_cmp2(q, l, smem, WV)); STG(st_scan(q, l, WV)); GRID_BAR();
        REP(12, st_cmpattn_mm(q, l, smem, WV)); REP(24, st_retout_mm(q, l, smem, WV)); STG(st_cmpattn_mm(q, l, smem, WV)); __syncthreads(); STG(st_retout_mm(q, l, smem, WV)); GRID_BAR();
        REP(14, st_attn_mm(q, l, smem, WV)); STG(st_attn_mm(q, l, smem, WV)); GRID_BAR();
        REP(13, st_outproj_mm(q, l, q.x, l == 0 ? (const bf16_t*)nullptr : (const bf16_t*)(q.ws + WS_X2), smem, WV)); STG(st_outproj_mm(q, l, q.x, l == 0 ? (const bf16_t*)nullptr : (const bf16_t*)(q.ws + WS_X2), smem, WV)); GRID_BAR();
        REP(17, st_norm(q, l, (const float*)(q.ws + WS_X1), 1, smem, WV)); STG(st_norm(q, l, (const float*)(q.ws + WS_X1), 1, smem, WV)); GRID_BAR();
        REP(23, st_rlogit_mm(q, l, smem, WV)); STG(st_rlogit_mm(q, l, smem, WV)); GRID_BAR();
        REP(25, st_route(q, l, smem, WV, 2)); STG(st_route(q, l, smem, WV)); GRID_BAR();
        REP(9, st_gemm1_mm(q, l, smem, WV)); STG(st_gemm1_mm(q, l, smem, WV)); GRID_BAR();
        REP(10, st_gemm2_mm(q, l, smem, WV)); STG(st_gemm2_mm(q, l, smem, WV)); GRID_BAR();
        REP(7, st_combine(q, l, smem, WV)); REP(11, st_combine(q, l, smem, WV)); STG(st_combine(q, l, smem, WV)); if (l0 + 1 < NL) GRID_BAR();
    }
#undef STG
#undef GRID_BAR
}
extern "C" void kernel_launch(void* const* d_in, const int* in_sizes, int n_in, void* d_out, int out_size, void* d_ws, size_t ws_size, hipStream_t stream) {
    if (n_in != 23 || ws_size < WS_END) { fprintf(stderr, "kernel_launch: unexpected n_in %d or ws_size %zu < %zu\n", n_in, ws_size, (size_t)WS_END); return; }
    Params p; memset(&p, 0, sizeof(p));
    p.x = (const float*)d_in[0]; p.c = (const float*)d_in[1]; p.pos = (const int*)d_in[2];
    p.ada_w = (const float*)d_in[3]; p.ada_b = (const float*)d_in[4]; p.norm1_g = (const float*)d_in[5]; p.norm2_g = (const float*)d_in[6]; p.w_in = (const float*)d_in[7];
    p.conv_w = (const float*)d_in[8]; p.conv_g = (const float*)d_in[9]; p.cmp_pe = (const float*)d_in[10]; p.cmp_w1 = (const float*)d_in[11]; p.cmp_w2 = (const float*)d_in[12];
    p.nsa_g = (const float*)d_in[13]; p.ret_g = (const float*)d_in[14]; p.w_out = (const float*)d_in[15]; p.router_w = (const float*)d_in[16]; p.router_bias = (const float*)d_in[17];
    p.exp_w_gu = (const float*)d_in[18]; p.exp_w_down = (const float*)d_in[19]; p.shared_w_gu = (const float*)d_in[20]; p.shared_w_down = (const float*)d_in[21]; p.final_g = (const float*)d_in[22];
    p.out = (float*)d_out; p.ws = (unsigned char*)d_ws;
    (void)hipMemsetAsync((char*)d_ws + WS_CTL, 0, 1 * MiB, stream);
    static int grid = 0;
    if (!grid) {
        int dev = 0, cus = 0, per_cu = 0;
        (void)hipGetDevice(&dev); (void)hipDeviceGetAttribute(&cus, hipDeviceAttributeMultiprocessorCount, dev);
        (void)hipFuncSetAttribute((const void*)k_mega, hipFuncAttributeMaxDynamicSharedMemorySize, SMEM_MEGA);
        if (hipOccupancyMaxActiveBlocksPerMultiprocessor(&per_cu, (const void*)k_mega, 512, SMEM_MEGA) != hipSuccess || per_cu < 1) { fprintf(stderr, "kernel_launch: occupancy query says %d\n", per_cu); (void)hipGetLastError(); }
        grid = cus > 0 ? cus : 256;
    }
    hipLaunchKernelGGL(k_mega, dim3(grid), dim3(512), SMEM_MEGA, stream, p);
}
```
